# Optimizing an MI355X kernel written in HIP

```python
import math
import jax
import jax.numpy as jnp
from jax import lax
import numpy as np

D_MODEL = 1024
BATCH = 8
SEQ = 2048
DEPTH = 4

GRID_W = 64
CTX_LEN = 256
N_MIXERS = 3

DN_ALPHA = (2 * DEPTH) ** 0.25
DN_BETA = (8 * DEPTH) ** -0.25
LN_EPS = 1e-5

DA_HEAD_DIM = 64
DA_HEADS = D_MODEL // (2 * DA_HEAD_DIM)
DA_V_DIM = 2 * DA_HEAD_DIM
Q_BLOCK = 128
ROPE_BASE = 10000.0

S5_GROUP = 16
S5_GROUPS = D_MODEL // S5_GROUP
S5_STATE = 64
DT_MIN = 1e-3
DT_MAX = 1e-1

LRU_WIDTH = 1408
LRU_BLOCKS = 16
LRU_BLOCK = LRU_WIDTH // LRU_BLOCKS
LRU_C = 8.0
CONV_W = 4

N_EXPERTS = 16
N_GROUPS = 4
EXPERTS_PER_GROUP = N_EXPERTS // N_GROUPS
TOP_K = 2
D_EXPERT = 1024
MOE_BLOCK = 256

N_ATTN = (DEPTH + 2) // 3
N_S5 = (DEPTH + 1) // 3
N_LRU = DEPTH // 3

kernel_name = "hybrid_diffattn_s5_rglru_grouped_moe_trunk"


def _layer_norm(x, g, b):
    xf = x.astype(jnp.float32)
    mu = jnp.mean(xf, -1, keepdims=True)
    var = jnp.mean(jnp.square(xf - mu), -1, keepdims=True)
    return ((xf - mu) * lax.rsqrt(var + LN_EPS) * g.astype(jnp.float32) + b.astype(jnp.float32)).astype(x.dtype)


def _modulate(h, shift, scale):
    return h * (1 + scale) + shift


def _rope_1d(x, pos):
    half = x.shape[-1] // 2
    freq = ROPE_BASE ** (-jnp.arange(half, dtype=jnp.float32) / half)
    ang = pos.astype(jnp.float32)[:, None] * freq[None, :]
    cos = jnp.cos(ang)[:, None, None, :]
    sin = jnp.sin(ang)[:, None, None, :]
    x1, x2 = x[..., :half], x[..., half:]
    return jnp.concatenate([x1 * cos - x2 * sin, x2 * cos + x1 * sin], axis=-1)


def _rope_2d(x, row, col):
    q = x.shape[-1] // 2
    out = jnp.concatenate([_rope_1d(x[..., :q], row), _rope_1d(x[..., q:], col)], axis=-1)
    return out.astype(x.dtype)


def _diff_attention(hc, hl, w_in, w_out, lam, subln_g, lam_init, need_ctx):
    B, T, D = hl.shape
    n_rows = T // GRID_W
    row = jnp.repeat(jnp.arange(n_rows), GRID_W)
    col = jnp.tile(jnp.arange(GRID_W), n_rows)

    def proj(h):
        L = h.shape[1]
        u = h @ w_in
        q = u[..., :D].reshape(B, L, 2, DA_HEADS, DA_HEAD_DIM)
        k = u[..., D:2 * D].reshape(B, L, 2, DA_HEADS, DA_HEAD_DIM)
        v = u[..., 2 * D:].reshape(B, L, DA_HEADS, DA_V_DIM)
        return q, k, v

    q_c, k_c, v_c = proj(hc)
    q_l, k_l, v_l = proj(hl)
    q_l = _rope_2d(q_l, row, col)
    k_l = _rope_2d(k_l, row, col)
    k_all = jnp.concatenate([k_c, k_l], axis=1)
    v_all = jnp.concatenate([v_c, v_l], axis=1)

    lf = lam.astype(jnp.float32)
    lam_full = jnp.exp(jnp.sum(lf[0] * lf[1])) - jnp.exp(jnp.sum(lf[2] * lf[3])) + lam_init
    scale = DA_HEAD_DIM ** -0.5

    def attend(q, k, v):
        s = jnp.einsum('bqmhd,bkmhd->bmhqk', q, k).astype(jnp.float32) * scale
        p = jax.nn.softmax(s, axis=-1)
        w = p[:, 0] - lam_full * p[:, 1]
        return jnp.einsum('bhqk,bkhe->bqhe', w, v.astype(jnp.float32))

    nb = T // Q_BLOCK
    qb = q_l.reshape(B, nb, Q_BLOCK, 2, DA_HEADS, DA_HEAD_DIM).swapaxes(0, 1)
    o_l = lax.map(lambda qq: attend(qq, k_all, v_all), qb)
    o_l = o_l.swapaxes(0, 1).reshape(B, T, DA_HEADS, DA_V_DIM)

    def finish(o):
        ms = jnp.mean(jnp.square(o), -1, keepdims=True)
        o = o * lax.rsqrt(ms + LN_EPS) * subln_g.astype(jnp.float32) * (1.0 - lam_init)
        return o.reshape(o.shape[0], o.shape[1], D).astype(hl.dtype) @ w_out

    y_l = finish(o_l)
    y_c = finish(attend(q_c, k_c, v_c)) if need_ctx else None
    return y_c, y_l


def _cmul(ar, ai, br, bi):
    return ar * br - ai * bi, ar * bi + ai * br


def _complex_op(l, r):
    lar, lai, lbr, lbi = l
    rar, rai, rbr, rbi = r
    ar, ai = _cmul(lar, lai, rar, rai)
    br, bi = _cmul(rar, rai, lbr, lbi)
    return ar, ai, br + rbr, bi + rbi


def _complex_linear_scan(ar, ai, br, bi, h0r, h0i, reverse):
    idx = -1 if reverse else 0
    add_r, add_i = _cmul(ar[:, idx], ai[:, idx], h0r, h0i)
    br = br.at[:, idx].add(add_r)
    bi = bi.at[:, idx].add(add_i)
    _, _, hr, hi = lax.associative_scan(_complex_op, (ar, ai, br, bi), reverse=reverse, axis=1)
    return hr, hi


def _real_op(l, r):
    return l[0] * r[0], r[0] * l[1] + r[1]


def _real_linear_scan(a, b, h0, reverse):
    idx = -1 if reverse else 0
    b = b.at[:, idx].add(a[:, idx] * h0)
    _, h = lax.associative_scan(_real_op, (a, b), reverse=reverse, axis=1)
    return h


def _s5_mixer(hc, hl, w_in, a_re, a_im, b_re, b_im, c_re, c_im, log_dt, d_skip, glu_v, glu_g, need_ctx):
    B, T, D = hl.shape
    Cn = hc.shape[1]
    f32 = jnp.float32
    uc = (hc @ w_in).astype(f32).reshape(B, Cn, S5_GROUPS, S5_GROUP)
    ul = (hl @ w_in).astype(f32).reshape(B, T, S5_GROUPS, S5_GROUP)
    y_l = d_skip.astype(f32) * ul.reshape(B, T, D)
    y_c = d_skip.astype(f32) * uc.reshape(B, Cn, D)
    for d, reverse in ((0, False), (1, True)):
        dt = jnp.exp(log_dt[d].astype(f32))[:, None]
        Ar, Ai = a_re[d].astype(f32), a_im[d].astype(f32)
        mag = jnp.exp(Ar * dt)
        zr, zi = mag * jnp.cos(Ai * dt), mag * jnp.sin(Ai * dt)
        den = Ar * Ar + Ai * Ai
        kr = ((zr - 1.0) * Ar + zi * Ai) / den
        ki = (zi * Ar - (zr - 1.0) * Ai) / den
        bbr, bbi = _cmul(kr[..., None], ki[..., None], b_re[d].astype(f32), b_im[d].astype(f32))
        cr, ci = c_re[d].astype(f32), c_im[d].astype(f32)

        def drive(u):
            return (jnp.einsum('btgn,gpn->btgp', u, bbr), jnp.einsum('btgn,gpn->btgp', u, bbi))

        def decay(L):
            shp = (1, L, S5_GROUPS, S5_STATE)
            return jnp.broadcast_to(zr, shp), jnp.broadcast_to(zi, shp)

        def readout(hr, hi):
            y = jnp.einsum('btgp,gnp->btgn', hr, cr) - jnp.einsum('btgp,gnp->btgn', hi, ci)
            return y.reshape(y.shape[0], y.shape[1], D)

        zero = jnp.zeros((B, S5_GROUPS, S5_STATE), f32)
        hcr, hci = _complex_linear_scan(*decay(Cn), *drive(uc), zero, zero, reverse)
        fidx = 0 if reverse else -1
        hlr, hli = _complex_linear_scan(*decay(T), *drive(ul), hcr[:, fidx], hci[:, fidx], reverse)
        y_l = y_l + readout(hlr, hli)
        if need_ctx:
            y_c = y_c + readout(hcr, hci)

    def glu(y):
        g = jax.nn.gelu(y).astype(hl.dtype)
        return (g @ glu_v) * jax.nn.sigmoid(g @ glu_g)

    return (glu(y_c) if need_ctx else None), glu(y_l)


def _block_diag(x, w):
    xs = x.reshape(x.shape[0], x.shape[1], LRU_BLOCKS, LRU_BLOCK)
    return jnp.einsum('btnd,nde->btne', xs, w).reshape(x.shape)


def _depthwise_conv(x, w, b):
    y = lax.conv_general_dilated(x, w[:, None, :], window_strides=(1,), padding=[(1, 2)],
                                 dimension_numbers=('NWC', 'WIO', 'NWC'),
                                 feature_group_count=x.shape[-1])
    return y + b


def _rglru_mixer(hc, hl, w_in, conv_w, conv_b, w_a, b_a, w_x, b_x, lam, w_out, need_ctx):
    B = hl.shape[0]
    f32 = jnp.float32

    def branches(h):
        u = h @ w_in
        return jax.nn.gelu(u[..., :LRU_WIDTH]), _depthwise_conv(u[..., LRU_WIDTH:], conv_w, conv_b)

    gc, xc = branches(hc)
    gl, xl = branches(hl)
    hsum_l = 0.0
    hsum_c = 0.0
    for d, reverse in ((0, False), (1, True)):
        def coeffs(xs):
            r = jax.nn.sigmoid(_block_diag(xs, w_a[d]).astype(f32) + b_a[d].astype(f32))
            i = jax.nn.sigmoid(_block_diag(xs, w_x[d]).astype(f32) + b_x[d].astype(f32))
            log_a = -LRU_C * r * jax.nn.softplus(-lam[d].astype(f32))
            return jnp.exp(log_a), jnp.sqrt(-jnp.expm1(2.0 * log_a)) * (i * xs.astype(f32))

        ac, bc = coeffs(xc)
        hcs = _real_linear_scan(ac, bc, jnp.zeros((B, LRU_WIDTH), f32), reverse)
        h0 = hcs[:, 0 if reverse else -1]
        al, bl = coeffs(xl)
        hsum_l = hsum_l + _real_linear_scan(al, bl, h0, reverse)
        if need_ctx:
            hsum_c = hsum_c + hcs
    y_l = (hsum_l.astype(hl.dtype) * gl) @ w_out
    y_c = ((hsum_c.astype(hc.dtype) * gc) @ w_out) if need_ctx else None
    return y_c, y_l


def _moe(h, router_w, router_b, w_gate, w_up, w_down):
    N, D = h.shape
    probs = jax.nn.softmax((h @ router_w).astype(jnp.float32), axis=-1)
    sel = probs + router_b.astype(jnp.float32)
    grp = sel.reshape(N, N_GROUPS, EXPERTS_PER_GROUP)
    g_idx = jnp.argmax(lax.top_k(grp, TOP_K)[0].sum(-1), axis=-1)
    in_grp = (jnp.arange(N_GROUPS)[None, :] == g_idx[:, None])[:, :, None]
    masked = jnp.where(in_grp, grp, -jnp.inf).reshape(N, N_EXPERTS)
    _, e_idx = lax.top_k(masked, TOP_K)
    w = jnp.take_along_axis(probs, e_idx, axis=1)
    w = w / jnp.sum(w, -1, keepdims=True)

    A = N * TOP_K
    e_flat = e_idx.reshape(-1)
    order = jnp.argsort(e_flat)
    es = e_flat[order]
    counts = jnp.bincount(e_flat, length=N_EXPERTS)
    padded = ((counts + MOE_BLOCK - 1) // MOE_BLOCK) * MOE_BLOCK
    pend = jnp.cumsum(padded)
    pstart = pend - padded
    cstart = jnp.cumsum(counts) - counts
    dest = pstart[es] + jnp.arange(A) - cstart[es]
    n_blk = -(-A // MOE_BLOCK) + N_EXPERTS
    R = n_blk * MOE_BLOCK
    row_tok = jnp.full((R,), N, jnp.int32).at[dest].set((order // TOP_K).astype(jnp.int32))
    row_w = jnp.zeros((R,), jnp.float32).at[dest].set(w.reshape(-1)[order])
    blk_e = jnp.minimum(jnp.searchsorted(pend, jnp.arange(n_blk) * MOE_BLOCK, side='right'), N_EXPERTS - 1)
    h_pad = jnp.concatenate([h, jnp.zeros((1, D), h.dtype)], axis=0)
    xr = h_pad[row_tok].reshape(n_blk, MOE_BLOCK, D)

    def expert_block(args):
        xb, e = args
        return (jax.nn.silu(xb @ w_gate[e]) * (xb @ w_up[e])) @ w_down[e]

    yr = lax.map(expert_block, (xr, blk_e)).reshape(R, D)
    y = jnp.zeros((N + 1, D), yr.dtype).at[row_tok].add(yr * row_w[:, None].astype(yr.dtype))
    return y[:N]


def setup_inputs(seed: int = 0) -> dict:
    key = jax.random.key(seed)
    ks = iter(jax.random.split(key, 48))
    f32 = jnp.float32

    def nrm(shape, scale):
        return jax.random.normal(next(ks), shape, f32) * scale

    D = D_MODEL
    G, P = S5_GROUPS, S5_STATE
    W = LRU_WIDTH
    inp = {}
    inp["x"] = nrm((BATCH, SEQ, D), 1.0)
    inp["c"] = nrm((BATCH, D), 1.0)
    inp["ctx"] = nrm((BATCH, CTX_LEN, D), 1.0)
    inp["c_ctx"] = nrm((D,), 1.0)
    inp["w_ada"] = nrm((DEPTH, D, 6 * D), 0.5 * D ** -0.5)
    inp["b_ada"] = nrm((DEPTH, 6 * D), 0.02)
    inp["ln_g"] = 1.0 + nrm((DEPTH, 2, D), 0.02)
    inp["ln_b"] = nrm((DEPTH, 2, D), 0.02)
    inp["attn_w_in"] = nrm((N_ATTN, D, 3 * D), D ** -0.5)
    inp["attn_w_out"] = nrm((N_ATTN, D, D), D ** -0.5 * DN_BETA)
    inp["attn_lam"] = nrm((N_ATTN, 4, DA_HEAD_DIM), 0.1)
    inp["attn_subln"] = 1.0 + nrm((N_ATTN, DA_V_DIM), 0.02)
    inp["s5_w_in"] = nrm((N_S5, D, D), D ** -0.5)
    inp["s5_a_re"] = -0.5 + nrm((N_S5, 2, G, P), 0.01)
    inp["s5_a_im"] = math.pi * jnp.arange(P, dtype=f32) + nrm((N_S5, 2, G, P), 0.01)
    inp["s5_b_re"] = nrm((N_S5, 2, G, P, S5_GROUP), (2 * S5_GROUP) ** -0.5)
    inp["s5_b_im"] = nrm((N_S5, 2, G, P, S5_GROUP), (2 * S5_GROUP) ** -0.5)
    inp["s5_c_re"] = nrm((N_S5, 2, G, S5_GROUP, P), (2 * P) ** -0.5)
    inp["s5_c_im"] = nrm((N_S5, 2, G, S5_GROUP, P), (2 * P) ** -0.5)
    inp["s5_log_dt"] = jax.random.uniform(next(ks), (N_S5, 2, G), f32, math.log(DT_MIN), math.log(DT_MAX))
    inp["s5_d"] = nrm((N_S5, D), 1.0)
    inp["s5_glu_v"] = nrm((N_S5, D, D), D ** -0.5 * DN_BETA)
    inp["s5_glu_g"] = nrm((N_S5, D, D), D ** -0.5)
    inp["lru_w_in"] = nrm((N_LRU, D, 2 * W), D ** -0.5)
    inp["lru_conv_w"] = nrm((N_LRU, CONV_W, W), CONV_W ** -0.5)
    inp["lru_conv_b"] = nrm((N_LRU, W), 0.02)
    inp["lru_w_a"] = nrm((N_LRU, 2, LRU_BLOCKS, LRU_BLOCK, LRU_BLOCK), LRU_BLOCK ** -0.5)
    inp["lru_b_a"] = nrm((N_LRU, 2, W), 0.02)
    inp["lru_w_x"] = nrm((N_LRU, 2, LRU_BLOCKS, LRU_BLOCK, LRU_BLOCK), LRU_BLOCK ** -0.5)
    inp["lru_b_x"] = nrm((N_LRU, 2, W), 0.02)
    u = jax.random.uniform(next(ks), (N_LRU, 2, W), f32, 0.81, 0.998)
    s = u ** (1.0 / LRU_C)
    inp["lru_lam"] = jnp.log(s) - jnp.log1p(-s)
    inp["lru_w_out"] = nrm((N_LRU, W, D), W ** -0.5 * DN_BETA)
    inp["router_w"] = nrm((D, N_EXPERTS), D ** -0.5)
    inp["router_b"] = nrm((N_EXPERTS,), 0.01)
    inp["moe_w_gate"] = nrm((DEPTH, N_EXPERTS, D, D_EXPERT), D ** -0.5)
    inp["moe_w_up"] = nrm((DEPTH, N_EXPERTS, D, D_EXPERT), D ** -0.5)
    inp["moe_w_down"] = nrm((DEPTH, N_EXPERTS, D_EXPERT, D), D_EXPERT ** -0.5 * DN_BETA)
    return inp


def reference(x, c, ctx, c_ctx, w_ada, b_ada, ln_g, ln_b,
              attn_w_in, attn_w_out, attn_lam, attn_subln,
              s5_w_in, s5_a_re, s5_a_im, s5_b_re, s5_b_im, s5_c_re, s5_c_im, s5_log_dt, s5_d, s5_glu_v, s5_glu_g,
              lru_w_in, lru_conv_w, lru_conv_b, lru_w_a, lru_b_a, lru_w_x, lru_b_x, lru_lam, lru_w_out,
              router_w, router_b, moe_w_gate, moe_w_up, moe_w_down):
    B, T, D = x.shape
    Cn = ctx.shape[1]
    s_lat = jax.nn.silu(c)
    s_ctx = jax.nn.silu(c_ctx)
    for i in range(DEPTH):
        kind, slot, last = i % N_MIXERS, i // N_MIXERS, i == DEPTH - 1
        need_ctx = not last
        m_l = (s_lat @ w_ada[i] + b_ada[i])[:, None, :]
        m_c = s_ctx @ w_ada[i] + b_ada[i]
        sh1_l, sc1_l, g1_l, sh2_l, sc2_l, g2_l = jnp.split(m_l, 6, axis=-1)
        sh1_c, sc1_c, g1_c, sh2_c, sc2_c, g2_c = jnp.split(m_c, 6, axis=-1)

        hl = _modulate(x, sh1_l, sc1_l)
        hc = _modulate(ctx, sh1_c, sc1_c)
        if kind == 0:
            lam_init = 0.8 - 0.6 * math.exp(-0.3 * i)
            yc, yl = _diff_attention(hc, hl, attn_w_in[slot], attn_w_out[slot], attn_lam[slot],
                                     attn_subln[slot], lam_init, need_ctx)
        elif kind == 1:
            yc, yl = _s5_mixer(hc, hl, s5_w_in[slot], s5_a_re[slot], s5_a_im[slot], s5_b_re[slot],
                               s5_b_im[slot], s5_c_re[slot], s5_c_im[slot], s5_log_dt[slot], s5_d[slot],
                               s5_glu_v[slot], s5_glu_g[slot], need_ctx)
        else:
            yc, yl = _rglru_mixer(hc, hl, lru_w_in[slot], lru_conv_w[slot], lru_conv_b[slot], lru_w_a[slot],
                                  lru_b_a[slot], lru_w_x[slot], lru_b_x[slot], lru_lam[slot],
                                  lru_w_out[slot], need_ctx)
        x = _layer_norm(DN_ALPHA * x + g1_l * yl, ln_g[i, 0], ln_b[i, 0])
        if need_ctx:
            ctx = _layer_norm(DN_ALPHA * ctx + g1_c * yc, ln_g[i, 0], ln_b[i, 0])

        hl = _modulate(x, sh2_l, sc2_l)
        if need_ctx:
            hc = _modulate(ctx, sh2_c, sc2_c)
            tok = jnp.concatenate([hc, hl], axis=1).reshape(-1, D)
            y = _moe(tok, router_w, router_b, moe_w_gate[i], moe_w_up[i], moe_w_down[i]).reshape(B, Cn + T, D)
            ctx = _layer_norm(DN_ALPHA * ctx + g2_c * y[:, :Cn], ln_g[i, 1], ln_b[i, 1])
            yl = y[:, Cn:]
        else:
            yl = _moe(hl.reshape(-1, D), router_w, router_b, moe_w_gate[i], moe_w_up[i],
                      moe_w_down[i]).reshape(B, T, D)
        x = _layer_norm(DN_ALPHA * x + g2_l * yl, ln_g[i, 1], ln_b[i, 1])
    return x
```

```cpp
#include <hip/hip_runtime.h>
#include <cstdio>
#include <cstdint>

#ifndef MK_N_LAUNCHES
#define MK_N_LAUNCHES 1
#endif

#define LAS __attribute__((address_space(3)))
#define GAS __attribute__((address_space(1)))
typedef unsigned short bf16_t;
typedef short bf16x8 __attribute__((ext_vector_type(8)));
typedef short s16x4 __attribute__((ext_vector_type(4)));
typedef float f32x4 __attribute__((ext_vector_type(4)));
typedef float f32x2 __attribute__((ext_vector_type(2)));
typedef float f32x16 __attribute__((ext_vector_type(16)));
typedef unsigned u32x4 __attribute__((ext_vector_type(4)));
typedef unsigned u32x2 __attribute__((ext_vector_type(2)));
typedef GAS unsigned gu32;
#define RLX_AGENT __ATOMIC_RELAXED, __HIP_MEMORY_SCOPE_AGENT
#define LDS_WAIT() asm volatile("s_waitcnt lgkmcnt(0)" ::: "memory")
#define VM_WAIT() asm volatile("s_waitcnt vmcnt(0)" ::: "memory")
#define DI __device__ __forceinline__

constexpr int D = 1024, NB = 8, TL = 2048, CN = 256, LSEQ = TL + CN  , MROWS = NB * LSEQ  , DEPTH = 4;
constexpr int NE = 16, DEXP = 1024, LRUW = 1408, LRUB = 88;
constexpr int S5G = 64, S5P = 64, S5N = 16;
constexpr float LN_EPS = 1e-5f;
constexpr float DN_ALPHA = 1.6817928305074292f;
constexpr int NWAVES = 8;

constexpr size_t MiB = 1u << 20;
constexpr size_t WS_CTL = 0, CTL_ZERO_BYTES = 1 * MiB;
constexpr size_t WS_MODP = 1 * MiB;
constexpr size_t WS_MOD = 16 * MiB;
constexpr size_t WS_PAR = 17 * MiB;
constexpr size_t WS_BD = 19 * MiB;
constexpr size_t WS_WATT_IN = 21 * MiB;
constexpr size_t WS_WATT_OUT = 33 * MiB;
constexpr size_t WS_WS5_IN = 37 * MiB;
constexpr size_t WS_WS5_GLU = 39 * MiB;
constexpr size_t WS_WLRU_IN = 43 * MiB;
constexpr size_t WS_WLRU_OUT = 49 * MiB;
constexpr size_t WS_WGU = 52 * MiB;
constexpr size_t WS_WD = 116 * MiB;
constexpr size_t WS_X = 148 * MiB;
constexpr size_t WS_H = 220 * MiB;
constexpr size_t WS_TOK = 256 * MiB;
constexpr size_t WS_HID = 258 * MiB;
constexpr size_t WS_YEXP = 338 * MiB;
constexpr size_t WS_MIX = 418 * MiB;
constexpr size_t WS_END = 670 * MiB;
constexpr size_t MX_Q = WS_MIX, MX_K = WS_MIX + 36 * MiB, MX_V = WS_MIX + 72 * MiB, MX_AO = WS_MIX + 108 * MiB;
constexpr size_t MX_U = WS_MIX, MX_Y0 = WS_MIX + 72 * MiB, MX_Y1 = WS_MIX + 144 * MiB, MX_G = WS_MIX + 216 * MiB;
constexpr size_t MX_UG = WS_MIX, MX_A2 = WS_MIX + 100 * MiB, MX_SUMM = WS_MIX + 150 * MiB, MX_CARRY = WS_MIX + 158 * MiB;
constexpr size_t PAR_ZR = 0, PAR_ZI = 32768, PAR_BBR = 65536, PAR_BBI = 65536 + 524288, PAR_ROPE = 65536 + 2 * 524288, PAR_SP = PAR_ROPE + 8192;
constexpr int CW_BAR = 4096;
constexpr int CW_CNT = 16384;

constexpr int RING_BYTES = 131072;
constexpr int MISC_OFF = RING_BYTES;
constexpr int TB_OFF = MISC_OFF + 512;
constexpr int TAB_OFF = TB_OFF + 512;
constexpr int LDS_BYTES = 147456;
static_assert(TAB_OFF + 8 * 1024 <= LDS_BYTES, "LDS map");

DI unsigned f2bf(float f) { unsigned u = __builtin_bit_cast(unsigned, f); return (u + 0x7fffu + ((u >> 16) & 1u)) >> 16; }
DI unsigned pk2(float lo, float hi) { return f2bf(lo) | (f2bf(hi) << 16); }
DI float bf2f(unsigned short b) { return __builtin_bit_cast(float, ((unsigned)b) << 16); }
DI float bflo(unsigned w) { return __builtin_bit_cast(float, w << 16); }
DI float bfhi(unsigned w) { return __builtin_bit_cast(float, w & 0xffff0000u); }
DI float wave_sum(float v) {
#pragma unroll
    for (int o = 1; o < 64; o <<= 1) v += __shfl_xor(v, o);
    return v;
}
DI float wave_max(float v) {
#pragma unroll
    for (int o = 1; o < 64; o <<= 1) v = fmaxf(v, __shfl_xor(v, o));
    return v;
}
DI float sigmoidf_(float x) { return 1.0f / (1.0f + __expf(-x)); }
DI float gelu_tanh(float x) { const float u = 0.7978845608028654f * (x + 0.044715f * x * x * x); const float e = __expf(2.0f * u); const float t = 1.0f - 2.0f / (e + 1.0f); return 0.5f * x * (1.0f + t); }
DI void sincos_cw(float x, float& s, float& c) {
    const float k = rintf(x * 0.6366197723675814f);
    float r = fmaf(k, -1.5707962512969971f, x); r = fmaf(k, -7.5497894158615964e-08f, r); r = fmaf(k, -5.3903029534742384e-15f, r);
    const float r2 = r * r;
    float sp = fmaf(r2, 2.7557313707070068e-6f, -1.9841270114006046e-4f); sp = fmaf(sp, r2, 8.3333337680e-3f); sp = fmaf(sp, r2, -1.6666667163e-1f); sp = fmaf(sp * r2, r, r);
    float cp = fmaf(r2, 2.4801587e-5f, -1.3888889225e-3f); cp = fmaf(cp, r2, 4.1666667908e-2f); cp = fmaf(cp, r2, -0.5f); cp = fmaf(cp, r2, 1.0f);
    const int q = ((int)k) & 3;
    const float ss = (q & 1) ? cp : sp, cc = (q & 1) ? sp : cp;
    s = (q & 2) ? -ss : ss; c = ((q + 1) & 2) ? -cc : cc;
}

#define XB_TMO      128
#define XB_XCNT(j)  (256  + 64 * (j))
#define XB_XSUB(j)  (1280 + 64 * (j))
#define XB_XGEN(j)  (2304 + 64 * (j))
#define XB_TOP      3328
#define XB_TOPGEN   3392
#define XCD_BAR_WORDS 3456
#define XB_SPIN_CAP (1u << 20)
DI unsigned xb_ld(unsigned* p)              { return __hip_atomic_load(p, __ATOMIC_RELAXED, __HIP_MEMORY_SCOPE_AGENT); }
DI unsigned xb_add(unsigned* p, unsigned v) { return __hip_atomic_fetch_add(p, v, __ATOMIC_RELAXED, __HIP_MEMORY_SCOPE_AGENT); }
DI unsigned xb_xcc_id() { return (unsigned)__builtin_amdgcn_s_getreg((3 << 11) | 20) & 0xFu; }
#define XB_SPIN(cond, bar) do { unsigned _sp = 0; while (cond) { __builtin_amdgcn_s_sleep(1); \
    if ((++_sp & 255u) == 0u) { if (xb_ld(&(bar)[XB_TMO])) break; if (_sp > XB_SPIN_CAP) { atomicAdd(&(bar)[XB_TMO], 1u); break; } } } } while (0)
struct XcdBarrier { unsigned* bar; unsigned x; volatile LAS unsigned* st; };
DI XcdBarrier xcd_barrier_post(unsigned* bar, volatile LAS unsigned* st) {
    XcdBarrier b; b.bar = bar; b.x = xb_xcc_id(); b.st = st;
    if (threadIdx.x == 0) (void)xb_add(&bar[XB_XCNT(b.x)], 1u);
    return b;
}
DI void xcd_barrier_complete(unsigned* bar, unsigned x, unsigned& nloc, unsigned& nx) {
    const unsigned G = gridDim.x * gridDim.y * gridDim.z;
    unsigned sum, cnt, mine, sp = 0u;
    for (;;) {
        sum = 0u; cnt = 0u; mine = 0u;
#pragma unroll
        for (unsigned j = 0; j < 16; ++j) { const unsigned c = xb_ld(&bar[XB_XCNT(j)]); sum += c; cnt += (c > 0u) ? 1u : 0u; mine = (j == x) ? c : mine; }
        if (sum == G) break;
        __builtin_amdgcn_s_sleep(1);
        if ((++sp & 255u) == 0u) { if (xb_ld(&bar[XB_TMO])) break; if (sp > XB_SPIN_CAP) { atomicAdd(&bar[XB_TMO], 1u); break; } }
    }
    nloc = mine > 0u ? mine : 1u; nx = cnt > 0u ? cnt : 1u;
}
DI void xcd_barrier(const XcdBarrier& b) {
    asm volatile("s_waitcnt vmcnt(0)" ::: "memory");
    __syncthreads();
    if (threadIdx.x == 0) {
        unsigned* bar = b.bar;
        __builtin_amdgcn_s_waitcnt(0);
        unsigned nloc = b.st[0], nx = b.st[1];
        if (nloc == 0u) { xcd_barrier_complete(bar, b.x, nloc, nx); b.st[0] = nloc; b.st[1] = nx; }
        const unsigned old = xb_add(&bar[XB_XSUB(b.x)], 1u);
        const unsigned gen = old / nloc;
        if (old + 1u == (gen + 1u) * nloc) {
            __builtin_amdgcn_fence(__ATOMIC_RELEASE, "agent");
            asm volatile("s_waitcnt vmcnt(0)" ::: "memory");
            const unsigned og = xb_add(&bar[XB_TOP], 1u);
            const unsigned tg = og / nx;
            if (og + 1u == (tg + 1u) * nx) xb_add(&bar[XB_TOPGEN], 1u);
            else XB_SPIN(xb_ld(&bar[XB_TOPGEN]) == tg, bar);
            __builtin_amdgcn_fence(__ATOMIC_ACQUIRE, "agent");
            xb_add(&bar[XB_XGEN(b.x)], 1u);
            asm volatile("s_waitcnt vmcnt(0)" ::: "memory");
        } else {
            XB_SPIN(xb_ld(&bar[XB_XGEN(b.x)]) == gen, bar);
            __builtin_amdgcn_fence(__ATOMIC_ACQUIRE, "agent");
            asm volatile("s_waitcnt vmcnt(0)" ::: "memory");
        }
    }
    __syncthreads();
}

namespace pg8 {
constexpr int BM = 256, BK = 64, HALF = 128, HTB = HALF * BK * 2, STAGE_BYTES = 8 * HTB, NXCD = 8, WGM = 8;
__host__ __device__ __forceinline__ int lds_byte(int r, int c) { const int st = (r >> 4) * 2 + (c >> 5), rr = r & 15, cc = c & 31, ob = rr * 64 + cc * 2; return st * 1024 + (ob ^ (((ob >> 9) & 1) << 5)); }
__host__ __device__ __forceinline__ void stage_rc(int b, int& R, int& C) { const int st = b / 1024, sb = b % 1024, swz = sb ^ (((sb >> 9) & 1) << 5); R = (st >> 1) * 16 + swz / 64; C = (st & 1) * 32 + (swz % 64) / 2; }
__host__ __device__ __forceinline__ int perm32(int rho) { const int n = rho >> 4, i = rho & 15; return 8 * (i >> 2) + 4 * n + (i & 3); }

struct Unit { int pm, pn, e; const char* A; const char* B; };
DI unsigned cvt_pk_bf16(float lo, float hi) { unsigned r; asm volatile("v_cvt_pk_bf16_f32 %0, %1, %2" : "=v"(r) : "v"(lo), "v"(hi)); return r; }

DI int xcd_remap(int wgid, int nwg) { const int q = nwg / NXCD, r = nwg % NXCD, xcd = wgid % NXCD, off = wgid / NXCD; return (xcd < r ? xcd * (q + 1) : r * (q + 1) + (xcd - r) * q) + off; }

struct DenseSched {
    static constexpr bool GATHER = false;
    const char* A; const char* Bt; int K, nM, nN, nwg, G, c;
    DI void init(const void* A_, const void* Bt_, int M, int N, int K_, int G_, int c_) { A = (const char*)A_; Bt = (const char*)Bt_; K = K_; nM = M / BM; nN = N / BM; nwg = nM * nN; G = G_; c = c_; }
    DI bool next(int i, Unit& u) const {
        const long L = (long)i * G + c; if (L >= nwg) return false;
        const int wgid = xcd_remap((int)L, nwg);
        const int nig = WGM * nN, gid = wgid / nig, fm = gid * WGM, gsz = (nM - fm) < WGM ? (nM - fm) : WGM;
        u.pm = fm + ((wgid % nig) % gsz); u.pn = (wgid % nig) / gsz; u.e = 0;
        u.A = A + (size_t)u.pm * BM * K * 2; u.B = Bt + (size_t)u.pn * BM * K * 2; return true;
    }
    DI void aoffs(int, const Unit&, const int (&R)[2], const int (&C)[2], unsigned (&vo)[2][2]) const {
#pragma unroll
        for (int h = 0; h < 2; ++h)
#pragma unroll
            for (int p = 0; p < 2; ++p) vo[h][p] = (unsigned)((h * HALF + R[p]) * K + C[p]) * 2u;
    }
};
template <bool GATHER_, int NPN>
struct MoeSched {
    static constexpr bool GATHER = GATHER_;
    const char* A; const char* Bt; const LAS int* tb; const LAS unsigned* tab; int NT, G, c; size_t estride;
    DI bool next(int i, Unit& u) const {
        const int nwg = NT * NPN; const long L = (long)i * G + c; if (L >= nwg) return false;
        const int id = xcd_remap((int)L, nwg);
        const int rt = id / NPN, pn = id % NPN; int e = 0;
#pragma unroll
        for (int j = 1; j < 16; ++j) e += (tb[j] <= rt) ? 1 : 0;
        u.pm = rt; u.pn = pn; u.e = e;
        u.A = GATHER ? A : A + (size_t)rt * BM * 1024 * 2; u.B = Bt + (size_t)e * estride + (size_t)pn * BM * 1024 * 2; return true;
    }
    DI void aoffs(int i, const Unit&, const int (&R)[2], const int (&C)[2], unsigned (&vo)[2][2]) const {
#pragma unroll
        for (int h = 0; h < 2; ++h)
#pragma unroll
            for (int p = 0; p < 2; ++p) vo[h][p] = GATHER ? (tab[i * 256 + h * HALF + R[p]] + (unsigned)C[p] * 2u) : (unsigned)((h * HALF + R[p]) * 1024 + C[p]) * 2u;
    }
};

struct EpiBf16 {
    static constexpr bool PERM = true;
    bf16_t* O; int ldc; int split_cols; size_t split_stride;
    DI void operator()(const f32x4 (&acc)[2][2][4][2], const Unit& u, int wr, int wc, int fr, int fq) const {
        const int row0 = u.pm * BM + wr * 64 + fr; int colt = u.pn * BM; bf16_t* base = O;
        if (split_cols) { const int t = colt / split_cols; base += (size_t)t * split_stride; colt -= t * split_cols; }
        const int col0 = colt + wc * 32 + 8 * fq;
#pragma unroll
        for (int ai = 0; ai < 2; ++ai)
#pragma unroll
            for (int m = 0; m < 4; ++m) { bf16_t* rowp = base + (size_t)(row0 + ai * HALF + m * 16) * ldc + col0;
#pragma unroll
                for (int bj = 0; bj < 2; ++bj) { const f32x4 v0 = acc[ai][bj][m][0], v1 = acc[ai][bj][m][1];
                    u32x4 w; w.x = cvt_pk_bf16(v0[0], v0[1]); w.y = cvt_pk_bf16(v0[2], v0[3]); w.z = cvt_pk_bf16(v1[0], v1[1]); w.w = cvt_pk_bf16(v1[2], v1[3]);
                    *(u32x4*)(rowp + bj * HALF) = w; } }
    }
};
struct EpiF32 {
    static constexpr bool PERM = false;
    float* C; int ldc;
    DI void operator()(const f32x4 (&acc)[2][2][4][2], const Unit& u, int wr, int wc, int fr, int fq) const {
        const int row0 = u.pm * BM + wr * 64 + fr, col0 = u.pn * BM + wc * 32 + 4 * fq;
#pragma unroll
        for (int ai = 0; ai < 2; ++ai)
#pragma unroll
            for (int m = 0; m < 4; ++m) { float* rowp = C + (size_t)(row0 + ai * HALF + m * 16) * ldc + col0;
#pragma unroll
                for (int bj = 0; bj < 2; ++bj)
#pragma unroll
                    for (int n = 0; n < 2; ++n) *(f32x4*)(rowp + bj * HALF + n * 16) = acc[ai][bj][m][n]; }
    }
};
struct EpiResid {
    static constexpr bool PERM = false;
    float* X; const float* gate;
    DI void operator()(const f32x4 (&acc)[2][2][4][2], const Unit& u, int wr, int wc, int fr, int fq) const {
        const int row0 = u.pm * BM + wr * 64 + fr, col0 = u.pn * BM + wc * 32 + 4 * fq;
        const int r9 = (u.pm % 9 == 0) ? 8 : u.pm / 9; const float* g = gate + (size_t)r9 * 6144 + col0;
        f32x4 gv[2][2];
#pragma unroll
        for (int bj = 0; bj < 2; ++bj)
#pragma unroll
            for (int n = 0; n < 2; ++n) gv[bj][n] = *(const f32x4*)(g + bj * HALF + n * 16);
#pragma unroll
        for (int ai = 0; ai < 2; ++ai)
#pragma unroll
            for (int m = 0; m < 4; ++m) { float* rowp = X + (size_t)(row0 + ai * HALF + m * 16) * D + col0;
#pragma unroll
                for (int bj = 0; bj < 2; ++bj)
#pragma unroll
                    for (int n = 0; n < 2; ++n) { const f32x4 x = *(const f32x4*)(rowp + bj * HALF + n * 16); *(f32x4*)(rowp + bj * HALF + n * 16) = x * DN_ALPHA + gv[bj][n] * acc[ai][bj][m][n]; } }
    }
};
struct EpiGluResid {
    static constexpr bool PERM = false;
    float* X; const float* gate;
    DI void operator()(const f32x4 (&acc)[2][2][4][2], const Unit& u, int wr, int wc, int fr, int fq) const {
        const int row0 = u.pm * BM + wr * 64 + fr, col0 = u.pn * HALF + wc * 32 + 4 * fq;
        const int r9 = (u.pm % 9 == 0) ? 8 : u.pm / 9; const float* g = gate + (size_t)r9 * 6144 + col0;
        f32x4 gv[2];
#pragma unroll
        for (int n = 0; n < 2; ++n) gv[n] = *(const f32x4*)(g + n * 16);
#pragma unroll
        for (int ai = 0; ai < 2; ++ai)
#pragma unroll
            for (int m = 0; m < 4; ++m) { float* rowp = X + (size_t)(row0 + ai * HALF + m * 16) * D + col0;
#pragma unroll
                for (int n = 0; n < 2; ++n) { const f32x4 v = acc[ai][0][m][n], gg = acc[ai][1][m][n]; f32x4 o;
#pragma unroll
                    for (int j = 0; j < 4; ++j) o[j] = v[j] * sigmoidf_(gg[j]);
                    const f32x4 x = *(const f32x4*)(rowp + n * 16); *(f32x4*)(rowp + n * 16) = x * DN_ALPHA + gv[n] * o; } }
    }
};
struct EpiSwiGLU {
    static constexpr bool PERM = true;
    bf16_t* Hid;
    DI void operator()(const f32x4 (&acc)[2][2][4][2], const Unit& u, int wr, int wc, int fr, int fq) const {
        const int row0 = u.pm * BM + wr * 64 + fr, col0 = u.pn * HALF + wc * 32 + 8 * fq;
#pragma unroll
        for (int ai = 0; ai < 2; ++ai)
#pragma unroll
            for (int m = 0; m < 4; ++m) { bf16_t* rowp = Hid + (size_t)(row0 + ai * HALF + m * 16) * DEXP + col0;
                f32x4 h0, h1;
#pragma unroll
                for (int j = 0; j < 4; ++j) { const float g0 = acc[ai][0][m][0][j], g1 = acc[ai][0][m][1][j]; h0[j] = g0 * sigmoidf_(g0) * acc[ai][1][m][0][j]; h1[j] = g1 * sigmoidf_(g1) * acc[ai][1][m][1][j]; }
                u32x4 w; w.x = cvt_pk_bf16(h0[0], h0[1]); w.y = cvt_pk_bf16(h0[2], h0[3]); w.z = cvt_pk_bf16(h1[0], h1[1]); w.w = cvt_pk_bf16(h1[2], h1[3]);
                *(u32x4*)rowp = w; }
    }
};

template <class Epi, class Sched, bool ALIGN_EPI = true>
DI void gemm_phase(LAS unsigned char* lds, const int K, const Sched& S, const Epi& E) {
    const int tid = threadIdx.x, wid = __builtin_amdgcn_readfirstlane(tid >> 6), lane = tid & 63, wr = wid >> 2, wc = wid & 3, fr = lane & 15, fq = lane >> 4;
    const int nt = K / BK;
    int Rr[2], Cc[2]; unsigned voffB[2];
#pragma unroll
    for (int i = 0; i < 2; ++i) { int R, C; stage_rc(tid * 16 + i * 8192, R, C); Rr[i] = R; Cc[i] = C; const int Rb = Epi::PERM ? ((R & ~31) + perm32(R & 31)) : R; voffB[i] = (unsigned)(Rb * K + C) * 2u; }
    const size_t kstep = (size_t)(BK * 2);
    const size_t hstep = (size_t)HALF * K * 2;
    const unsigned ldsw = (unsigned)wid * 1024u;
    const int aoff = lds_byte(wr * 64 + fr, fq * 8), boff = lds_byte(wc * 32 + fr, fq * 8);
#define PG8_SA(b, h) (((b) * 2 + (h)) * HTB)
#define PG8_SB(b, h) ((4 + (b) * 2 + (h)) * HTB)
#define PG8_STAGE(bufoff, gbase, o0, o1) do { \
        __builtin_amdgcn_global_load_lds((const unsigned*)((const char*)(gbase) + (o0)), (LAS unsigned*)(lds + (bufoff) + ldsw), 16, 0, 0); \
        __builtin_amdgcn_global_load_lds((const unsigned*)((const char*)(gbase) + (o1)), (LAS unsigned*)(lds + (bufoff) + ldsw + 8192), 16, 0, 0); } while (0)
#define PG8_STAGEB(bufoff, gbase) PG8_STAGE(bufoff, gbase, voffB[0], voffB[1])
#define PG8_LDA(dst, b, h) do { _Pragma("unroll") for (int m = 0; m < 4; ++m) _Pragma("unroll") for (int k = 0; k < 2; ++k) dst[m][k] = *(const LAS bf16x8*)(lds + PG8_SA(b, h) + aoff + m * 2048 + k * 1024); } while (0)
#define PG8_LDB(dst, b, h) do { _Pragma("unroll") for (int n = 0; n < 2; ++n) _Pragma("unroll") for (int k = 0; k < 2; ++k) dst[n][k] = *(const LAS bf16x8*)(lds + PG8_SB(b, h) + boff + n * 2048 + k * 1024); } while (0)
#define PG8_MMA(ai, bj, At, Bt) do { __builtin_amdgcn_s_setprio(1); _Pragma("unroll") for (int m = 0; m < 4; ++m) _Pragma("unroll") for (int n = 0; n < 2; ++n) _Pragma("unroll") for (int k = 0; k < 2; ++k) \
        acc[ai][bj][m][n] = __builtin_amdgcn_mfma_f32_16x16x32_bf16(Bt[n][k], At[m][k], acc[ai][bj][m][n], 0, 0, 0); __builtin_amdgcn_s_setprio(0); } while (0)
#define PG8_WAIT_V(n) asm volatile("s_waitcnt vmcnt(" #n ")" ::: "memory")
#define PG8_WAIT_L(n) asm volatile("s_waitcnt lgkmcnt(" #n ")" ::: "memory")
#define PG8_BAR __builtin_amdgcn_s_barrier()
#define PG8_SCHED __builtin_amdgcn_sched_barrier(0)
    Unit cur, nxt; int ui = 0;
    if (!S.next(0, cur)) return;
    f32x4 acc[2][2][4][2];
#pragma unroll
    for (int a = 0; a < 2; ++a)
#pragma unroll
        for (int b = 0; b < 2; ++b)
#pragma unroll
            for (int m = 0; m < 4; ++m)
#pragma unroll
                for (int n = 0; n < 2; ++n) acc[a][b][m][n] = (f32x4){0.f, 0.f, 0.f, 0.f};
    bf16x8 At[4][2], B0[2][2], B1[2][2];
    unsigned voA[2][2], voN[2][2];
    S.aoffs(0, cur, Rr, Cc, voA);
#pragma unroll
    for (int h = 0; h < 2; ++h)
#pragma unroll
        for (int p = 0; p < 2; ++p) voN[h][p] = voA[h][p];
    const char* cA = cur.A; const char* cB = cur.B;
    PG8_STAGEB(PG8_SB(0, 0), cB); PG8_STAGEB(PG8_SB(0, 1), cB + hstep); PG8_STAGE(PG8_SA(0, 0), cA, voA[0][0], voA[0][1]); PG8_STAGE(PG8_SA(0, 1), cA, voA[1][0], voA[1][1]);
    if (wr == 1) PG8_BAR;
    PG8_WAIT_V(2); PG8_BAR;
    PG8_STAGEB(PG8_SB(1, 0), cB + kstep); PG8_STAGE(PG8_SA(1, 0), cA + kstep, voA[0][0], voA[0][1]); PG8_STAGEB(PG8_SB(1, 1), cB + hstep + kstep);
    PG8_WAIT_V(6); PG8_BAR;
    for (;;) {
        const bool has_next = S.next(ui + 1, nxt);
        const char* nA = has_next ? nxt.A : cA; const char* nB = has_next ? nxt.B : cB;
        for (int t = 0; t < nt; t += 2) {
            const bool last = (t == nt - 2);
            const char* a1 = cA + (size_t)(t + 1) * kstep;
            const char* a2 = last ? nA : cA + (size_t)(t + 2) * kstep; const char* b2 = last ? nB : cB + (size_t)(t + 2) * kstep;
            const char* a3 = a2 + kstep; const char* b3 = b2 + kstep;
            if (Sched::GATHER) { if (last && has_next) S.aoffs(ui + 1, nxt, Rr, Cc, voN); }
            unsigned s00 = voA[0][0], s01 = voA[0][1], s10 = voA[1][0], s11 = voA[1][1];
            if (Sched::GATHER) { if (last) { s00 = voN[0][0]; s01 = voN[0][1]; s10 = voN[1][0]; s11 = voN[1][1]; } }
            PG8_LDB(B0, 0, 0); PG8_LDB(B1, 0, 1); PG8_SCHED; PG8_LDA(At, 0, 0); PG8_STAGE(PG8_SA(1, 1), a1, voA[1][0], voA[1][1]);
            PG8_WAIT_V(8); PG8_WAIT_L(0); PG8_BAR; PG8_MMA(0, 0, At, B0); PG8_MMA(0, 1, At, B1); PG8_BAR; PG8_SCHED;
            PG8_LDA(At, 0, 1); PG8_STAGEB(PG8_SB(0, 0), b2); PG8_STAGEB(PG8_SB(0, 1), b2 + hstep); PG8_STAGE(PG8_SA(0, 0), a2, s00, s01);
            PG8_WAIT_V(8); PG8_WAIT_L(0); PG8_BAR; PG8_MMA(1, 0, At, B0); PG8_MMA(1, 1, At, B1); PG8_BAR; PG8_SCHED;
            PG8_LDB(B0, 1, 0); PG8_LDB(B1, 1, 1); PG8_SCHED; PG8_LDA(At, 1, 0); PG8_STAGE(PG8_SA(0, 1), a2, s10, s11);
            PG8_WAIT_V(8); PG8_WAIT_L(0); PG8_BAR; PG8_MMA(0, 0, At, B0); PG8_MMA(0, 1, At, B1); PG8_BAR; PG8_SCHED;
            PG8_LDA(At, 1, 1); PG8_STAGEB(PG8_SB(1, 0), b3); PG8_STAGEB(PG8_SB(1, 1), b3 + hstep); PG8_STAGE(PG8_SA(1, 0), a3, s00, s01);
            PG8_WAIT_V(8); PG8_WAIT_L(0); PG8_BAR; PG8_MMA(1, 0, At, B0); PG8_MMA(1, 1, At, B1); PG8_BAR; PG8_SCHED;
        }
        if constexpr (ALIGN_EPI) { if (wr == 0) PG8_BAR; }
        E(acc, cur, wr, wc, fr, fq);
        if (!has_next) break;
#pragma unroll
        for (int a = 0; a < 2; ++a)
#pragma unroll
            for (int b = 0; b < 2; ++b)
#pragma unroll
                for (int m = 0; m < 4; ++m)
#pragma unroll
                    for (int n = 0; n < 2; ++n) acc[a][b][m][n] = (f32x4){0.f, 0.f, 0.f, 0.f};
        cur = nxt; cA = nA; cB = nB; ++ui;
        if (Sched::GATHER) {
#pragma unroll
            for (int h = 0; h < 2; ++h)
#pragma unroll
                for (int p = 0; p < 2; ++p) voA[h][p] = voN[h][p];
        }
        if constexpr (ALIGN_EPI) { if (wr == 1) PG8_BAR; }
    }
    PG8_WAIT_V(0);
    if constexpr (!ALIGN_EPI) { if (wr == 0) PG8_BAR; }
    PG8_BAR;
#undef PG8_SA
#undef PG8_SB
#undef PG8_STAGE
#undef PG8_STAGEB
#undef PG8_LDA
#undef PG8_LDB
#undef PG8_MMA
#undef PG8_WAIT_V
#undef PG8_WAIT_L
#undef PG8_BAR
#undef PG8_SCHED
}
}

namespace att {
constexpr int KVBLK = 64;
constexpr float SCALE = 0.125f;
constexpr float THR = 8.f;
constexpr int SHM_V = KVBLK * 128 * 2, SHM_K = KVBLK * 128 * 2;
constexpr int ATT_LDS = 2 * SHM_V + 2 * SHM_K + 8 * 64 * 4;
#define KSWZ(row, colB) ((row) * 256 + ((colB) ^ (((row) & 7) << 4)))
#define SBAR() __builtin_amdgcn_sched_barrier(0)
DI int crow(int r, int hi) { return (r & 3) + 8 * (r >> 2) + 4 * hi; }
DI unsigned cvtpk(float lo, float hi) { unsigned r; asm volatile("v_cvt_pk_bf16_f32 %0, %1, %2" : "=v"(r) : "v"(lo), "v"(hi)); return r; }
DI void partialSM(f32x16& p0, f32x16& p1, float& m_reg, float& mn, float& alpha) {
  constexpr float C = SCALE * 1.4426950408889634f;
  float pmax = p0[0];
#pragma unroll
  for (int r = 1; r < 16; ++r) pmax = fmaxf(pmax, p0[r]);
#pragma unroll
  for (int r = 0; r < 16; ++r) pmax = fmaxf(pmax, p1[r]);
  { auto rr = __builtin_amdgcn_permlane32_swap(__float_as_uint(pmax), __float_as_uint(pmax), false, false);
    pmax = fmaxf(__uint_as_float(rr[0]), __uint_as_float(rr[1])); }
  if (__builtin_expect(__all(pmax - m_reg <= THR / SCALE), 1)) { mn = m_reg; alpha = 1.f; }
  else { mn = fmaxf(m_reg, pmax); alpha = __builtin_amdgcn_exp2f((m_reg - mn) * C); m_reg = mn; }
  float mnC = -mn * C;
#pragma unroll
  for (int r = 0; r < 16; ++r) p0[r] = fmaf(p0[r], C, mnC);
#pragma unroll
  for (int r = 0; r < 16; ++r) p1[r] = fmaf(p1[r], C, mnC);
#pragma unroll
  for (int r = 0; r < 16; ++r) p0[r] = __builtin_amdgcn_exp2f(p0[r]);
}
DI void finishSM(f32x16& p0, f32x16& p1, float alpha, float& l_reg, bf16x8& pa0, bf16x8& pa1, bf16x8& pa2, bf16x8& pa3) {
#pragma unroll
  for (int r = 0; r < 16; ++r) p1[r] = __builtin_amdgcn_exp2f(p1[r]);
  float ps = 0;
#pragma unroll
  for (int r = 0; r < 16; ++r) ps += p0[r];
#pragma unroll
  for (int r = 0; r < 16; ++r) ps += p1[r];
  { auto rr = __builtin_amdgcn_permlane32_swap(__float_as_uint(ps), __float_as_uint(ps), false, false);
    ps = __uint_as_float(rr[0]) + __uint_as_float(rr[1]); }
  l_reg = l_reg * alpha + ps;
#define PK4(P, BASE, OUT) do { unsigned a0 = cvtpk(P[BASE + 0], P[BASE + 1]), a1 = cvtpk(P[BASE + 2], P[BASE + 3]);   \
    unsigned b0 = cvtpk(P[BASE + 4], P[BASE + 5]), b1 = cvtpk(P[BASE + 6], P[BASE + 7]);                              \
    auto r0 = __builtin_amdgcn_permlane32_swap(a0, b0, false, false); auto r1 = __builtin_amdgcn_permlane32_swap(a1, b1, false, false); \
    u32x4 w = {r0[0], r1[0], r0[1], r1[1]}; OUT = __builtin_bit_cast(bf16x8, w); } while (0)
  PK4(p0, 0, pa0); PK4(p0, 8, pa1); PK4(p1, 0, pa2); PK4(p1, 8, pa3);
#undef PK4
}
DI void qkt(f32x16& p0, f32x16& p1, const LAS char* Ks, const bf16x8* qr, int r32, int hi, int mo) {
  p0 = f32x16{}; p1 = f32x16{};
#pragma unroll
  for (int d0 = 0; d0 < 4; ++d0) { const int cb = mo + (d0 * 16 + hi * 8) * 2;
    bf16x8 b0 = *(const LAS bf16x8*)(Ks + KSWZ(r32, cb));
    bf16x8 b1 = *(const LAS bf16x8*)(Ks + KSWZ(32 + r32, cb));
    p0 = __builtin_amdgcn_mfma_f32_32x32x16_bf16(b0, qr[d0], p0, 0, 0, 0);
    p1 = __builtin_amdgcn_mfma_f32_32x32x16_bf16(b1, qr[d0], p1, 0, 0, 0); }
}
DI int v_st(int k, int c) { const int kk = (k & ~0xC) | ((k & 4) << 1) | ((k & 8) >> 1); return ((kk >> 3) * 4 + (c >> 5)) * 512 + ((kk & 7) * 32 + (c & 31)) * 2; }
DI int v_rd_base(int lane) { return ((lane & 3) << 3) | (((lane >> 2) & 3) << 6) | (((lane >> 4) & 1) << 5) | (((lane >> 5) & 1) << 8); }
constexpr int v_rd_off(int d0, int ks, int half) { return d0 * 512 + ks * 4096 + half * 2048; }
template <int OFF> DI s16x4 tr_read(int vb) { s16x4 r; asm volatile("ds_read_b64_tr_b16 %0, %1 offset:%2" : "=&v"(r) : "v"(vb), "i"(OFF) : "memory"); return r; }
template <int D0> DI void pv_one(f32x16& od, int vb, bf16x8 pa0, bf16x8 pa1, bf16x8 pa2, bf16x8 pa3) {
  const s16x4 l0 = tr_read<v_rd_off(D0, 0, 0)>(vb), h0 = tr_read<v_rd_off(D0, 0, 1)>(vb), l1 = tr_read<v_rd_off(D0, 1, 0)>(vb), h1 = tr_read<v_rd_off(D0, 1, 1)>(vb);
  const s16x4 l2 = tr_read<v_rd_off(D0, 2, 0)>(vb), h2 = tr_read<v_rd_off(D0, 2, 1)>(vb), l3 = tr_read<v_rd_off(D0, 3, 0)>(vb), h3 = tr_read<v_rd_off(D0, 3, 1)>(vb);
  asm volatile("s_waitcnt lgkmcnt(0)" ::: "memory"); SBAR();
#define PK(L, H) (bf16x8){L[0], L[1], L[2], L[3], H[0], H[1], H[2], H[3]}
  od = __builtin_amdgcn_mfma_f32_32x32x16_bf16(pa0, PK(l0, h0), od, 0, 0, 0);
  od = __builtin_amdgcn_mfma_f32_32x32x16_bf16(pa1, PK(l1, h1), od, 0, 0, 0);
  od = __builtin_amdgcn_mfma_f32_32x32x16_bf16(pa2, PK(l2, h2), od, 0, 0, 0);
  od = __builtin_amdgcn_mfma_f32_32x32x16_bf16(pa3, PK(l3, h3), od, 0, 0, 0);
#undef PK
}
DI void pv_d0(f32x16* o, int vb, bf16x8 pa0, bf16x8 pa1, bf16x8 pa2, bf16x8 pa3) {
  pv_one<0>(o[0], vb, pa0, pa1, pa2, pa3); pv_one<1>(o[1], vb, pa0, pa1, pa2, pa3); pv_one<2>(o[2], vb, pa0, pa1, pa2, pa3); pv_one<3>(o[3], vb, pa0, pa1, pa2, pa3);
}
DI void attn_unit(const bf16_t* Qb, const bf16_t* Kb, const bf16_t* Vb, bf16_t* Ob, int h, int seq, float lam, float osc, const float* subg, LAS char* lds) {
  const int tid = threadIdx.x, wid = __builtin_amdgcn_readfirstlane(tid >> 6), lane = tid & 63, r32 = lane & 31, hi = lane >> 5;
  const int mbr = wid >> 2, wq = wid & 3, mo = mbr * 128;
  LAS char* V_lds = lds; LAS char* K_lds = lds + 2 * SHM_V;
  LAS float* wsl = (LAS float*)(lds + 2 * SHM_V + 2 * SHM_K) + wid * 64; LAS float* li_l = wsl; LAS float* al_l = wsl + 32;
  float m_reg = -1e30f, l_reg = 0; f32x16 o[4] = {}; bf16x8 qr[4];
  const bf16_t* Qw = Qb + (size_t)(wq * 32 + r32) * 1024 + mbr * 512 + h * 64 + hi * 8;
#pragma unroll
  for (int d0 = 0; d0 < 4; ++d0) qr[d0] = *(const bf16x8*)(Qw + d0 * 16);
  const int sr = tid >> 4, sc = (tid & 15) * 8, vst0 = v_st(sr, sc), vst1 = v_st(32 + sr, sc);
  const int kcol = (sc >> 6) * 512 + h * 64 + (sc & 63), vcol = h * 128 + sc;
  const int vb0 = (int)(uintptr_t)V_lds + v_rd_base(lane);
  bf16x8 vsA0, vsA1, ksA0, ksA1, vsB0, vsB1, ksB0, ksB1;
#define SLOADA(k0) do { vsA0 = *(const bf16x8*)(Vb + (size_t)((k0) + sr) * 1024 + vcol); vsA1 = *(const bf16x8*)(Vb + (size_t)((k0) + 32 + sr) * 1024 + vcol); \
    ksA0 = *(const bf16x8*)(Kb + (size_t)((k0) + sr) * 1024 + kcol); ksA1 = *(const bf16x8*)(Kb + (size_t)((k0) + 32 + sr) * 1024 + kcol); } while (0)
#define SLOADB(k0) do { vsB0 = *(const bf16x8*)(Vb + (size_t)((k0) + sr) * 1024 + vcol); vsB1 = *(const bf16x8*)(Vb + (size_t)((k0) + 32 + sr) * 1024 + vcol); \
    ksB0 = *(const bf16x8*)(Kb + (size_t)((k0) + sr) * 1024 + kcol); ksB1 = *(const bf16x8*)(Kb + (size_t)((k0) + 32 + sr) * 1024 + kcol); } while (0)
#define SWRITE(b, v0, v1, k0_, k1_) do { *(LAS bf16x8*)(V_lds + (b) * SHM_V + vst0) = v0; *(LAS bf16x8*)(V_lds + (b) * SHM_V + vst1) = v1; const int kc = sc * 2; \
    *(LAS bf16x8*)(K_lds + (b) * SHM_K + KSWZ(sr, kc)) = k0_; *(LAS bf16x8*)(K_lds + (b) * SHM_K + KSWZ(32 + sr, kc)) = k1_; } while (0)
#define SWAIT() asm volatile("s_waitcnt vmcnt(4)" ::: "memory")
#define RESC(a) do { if (__any((a) < 1.f)) { if (hi == 0) al_l[r32] = (a); asm volatile("s_waitcnt lgkmcnt(0)" ::: "memory"); \
    _Pragma("unroll") for (int d = 0; d < 4; ++d) _Pragma("unroll") for (int r = 0; r < 16; ++r) o[d][r] *= al_l[crow(r, hi)]; } } while (0)
  f32x16 pA0, pA1, pB0, pB1; float mnA, mnB, alA, alB; bf16x8 pa0, pa1, pa2, pa3; const int NT = seq / KVBLK;
  SLOADA(0); asm volatile("s_waitcnt vmcnt(0)" ::: "memory"); SWRITE(0, vsA0, vsA1, ksA0, ksA1); __syncthreads();
  qkt(pA0, pA1, K_lds, qr, r32, hi, mo); partialSM(pA0, pA1, m_reg, mnA, alA);
  SLOADB(KVBLK); if (2 < NT) SLOADA(2 * KVBLK);
  SWAIT(); SWRITE(1, vsB0, vsB1, ksB0, ksB1); __syncthreads();
  for (int j = 1; j + 1 < NT; j += 2) {
    SBAR(); qkt(pB0, pB1, K_lds + SHM_K, qr, r32, hi, mo);
    finishSM(pA0, pA1, alA, l_reg, pa0, pa1, pa2, pa3); SBAR();
    SLOADB((j + 2) * KVBLK); SBAR();
    pv_d0(o, vb0, pa0, pa1, pa2, pa3); partialSM(pB0, pB1, m_reg, mnB, alB);
    __syncthreads(); SWAIT(); SWRITE(0, vsA0, vsA1, ksA0, ksA1);
    RESC(alB); __syncthreads();
    SBAR(); qkt(pA0, pA1, K_lds, qr, r32, hi, mo);
    finishSM(pB0, pB1, alB, l_reg, pa0, pa1, pa2, pa3); SBAR();
    if (j + 3 < NT) SLOADA((j + 3) * KVBLK); SBAR();
    pv_d0(o, vb0 + SHM_V, pa0, pa1, pa2, pa3); partialSM(pA0, pA1, m_reg, mnA, alA);
    __syncthreads(); SWAIT(); SWRITE(1, vsB0, vsB1, ksB0, ksB1);
    RESC(alA); __syncthreads();
  }
  SBAR(); qkt(pB0, pB1, K_lds + SHM_K, qr, r32, hi, mo);
  finishSM(pA0, pA1, alA, l_reg, pa0, pa1, pa2, pa3); SBAR();
  pv_d0(o, vb0, pa0, pa1, pa2, pa3); partialSM(pB0, pB1, m_reg, mnB, alB);
  __syncthreads(); RESC(alB);
  finishSM(pB0, pB1, alB, l_reg, pa0, pa1, pa2, pa3); SBAR();
  pv_d0(o, vb0 + SHM_V, pa0, pa1, pa2, pa3);
  if (hi == 0) li_l[r32] = l_reg; asm volatile("s_waitcnt lgkmcnt(0)" ::: "memory");
  float rli[16];
#pragma unroll
  for (int r = 0; r < 16; ++r) rli[r] = 1.0f / li_l[crow(r, hi)];
  asm volatile("s_waitcnt vmcnt(0)" ::: "memory");
  __syncthreads();
  LAS float* ex = (LAS float*)lds;
  if (mbr == 1) {
#pragma unroll
    for (int r = 0; r < 16; ++r)
#pragma unroll
      for (int d0 = 0; d0 < 4; ++d0) ex[((wq * 16 + r) * 4 + d0) * 64 + lane] = o[d0][r] * rli[r] * lam;
  }
  asm volatile("s_waitcnt lgkmcnt(0)" ::: "memory");
  __syncthreads();
  if (mbr == 0) {
    float g[4];
#pragma unroll
    for (int d0 = 0; d0 < 4; ++d0) g[d0] = subg[d0 * 32 + r32] * osc;
    bf16_t* Ow = Ob + (size_t)(wq * 32) * 1024 + h * 128;
#pragma unroll
    for (int r = 0; r < 16; ++r) {
      float v[4]; float ss = 0.f;
#pragma unroll
      for (int d0 = 0; d0 < 4; ++d0) { v[d0] = o[d0][r] * rli[r] - ex[((wq * 16 + r) * 4 + d0) * 64 + lane]; ss += v[d0] * v[d0]; }
#pragma unroll
      for (int of = 1; of < 32; of <<= 1) ss += __shfl_xor(ss, of);
      const float rs = 1.0f / sqrtf(ss * (1.0f / 128.0f) + LN_EPS);
      const int orow = crow(r, hi);
#pragma unroll
      for (int d0 = 0; d0 < 4; ++d0) Ow[(size_t)orow * 1024 + d0 * 32 + r32] = (bf16_t)f2bf(v[d0] * rs * g[d0]);
    }
  }
  asm volatile("s_waitcnt lgkmcnt(0)" ::: "memory");
  __syncthreads();
#undef SLOADA
#undef SLOADB
#undef SWRITE
#undef SWAIT
#undef RESC
}
}

struct Args { const float* in[37]; float* out; unsigned char* ws; int ph_lo, ph_hi; };
struct Frame { LAS unsigned char* lds; int tid, lane, wave, G, bid, gw, NGW; };
enum { I_X = 0, I_C, I_CTX, I_CCTX, I_WADA, I_BADA, I_LNG, I_LNB, I_AWIN, I_AWOUT, I_ALAM, I_ASUB, I_S5WIN, I_S5ARE, I_S5AIM, I_S5BRE, I_S5BIM, I_S5CRE, I_S5CIM, I_S5LDT, I_S5D, I_S5GV, I_S5GG,
       I_LWIN, I_LCW, I_LCB, I_LWA, I_LBA, I_LWX, I_LBX, I_LLAM, I_LWOUT, I_RW, I_RB, I_MG, I_MU, I_MD };

DI void transpose_tile(const float* W, int ldw, int k0, int n0, bf16_t* WT, int ldt, int drow0, LAS float* scr, int lane) {
#pragma unroll 8
    for (int i = 0; i < 32; ++i) { const int kk = 2 * i + (lane >> 5); scr[kk * 33 + (lane & 31)] = W[(size_t)(k0 + kk) * ldw + n0 + (lane & 31)]; }
    LDS_WAIT(); asm volatile("" ::: "memory");
    const int c = lane & 7;
#pragma unroll
    for (int j = 0; j < 4; ++j) { const int n = (lane >> 3) + 8 * j; const LAS float* s = scr + (8 * c) * 33 + n;
        u32x4 o; o.x = pk2(s[0 * 33], s[1 * 33]); o.y = pk2(s[2 * 33], s[3 * 33]); o.z = pk2(s[4 * 33], s[5 * 33]); o.w = pk2(s[6 * 33], s[7 * 33]);
        *(u32x4*)(WT + (size_t)(drow0 + n) * ldt + k0 + 8 * c) = o; }
    LDS_WAIT(); asm volatile("" ::: "memory");
}
DI void transpose_item(const float* W, int K, int N, bf16_t* WT, int item, int drow_base, LAS float* scr, int lane) {
    const int nblk = N / 32, kb = item / nblk, nb = item % nblk;
    transpose_tile(W, N, 64 * kb, 32 * nb, WT, K, drow_base + 32 * nb, scr, lane);
}
DI void convert_moe_weights(const Args& a, const Frame& F, int li) {
    LAS float* scr = (LAS float*)(F.lds + F.wave * 16384);
    bf16_t* WGU = (bf16_t*)(a.ws + WS_WGU); bf16_t* WD = (bf16_t*)(a.ws + WS_WD);
    constexpr int PER = 16 * 32;
    for (int it = F.gw; it < 3 * 16 * PER; it += F.NGW) {
        const int which = it / (16 * PER), r = it % (16 * PER), e = r / PER, item = r % PER, kb = item / 32, nb = item % 32, n0 = 32 * nb;
        const size_t moff = ((size_t)(li * 16 + e)) * 1024 * 1024;
        if (which == 0)      transpose_tile(a.in[I_MG] + moff, 1024, 64 * kb, n0, WGU, 1024, e * 2048 + (n0 >> 7) * 256 + (n0 & 127), scr, F.lane);
        else if (which == 1) transpose_tile(a.in[I_MU] + moff, 1024, 64 * kb, n0, WGU, 1024, e * 2048 + (n0 >> 7) * 256 + 128 + (n0 & 127), scr, F.lane);
        else                 transpose_tile(a.in[I_MD] + moff, 1024, 64 * kb, n0, WD, 1024, e * 1024 + n0, scr, F.lane);
    }
}

DI void p0_prologue(const Args& a, const Frame& F) {
    LAS float* scr = (LAS float*)(F.lds + F.wave * 16384);
    unsigned char* ws = a.ws;
    {
        constexpr int I_AIN = 16 * 96, I_AOUT = 16 * 32, I_S5 = 16 * 32, I_LIN = 16 * 88, I_LOUT = 22 * 32;
        constexpr int NIT = 2 * I_AIN + 2 * I_AOUT + 3 * I_S5 + I_LIN + I_LOUT;
        for (int it = F.gw; it < NIT; it += F.NGW) {
            int r = it;
            if (r < 2 * I_AIN) { const int s = r / I_AIN; transpose_item(a.in[I_AWIN] + (size_t)s * 1024 * 3072, 1024, 3072, (bf16_t*)(ws + WS_WATT_IN) + (size_t)s * 3072 * 1024, r % I_AIN, 0, scr, F.lane); continue; } r -= 2 * I_AIN;
            if (r < 2 * I_AOUT) { const int s = r / I_AOUT; transpose_item(a.in[I_AWOUT] + (size_t)s * 1024 * 1024, 1024, 1024, (bf16_t*)(ws + WS_WATT_OUT) + (size_t)s * 1024 * 1024, r % I_AOUT, 0, scr, F.lane); continue; } r -= 2 * I_AOUT;
            if (r < I_S5) { transpose_item(a.in[I_S5WIN], 1024, 1024, (bf16_t*)(ws + WS_WS5_IN), r, 0, scr, F.lane); continue; } r -= I_S5;
            if (r < 2 * I_S5) { const int which = r / I_S5, item = r % I_S5, kb = item / 32, nb = item % 32, n0 = 32 * nb;
                transpose_tile(a.in[which ? I_S5GG : I_S5GV], 1024, 64 * kb, n0, (bf16_t*)(ws + WS_WS5_GLU), 1024, (n0 >> 7) * 256 + which * 128 + (n0 & 127), scr, F.lane); continue; } r -= 2 * I_S5;
            if (r < I_LIN) { transpose_item(a.in[I_LWIN], 1024, 2816, (bf16_t*)(ws + WS_WLRU_IN), r, 0, scr, F.lane); continue; } r -= I_LIN;
            transpose_item(a.in[I_LWOUT], 1408, 1024, (bf16_t*)(ws + WS_WLRU_OUT), r, 0, scr, F.lane);
        }
    }
    __syncthreads();
    if (F.bid < 192) {
        LAS float* sl = (LAS float*)F.lds;
        for (int i = F.tid; i < 9 * 1024; i += 512) { const int r = i >> 10, k = i & 1023; const float v = (r < 8) ? a.in[I_C][r * 1024 + k] : a.in[I_CCTX][k]; sl[i] = v / (1.0f + __expf(-v)); }
        __syncthreads();
        const int ks = F.gw / 96, cg = F.gw % 96, col4 = cg * 64 + F.lane, layer = col4 / 1536, c4 = (col4 % 1536) * 4;
        f32x4 acc[9];
#pragma unroll
        for (int r = 0; r < 9; ++r) acc[r] = (f32x4){0.f, 0.f, 0.f, 0.f};
        const float* wp = a.in[I_WADA] + (size_t)layer * 1024 * 6144 + (size_t)(ks * 64) * 6144 + c4;
#pragma unroll 4
        for (int k = 0; k < 64; ++k) { const f32x4 w = *(const f32x4*)(wp + (size_t)k * 6144);
#pragma unroll
            for (int r = 0; r < 9; ++r) { const float s = sl[r * 1024 + ks * 64 + k]; acc[r] += w * s; } }
        float* mp = (float*)(ws + WS_MODP) + ((size_t)(ks * 4 + layer) * 9) * 6144 + c4;
#pragma unroll
        for (int r = 0; r < 9; ++r) *(f32x4*)(mp + (size_t)r * 6144) = acc[r];
        __syncthreads();
    }
    const int gt = F.bid * 512 + F.tid, NGT = F.G * 512;
    for (int t = gt; t < 8192; t += NGT) {
        const int p = t & 63;
        const float dt = expf(a.in[I_S5LDT][t >> 6]);
        const float Ar = a.in[I_S5ARE][t], Ai = a.in[I_S5AIM][t];
        const float mag = expf(Ar * dt); float sn, cs; sincos_cw(Ai * dt, sn, cs);
        const float zr = mag * cs, zi = mag * sn, den = Ar * Ar + Ai * Ai;
        const float kr = ((zr - 1.0f) * Ar + zi * Ai) / den, ki = (zi * Ar - (zr - 1.0f) * Ai) / den;
        ((float*)(ws + WS_PAR + PAR_ZR))[t] = zr; ((float*)(ws + WS_PAR + PAR_ZI))[t] = zi;
#pragma unroll
        for (int n = 0; n < 16; ++n) { const float br = a.in[I_S5BRE][(size_t)t * 16 + n], bi = a.in[I_S5BIM][(size_t)t * 16 + n];
            ((float*)(ws + WS_PAR + PAR_BBR))[(size_t)t * 16 + n] = kr * br - ki * bi; ((float*)(ws + WS_PAR + PAR_BBI))[(size_t)t * 16 + n] = kr * bi + ki * br; }
        (void)p;
    }
    for (int t = gt; t < 1024; t += NGT) {
        const int pos = t >> 4, j = t & 15; const float freq = exp2f(-(float)j * (13.287712379549449f / 16.0f)); float sn, cs; sincos_cw((float)pos * freq, sn, cs);
        ((f32x2*)(ws + WS_PAR + PAR_ROPE))[t] = (f32x2){cs, sn};
    }
    for (int t = gt; t < 2 * LRUW; t += NGT) ((float*)(ws + WS_PAR + PAR_SP))[t] = log1pf(expf(-a.in[I_LLAM][t]));
    for (int t = gt; t < 2 * 2 * 16 * 96 * 96; t += NGT) {
        const int d = t % 96, e = (t / 96) % 96, n = (t / 9216) % 16, mat = (t / (9216 * 16)) % 2, dir = t / (9216 * 32);
        float v = 0.f; if (d < 88 && e < 88) v = a.in[mat ? I_LWX : I_LWA][(((size_t)dir * 16 + n) * 88 + d) * 88 + e];
        ((bf16_t*)(ws + WS_BD))[t] = (bf16_t)f2bf(v);
    }
}
DI void p0b_modreduce(const Args& a, const Frame& F) {
    const int gt = F.bid * 512 + F.tid, NGT = F.G * 512;
    for (int t = gt; t < 4 * 9 * 1536; t += NGT) {
        const int c4 = (t % 1536) * 4, lr = t / 1536, layer = lr / 9;
        f32x4 s = *(const f32x4*)(a.in[I_BADA] + (size_t)layer * 6144 + c4);
#pragma unroll
        for (int ks = 0; ks < 16; ++ks) s += *(const f32x4*)((const float*)(a.ws + WS_MODP) + ((size_t)ks * 36 + lr) * 6144 + c4);
        *(f32x4*)((float*)(a.ws + WS_MOD) + (size_t)lr * 6144 + c4) = s;
    }
}
DI const float* mod_row(const Args& a, int li, int row) { const int p = row % LSEQ, b = row / LSEQ; return (const float*)(a.ws + WS_MOD) + (size_t)(li * 9 + (p < CN ? 8 : b)) * 6144; }
DI void store_h(bf16_t* hrow, int lane, const f32x4 (&v)[4]) {
#pragma unroll
    for (int j = 0; j < 4; ++j) { u32x2 w; w.x = pk2(v[j][0], v[j][1]); w.y = pk2(v[j][2], v[j][3]); *(u32x2*)(hrow + 4 * lane + 256 * j) = w; }
}
DI void p1_init(const Args& a, const Frame& F) {
    float* X = (float*)(a.ws + WS_X); bf16_t* H = (bf16_t*)(a.ws + WS_H);
    for (int row = F.gw; row < MROWS; row += F.NGW) {
        const int b = row / LSEQ, p = row % LSEQ;
        const float* src = (p < CN) ? a.in[I_CTX] + ((size_t)b * CN + p) * D : a.in[I_X] + ((size_t)b * TL + (p - CN)) * D;
        const float* mr = mod_row(a, 0, row);
        f32x4 v[4], h[4];
#pragma unroll
        for (int j = 0; j < 4; ++j) { const int c = 4 * F.lane + 256 * j; v[j] = *(const f32x4*)(src + c); const f32x4 sh = *(const f32x4*)(mr + c), sc = *(const f32x4*)(mr + 1024 + c);
            h[j] = v[j] * (sc + 1.0f) + sh; *(f32x4*)(X + (size_t)row * D + c) = v[j]; }
        store_h(H + (size_t)row * D, F.lane, h);
    }
}
DI void ln_row(f32x4 (&v)[4], const float* g, const float* bta, int lane) {
    float s = 0.f;
#pragma unroll
    for (int j = 0; j < 4; ++j) s += (v[j][0] + v[j][1]) + (v[j][2] + v[j][3]);
    const float mean = wave_sum(s) * (1.0f / D); float q = 0.f;
#pragma unroll
    for (int j = 0; j < 4; ++j) { v[j] = v[j] - mean; q += (v[j][0] * v[j][0] + v[j][1] * v[j][1]) + (v[j][2] * v[j][2] + v[j][3] * v[j][3]); }
    const float rstd = 1.0f / sqrtf(wave_sum(q) * (1.0f / D) + LN_EPS);
#pragma unroll
    for (int j = 0; j < 4; ++j) { const int c = 4 * lane + 256 * j; v[j] = v[j] * rstd * *(const f32x4*)(g + c) + *(const f32x4*)(bta + c); }
}

DI void m0_route(const Args& a, const Frame& F, int li) {
    convert_moe_weights(a, F, li);
    __syncthreads();
    LAS float* rw = (LAS float*)F.lds;
    LAS int* lcnt = (LAS int*)(F.lds + 65536);
    LAS int* rinfo = (LAS int*)(F.lds + 65536 + 256);
    LAS float* rwt = (LAS float*)(F.lds + 65536 + 256 + 8 * 9 * 16);
    for (int i = F.tid; i < 16 * 1024; i += 512) { const int k = i >> 4, e = i & 15; rw[e * 1024 + k] = a.in[I_RW][i]; }
    if (F.tid < 32) lcnt[F.tid] = 0;
    __syncthreads();
    float* X = (float*)(a.ws + WS_X); bf16_t* H = (bf16_t*)(a.ws + WS_H);
    const float* lg = a.in[I_LNG] + (size_t)(li * 2 + 0) * D; const float* lb = a.in[I_LNB] + (size_t)(li * 2 + 0) * D;
    int nrows = 0;
    for (int row = F.gw; row < MROWS; row += F.NGW, ++nrows) {
        const float* mr = mod_row(a, li, row);
        f32x4 v[4], h[4];
#pragma unroll
        for (int j = 0; j < 4; ++j) v[j] = *(const f32x4*)(X + (size_t)row * D + 4 * F.lane + 256 * j);
        ln_row(v, lg, lb, F.lane);
#pragma unroll
        for (int j = 0; j < 4; ++j) { const int c = 4 * F.lane + 256 * j; *(f32x4*)(X + (size_t)row * D + c) = v[j]; const f32x4 sh = *(const f32x4*)(mr + 3072 + c), sc = *(const f32x4*)(mr + 4096 + c); h[j] = v[j] * (sc + 1.0f) + sh; }
        store_h(H + (size_t)row * D, F.lane, h);
        float lg16[16];
#pragma unroll
        for (int e = 0; e < 16; ++e) { float s = 0.f;
#pragma unroll
            for (int j = 0; j < 4; ++j) { const f32x4 w = *(const LAS f32x4*)(rw + e * 1024 + 4 * F.lane + 256 * j); s += (h[j][0] * w[0] + h[j][1] * w[1]) + (h[j][2] * w[2] + h[j][3] * w[3]); }
            lg16[e] = wave_sum(s); }
        float mx = lg16[0];
#pragma unroll
        for (int e = 1; e < 16; ++e) mx = fmaxf(mx, lg16[e]);
        float pr[16], sum = 0.f;
#pragma unroll
        for (int e = 0; e < 16; ++e) { pr[e] = expf(lg16[e] - mx); sum += pr[e]; }
        const float inv = 1.0f / sum;
        float bestg = -3.0e38f; int e1 = 0, e2 = 1; float p1 = 0.f, p2 = 0.f;
#pragma unroll
        for (int g = 0; g < 4; ++g) {
            float b1 = -3.0e38f, b2 = -3.0e38f; int i1 = 0, i2 = 0; float q1 = 0.f, q2 = 0.f;
#pragma unroll
            for (int k = 0; k < 4; ++k) { const float p = pr[4 * g + k] * inv; const float sv = p + a.in[I_RB][4 * g + k];
                if (sv > b1) { b2 = b1; i2 = i1; q2 = q1; b1 = sv; i1 = 4 * g + k; q1 = p; } else if (sv > b2) { b2 = sv; i2 = 4 * g + k; q2 = p; } }
            const float gs = b1 + b2;
            if (gs > bestg) { bestg = gs; e1 = i1; e2 = i2; p1 = q1; p2 = q2; }
        }
        const float wn = 1.0f / (p1 + p2);
        if (F.lane == 0) { const int lp1 = atomicAdd((int*)&lcnt[e1], 1), lp2 = atomicAdd((int*)&lcnt[e2], 1);
            LAS int* ri = rinfo + (F.wave * 9 + nrows) * 4; ri[0] = e1; ri[1] = lp1; ri[2] = e2; ri[3] = lp2;
            rwt[(F.wave * 9 + nrows) * 2 + 0] = p1 * wn; rwt[(F.wave * 9 + nrows) * 2 + 1] = p2 * wn; }
    }
    LDS_WAIT();
    __syncthreads();
    if (F.tid < 16) lcnt[16 + F.tid] = (int)__hip_atomic_fetch_add((unsigned*)(a.ws + WS_CTL) + CW_CNT + (li * 16 + F.tid) * 64, (unsigned)lcnt[F.tid], RLX_AGENT);
    LDS_WAIT();
    __syncthreads();
    if (F.lane == 0) {
        unsigned* tok = (unsigned*)(a.ws + WS_TOK); int* lists = (int*)(a.ws + WS_TOK + MiB);
        int k = 0;
        for (int row = F.gw; row < MROWS; row += F.NGW, ++k) {
            const LAS int* ri = rinfo + (F.wave * 9 + k) * 4; const int e1 = ri[0], e2 = ri[2]; const int pos1 = lcnt[16 + e1] + ri[1], pos2 = lcnt[16 + e2] + ri[3];
            lists[(size_t)e1 * MROWS + pos1] = row; lists[(size_t)e2 * MROWS + pos2] = row;
            u32x4 w0; w0.x = (unsigned)e1; w0.y = (unsigned)pos1; w0.z = (unsigned)e2; w0.w = (unsigned)pos2;
            *(u32x4*)(tok + (size_t)row * 8) = w0; tok[(size_t)row * 8 + 4] = __float_as_uint(rwt[(F.wave * 9 + k) * 2]); tok[(size_t)row * 8 + 5] = __float_as_uint(rwt[(F.wave * 9 + k) * 2 + 1]);
        }
    }
}
DI int moe_tile_table(const Args& a, const Frame& F, int li) {
    LAS int* tb = (LAS int*)(F.lds + TB_OFF);
    if (F.tid < 64) {
        int c = 0; if (F.lane < 16) c = (int)__hip_atomic_load((unsigned*)(a.ws + WS_CTL) + CW_CNT + (li * 16 + F.lane) * 64, RLX_AGENT);
        const int nt = (c + 255) >> 8; int inc = nt;
#pragma unroll
        for (int o = 1; o < 16; o <<= 1) { const int t = __shfl_up(inc, o); if (F.lane >= o) inc += t; }
        if (F.lane < 16) { tb[F.lane] = inc - nt; tb[32 + F.lane] = c; }
        if (F.lane == 15) tb[16] = inc;
    }
    LDS_WAIT();
    __syncthreads();
    return tb[16];
}
DI void m1_gateup(const Args& a, const Frame& F, int li) {
    const int NT = moe_tile_table(a, F, li);
    LAS int* tb = (LAS int*)(F.lds + TB_OFF); LAS unsigned* tab = (LAS unsigned*)(F.lds + TAB_OFF);
    pg8::MoeSched<true, 8> S; S.A = (const char*)(a.ws + WS_H); S.Bt = (const char*)(a.ws + WS_WGU); S.tb = tb; S.tab = tab; S.NT = NT; S.G = F.G; S.c = F.bid; S.estride = (size_t)2048 * 1024 * 2;
    const int* lists = (const int*)(a.ws + WS_TOK + MiB);
    pg8::Unit u;
    for (int i = 0; i < 8 && S.next(i, u); ++i) {
        if (F.tid < 256) { const int cnt = tb[32 + u.e], idx = (u.pm - tb[u.e]) * 256 + F.tid; const int tokr = lists[(size_t)u.e * MROWS + (idx < cnt ? idx : 0)]; tab[i * 256 + F.tid] = (unsigned)tokr * 2048u; }
    }
    LDS_WAIT();
    __syncthreads();
    pg8::EpiSwiGLU E{(bf16_t*)(a.ws + WS_HID)};
    pg8::gemm_phase<pg8::EpiSwiGLU, pg8::MoeSched<true, 8>>(F.lds, 1024, S, E);
}
DI void m2_down(const Args& a, const Frame& F, int li) {
    const int NT = moe_tile_table(a, F, li);
    LAS int* tb = (LAS int*)(F.lds + TB_OFF);
    pg8::MoeSched<false, 4> S; S.A = (const char*)(a.ws + WS_HID); S.Bt = (const char*)(a.ws + WS_WD); S.tb = tb; S.tab = nullptr; S.NT = NT; S.G = F.G; S.c = F.bid; S.estride = (size_t)1024 * 1024 * 2;
    pg8::EpiBf16 E{(bf16_t*)(a.ws + WS_YEXP), 1024, 0, 0};
    pg8::gemm_phase<pg8::EpiBf16, pg8::MoeSched<false, 4>>(F.lds, 1024, S, E);
}
DI void m3_combine(const Args& a, const Frame& F, int li) {
    (void)moe_tile_table(a, F, li);
    const LAS int* tb = (const LAS int*)(F.lds + TB_OFF);
    float* X = (float*)(a.ws + WS_X); bf16_t* H = (bf16_t*)(a.ws + WS_H); const bf16_t* Y = (const bf16_t*)(a.ws + WS_YEXP);
    const unsigned* tok = (const unsigned*)(a.ws + WS_TOK);
    const float* lg = a.in[I_LNG] + (size_t)(li * 2 + 1) * D; const float* lb = a.in[I_LNB] + (size_t)(li * 2 + 1) * D;
    for (int row = F.gw; row < MROWS; row += F.NGW) {
        const u32x4 t0 = *(const u32x4*)(tok + (size_t)row * 8); const float w1 = __uint_as_float(tok[(size_t)row * 8 + 4]), w2 = __uint_as_float(tok[(size_t)row * 8 + 5]);
        const int e1 = __builtin_amdgcn_readfirstlane((int)t0.x), e2 = __builtin_amdgcn_readfirstlane((int)t0.z);
        const size_t s1 = (size_t)tb[e1] * 256 + t0.y, s2 = (size_t)tb[e2] * 256 + t0.w;
        const float* mr = mod_row(a, li, row);
        f32x4 v[4];
#pragma unroll
        for (int j = 0; j < 4; ++j) { const int c = 4 * F.lane + 256 * j;
            const u32x2 y1 = *(const u32x2*)(Y + s1 * 1024 + c), y2 = *(const u32x2*)(Y + s2 * 1024 + c);
            f32x4 y; y[0] = w1 * bflo(y1.x) + w2 * bflo(y2.x); y[1] = w1 * bfhi(y1.x) + w2 * bfhi(y2.x); y[2] = w1 * bflo(y1.y) + w2 * bflo(y2.y); y[3] = w1 * bfhi(y1.y) + w2 * bfhi(y2.y);
            const f32x4 g2 = *(const f32x4*)(mr + 5120 + c);
            v[j] = *(const f32x4*)(X + (size_t)row * D + c) * DN_ALPHA + g2 * y; }
        ln_row(v, lg, lb, F.lane);
        if (li < DEPTH - 1) {
            const float* mn = mod_row(a, li + 1, row); f32x4 h[4];
#pragma unroll
            for (int j = 0; j < 4; ++j) { const int c = 4 * F.lane + 256 * j; *(f32x4*)(X + (size_t)row * D + c) = v[j]; const f32x4 sh = *(const f32x4*)(mn + c), sc = *(const f32x4*)(mn + 1024 + c); h[j] = v[j] * (sc + 1.0f) + sh; }
            store_h(H + (size_t)row * D, F.lane, h);
        } else {
            const int b = row / LSEQ, p = row % LSEQ;
            if (p >= CN) { float* o = a.out + ((size_t)b * TL + (p - CN)) * D;
#pragma unroll
                for (int j = 0; j < 4; ++j) *(f32x4*)(o + 4 * F.lane + 256 * j) = v[j]; }
        }
    }
}

DI void a1_qkv(const Args& a, const Frame& F, int slot) {
    pg8::DenseSched S; S.init(a.ws + WS_H, a.ws + WS_WATT_IN + (size_t)slot * 3072 * 1024 * 2, MROWS, 3072, 1024, F.G, F.bid);
    pg8::EpiBf16 E{(bf16_t*)(a.ws + MX_Q), 1024, 1024, (size_t)MROWS * 1024};
    pg8::gemm_phase<pg8::EpiBf16, pg8::DenseSched>(F.lds, 1024, S, E);
}
DI void a1b_rope(const Args& a, const Frame& F) {
    const f32x2* tabl = (const f32x2*)(a.ws + WS_PAR + PAR_ROPE);
    const int quarter = F.lane & 3, colb = (F.lane >> 2) * 64 + quarter * 16;
    for (int it = F.gw; it < 2 * NB * TL; it += F.NGW) {
        const int which = it & 1, lr = it >> 1, b = lr / TL, t = lr % TL;
        bf16_t* p = (bf16_t*)(a.ws + (which ? MX_K : MX_Q)) + ((size_t)b * LSEQ + CN + t) * 1024 + colb;
        const int pos = (quarter < 2) ? (t >> 6) : (t & 63);
        u32x4 w0 = *(const u32x4*)p, w1 = *(const u32x4*)(p + 8);
        unsigned wi[8] = {w0.x, w0.y, w0.z, w0.w, w1.x, w1.y, w1.z, w1.w}; unsigned wo[8];
#pragma unroll
        for (int q = 0; q < 8; ++q) {
            const float m0 = bflo(wi[q]), m1 = bfhi(wi[q]);
            const float o0 = __shfl_xor(m0, 1), o1 = __shfl_xor(m1, 1);
            const f32x2 cs0 = tabl[pos * 16 + 2 * q], cs1 = tabl[pos * 16 + 2 * q + 1];
            const float sg = (quarter & 1) ? 1.0f : -1.0f;
            wo[q] = pk2(m0 * cs0.x + sg * o0 * cs0.y, m1 * cs1.x + sg * o1 * cs1.y);
        }
        *(u32x4*)p = (u32x4){wo[0], wo[1], wo[2], wo[3]}; *(u32x4*)(p + 8) = (u32x4){wo[4], wo[5], wo[6], wo[7]};
    }
}
DI void a2_attention(const Args& a, const Frame& F, int li, int slot) {
    const float lam_init = (li == 0) ? 0.2f : 0.55605820415562f;
    const float* lm = a.in[I_ALAM] + (size_t)slot * 4 * 64;
    const float s0 = wave_sum(lm[F.lane] * lm[64 + F.lane]), s1 = wave_sum(lm[128 + F.lane] * lm[192 + F.lane]);
    const float lamf = expf(s0) - expf(s1) + lam_init;
    const bf16_t* Q = (const bf16_t*)(a.ws + MX_Q); const bf16_t* K = (const bf16_t*)(a.ws + MX_K); const bf16_t* V = (const bf16_t*)(a.ws + MX_V); bf16_t* AO = (bf16_t*)(a.ws + MX_AO);
    const float* subg = a.in[I_ASUB] + (size_t)slot * 128;
    const int v = (F.G % 8 == 0) ? (F.bid % 8) * (F.G / 8) + F.bid / 8 : F.bid;
    for (int u = v; u < 1024 + 128; u += F.G) {
        int b, h, row0, seq;
        if (u < 1024) { const int bh = u >> 4, qb = u & 15; b = bh >> 3; h = bh & 7; row0 = b * LSEQ + CN + qb * 128; seq = LSEQ; }
        else { const int w = u - 1024, bh = w >> 1, qb = w & 1; b = bh >> 3; h = bh & 7; row0 = b * LSEQ + qb * 128; seq = CN; }
        att::attn_unit(Q + (size_t)row0 * 1024, K + (size_t)b * LSEQ * 1024, V + (size_t)b * LSEQ * 1024, AO + (size_t)row0 * 1024, h, seq, lamf, 1.0f - lam_init, subg, (LAS char*)F.lds);
    }
}
DI void a3_wout(const Args& a, const Frame& F, int li, int slot) {
    pg8::DenseSched S; S.init(a.ws + MX_AO, a.ws + WS_WATT_OUT + (size_t)slot * 1024 * 1024 * 2, MROWS, 1024, 1024, F.G, F.bid);
    pg8::EpiResid E{(float*)(a.ws + WS_X), (const float*)(a.ws + WS_MOD) + (size_t)li * 9 * 6144 + 2048};
    pg8::gemm_phase<pg8::EpiResid, pg8::DenseSched>(F.lds, 1024, S, E);
}

DI void s1_win(const Args& a, const Frame& F) {
    pg8::DenseSched S; S.init(a.ws + WS_H, a.ws + WS_WS5_IN, MROWS, 1024, 1024, F.G, F.bid);
    pg8::EpiF32 E{(float*)(a.ws + MX_U), 1024};
    pg8::gemm_phase<pg8::EpiF32, pg8::DenseSched>(F.lds, 1024, S, E);
}
DI void s2_scan(const Args& a, const Frame& F) {
    if (F.wave >= 4) return;
    const int id = F.bid * 4 + F.wave; if (id >= 1024) return;
    const int dir = id >> 9, b = (id >> 6) & 7, g = id & 63, p = F.lane;
    const int sidx = (dir * 64 + g) * 64 + p;
    const float zr = ((const float*)(a.ws + WS_PAR + PAR_ZR))[sidx], zi = ((const float*)(a.ws + WS_PAR + PAR_ZI))[sidx];
    float Br[16], Bi[16], Cr[16], Ci[16];
#pragma unroll
    for (int n = 0; n < 16; ++n) { Br[n] = ((const float*)(a.ws + WS_PAR + PAR_BBR))[(size_t)sidx * 16 + n]; Bi[n] = ((const float*)(a.ws + WS_PAR + PAR_BBI))[(size_t)sidx * 16 + n];
        Cr[n] = a.in[I_S5CRE][((size_t)(dir * 64 + g) * 16 + n) * 64 + p]; Ci[n] = a.in[I_S5CIM][((size_t)(dir * 64 + g) * 16 + n) * 64 + p]; }
    const float* U = (const float*)(a.ws + MX_U) + (size_t)b * LSEQ * 1024 + g * 16;
    float* Y = (float*)(a.ws + (dir ? MX_Y1 : MX_Y0)) + (size_t)b * LSEQ * 1024 + g * 16;
    float hr = 0.f, hi = 0.f;
    const int b5 = F.lane & 32, b4 = F.lane & 16, b3 = F.lane & 8, b2 = F.lane & 4, nout = (F.lane >> 2) & 15;
    f32x4 un[2][4];
#define S5_POS(s) (dir ? ((s) < CN ? (CN - 1 - (s)) : (LSEQ + CN - 1 - (s))) : (s))
#define S5_LOAD(dst, s) do { const float* up = U + (size_t)S5_POS(s) * 1024; dst[0] = *(const f32x4*)(up); dst[1] = *(const f32x4*)(up + 4); dst[2] = *(const f32x4*)(up + 8); dst[3] = *(const f32x4*)(up + 12); } while (0)
    S5_LOAD(un[0], 0); S5_LOAD(un[1], 1);
    for (int s = 0; s < LSEQ; s += 2) {
        f32x4 uc[2][4];
#pragma unroll
        for (int q = 0; q < 2; ++q)
#pragma unroll
            for (int k = 0; k < 4; ++k) uc[q][k] = un[q][k];
        if (s + 2 < LSEQ) { S5_LOAD(un[0], s + 2); S5_LOAD(un[1], s + 3); }
#pragma unroll
        for (int q = 0; q < 2; ++q) {
            float br = 0.f, bi = 0.f;
#pragma unroll
            for (int n = 0; n < 16; ++n) { const float uv = uc[q][n >> 2][n & 3]; br = fmaf(Br[n], uv, br); bi = fmaf(Bi[n], uv, bi); }
            const float nr = zr * hr - zi * hi + br, ni = zr * hi + zi * hr + bi; hr = nr; hi = ni;
            float part[16];
#pragma unroll
            for (int n = 0; n < 16; ++n) part[n] = Cr[n] * hr - Ci[n] * hi;
            float v8[8], v4[4], v2[2];
#pragma unroll
            for (int k = 0; k < 8; ++k) { const float send = b5 ? part[k] : part[k + 8], keep = b5 ? part[k + 8] : part[k]; v8[k] = keep + __shfl_xor(send, 32); }
#pragma unroll
            for (int k = 0; k < 4; ++k) { const float send = b4 ? v8[k] : v8[k + 4], keep = b4 ? v8[k + 4] : v8[k]; v4[k] = keep + __shfl_xor(send, 16); }
#pragma unroll
            for (int k = 0; k < 2; ++k) { const float send = b3 ? v4[k] : v4[k + 2], keep = b3 ? v4[k + 2] : v4[k]; v2[k] = keep + __shfl_xor(send, 8); }
            float v1; { const float send = b2 ? v2[0] : v2[1], keep = b2 ? v2[1] : v2[0]; v1 = keep + __shfl_xor(send, 4); }
            v1 += __shfl_xor(v1, 1); v1 += __shfl_xor(v1, 2);
            if ((F.lane & 3) == 0) Y[(size_t)S5_POS(s + q) * 1024 + nout] = v1;
        }
    }
#undef S5_POS
#undef S5_LOAD
}
DI void s2b_gelu(const Args& a, const Frame& F) {
    const float* U = (const float*)(a.ws + MX_U); const float* Y0 = (const float*)(a.ws + MX_Y0); const float* Y1 = (const float*)(a.ws + MX_Y1); bf16_t* Gb = (bf16_t*)(a.ws + MX_G);
    for (int row = F.gw; row < MROWS; row += F.NGW) {
        f32x4 g[4];
#pragma unroll
        for (int j = 0; j < 4; ++j) { const size_t o = (size_t)row * D + 4 * F.lane + 256 * j; const f32x4 u = *(const f32x4*)(U + o), y0 = *(const f32x4*)(Y0 + o), y1 = *(const f32x4*)(Y1 + o), dd = *(const f32x4*)(a.in[I_S5D] + 4 * F.lane + 256 * j);
            const f32x4 y = dd * u + y0 + y1;
#pragma unroll
            for (int q = 0; q < 4; ++q) g[j][q] = gelu_tanh(y[q]); }
        store_h(Gb + (size_t)row * D, F.lane, g);
    }
}
DI void s3_glu(const Args& a, const Frame& F, int li) {
    pg8::DenseSched S; S.init(a.ws + MX_G, a.ws + WS_WS5_GLU, MROWS, 2048, 1024, F.G, F.bid);
    pg8::EpiGluResid E{(float*)(a.ws + WS_X), (const float*)(a.ws + WS_MOD) + (size_t)li * 9 * 6144 + 2048};
    pg8::gemm_phase<pg8::EpiGluResid, pg8::DenseSched>(F.lds, 1024, S, E);
}

DI void l1_win(const Args& a, const Frame& F) {
    pg8::DenseSched S; S.init(a.ws + WS_H, a.ws + WS_WLRU_IN, MROWS, 2816, 1024, F.G, F.bid);
    pg8::EpiBf16 E{(bf16_t*)(a.ws + MX_UG), 2816, 0, 0};
    pg8::gemm_phase<pg8::EpiBf16, pg8::DenseSched>(F.lds, 1024, S, E);
}
template <int PASS> DI void lru_tiles(const Args& a, const Frame& F) {
    LAS float* XS = (LAS float*)F.lds;
    LAS bf16_t* XB = (LAS bf16_t*)(F.lds + 22528);
    LAS f32x2* AB = (LAS f32x2*)(F.lds + 36864);
    const bf16_t* Ug = (const bf16_t*)(a.ws + MX_UG); const bf16_t* BD = (const bf16_t*)(a.ws + WS_BD);
    const float* SP = (const float*)(a.ws + WS_PAR + PAR_SP);
    f32x2* SUMM = (f32x2*)(a.ws + MX_SUMM); float* CARRY = (float*)(a.ws + MX_CARRY); bf16_t* A2 = (bf16_t*)(a.ws + MX_A2);
    const int fr = F.lane & 15, fq = F.lane >> 4, dir = F.wave >> 2, mb = F.wave & 3;
    for (int unit = F.bid; unit < 288 * 16; unit += F.G) {
        const int rc = unit >> 4, n = unit & 15, b = rc / 36, c = rc % 36, p0 = c * 64;
        const int seg_lo = (c < 4) ? 0 : CN, seg_hi = (c < 4) ? CN : LSEQ;
        const size_t rowbase = (size_t)b * LSEQ + p0;
        for (int idx = F.tid; idx < 64 * 88; idx += 512) {
            const int i = idx / 88, ch = idx % 88, cch = n * 88 + ch;
            float s = a.in[I_LCB][cch];
#pragma unroll
            for (int k = 0; k < 4; ++k) { const int q = p0 + i + k - 1; if (q >= seg_lo && q < seg_hi) s += a.in[I_LCW][k * LRUW + cch] * bf2f(Ug[((size_t)b * LSEQ + q) * 2816 + LRUW + cch]); }
            XS[idx] = s; XB[i * 104 + ch] = (bf16_t)f2bf(s);
        }
        for (int idx = F.tid; idx < 64 * 8; idx += 512) XB[(idx >> 3) * 104 + 88 + (idx & 7)] = 0;
        LDS_WAIT();
        __syncthreads();
        {
            bf16x8 af[3];
#pragma unroll
            for (int ks = 0; ks < 3; ++ks) af[ks] = *(const LAS bf16x8*)(XB + (mb * 16 + fr) * 104 + ks * 32 + fq * 8);
#pragma unroll
            for (int nb = 0; nb < 6; ++nb) {
                f32x4 acc0 = {0.f, 0.f, 0.f, 0.f}, acc1 = {0.f, 0.f, 0.f, 0.f};
#pragma unroll
                for (int ks = 0; ks < 3; ++ks) {
                    const bf16x8 w0 = *(const bf16x8*)(BD + ((size_t)((dir * 2 + 0) * 16 + n) * 96 + nb * 16 + fr) * 96 + ks * 32 + fq * 8);
                    const bf16x8 w1 = *(const bf16x8*)(BD + ((size_t)((dir * 2 + 1) * 16 + n) * 96 + nb * 16 + fr) * 96 + ks * 32 + fq * 8);
                    acc0 = __builtin_amdgcn_mfma_f32_16x16x32_bf16(af[ks], w0, acc0, 0, 0, 0);
                    acc1 = __builtin_amdgcn_mfma_f32_16x16x32_bf16(af[ks], w1, acc1, 0, 0, 0);
                }
                const int e = nb * 16 + fr;
                if (e < 88) {
                    const int cch = n * 88 + e; const float ba = a.in[I_LBA][dir * LRUW + cch], bx = a.in[I_LBX][dir * LRUW + cch], sp = SP[dir * LRUW + cch];
#pragma unroll
                    for (int j = 0; j < 4; ++j) { const int row = mb * 16 + fq * 4 + j;
                        const float r = sigmoidf_(acc0[j] + ba), ig = sigmoidf_(acc1[j] + bx), la = -8.0f * r * sp, av = expf(la), bt = sqrtf(-expm1f(2.0f * la)) * ig * XS[row * 88 + e];
                        AB[(dir * 64 + row) * 88 + e] = (f32x2){av, bt}; }
                }
            }
        }
        LDS_WAIT();
        __syncthreads();
        if (F.tid < 176) {
            const int sd = F.tid / 88, ch = F.tid % 88; const size_t sidx = ((size_t)(sd * 8 + b) * 36 + c) * LRUW + n * 88 + ch;
            if (PASS == 1) {
                float h = 0.f, P = 1.f;
                for (int s = 0; s < 64; ++s) { const int t = sd ? 63 - s : s; const f32x2 ab = AB[(sd * 64 + t) * 88 + ch]; h = fmaf(ab.x, h, ab.y); P *= ab.x; }
                SUMM[sidx] = (f32x2){P, h};
            } else {
                float h = CARRY[sidx];
                for (int s = 0; s < 64; ++s) { const int t = sd ? 63 - s : s; const f32x2 ab = AB[(sd * 64 + t) * 88 + ch]; h = fmaf(ab.x, h, ab.y); AB[(sd * 64 + t) * 88 + ch].x = h; }
            }
        }
        if (PASS == 2) {
            LDS_WAIT();
            __syncthreads();
            for (int idx = F.tid; idx < 64 * 88; idx += 512) {
                const int i = idx / 88, ch = idx % 88;
                const float hs = AB[i * 88 + ch].x + AB[(64 + i) * 88 + ch].x;
                const float gt = gelu_tanh(bf2f(Ug[(rowbase + i) * 2816 + n * 88 + ch]));
                A2[(rowbase + i) * LRUW + n * 88 + ch] = (bf16_t)f2bf(hs * gt);
            }
        }
        LDS_WAIT();
        __syncthreads();
    }
}
DI void l3_carry(const Args& a, const Frame& F) {
    const f32x2* SUMM = (const f32x2*)(a.ws + MX_SUMM); float* CARRY = (float*)(a.ws + MX_CARRY);
    const int gt = F.bid * 512 + F.tid;
    if (gt < 2 * NB * LRUW) {
        const int dir = gt / (NB * LRUW), b = (gt / LRUW) % NB, ch = gt % LRUW; float h = 0.f;
        for (int s = 0; s < 36; ++s) { const int c = dir ? (s < 4 ? 3 - s : 39 - s) : s; const size_t idx = ((size_t)(dir * 8 + b) * 36 + c) * LRUW + ch;
            CARRY[idx] = h; const f32x2 ph = SUMM[idx]; h = fmaf(ph.x, h, ph.y); }
    }
}
DI void l5_wout(const Args& a, const Frame& F, int li) {
    pg8::DenseSched S; S.init(a.ws + MX_A2, a.ws + WS_WLRU_OUT, MROWS, 1024, LRUW, F.G, F.bid);
    pg8::EpiResid E{(float*)(a.ws + WS_X), (const float*)(a.ws + WS_MOD) + (size_t)li * 9 * 6144 + 2048};
    pg8::gemm_phase<pg8::EpiResid, pg8::DenseSched>(F.lds, LRUW, S, E);
}

constexpr int NPHASE = 36;
__global__ void __launch_bounds__(NWAVES * 64, 2) fwd_kernel(Args args) {
    extern __shared__ __attribute__((aligned(16))) unsigned char lds_raw[];
    Frame F;
    F.lds = (LAS unsigned char*)lds_raw;
    F.tid = threadIdx.x; F.lane = F.tid & 63; F.wave = __builtin_amdgcn_readfirstlane(F.tid >> 6);
    F.G = gridDim.x; F.bid = blockIdx.x; F.gw = F.bid * NWAVES + F.wave; F.NGW = F.G * NWAVES;
    volatile LAS unsigned* MISC = (volatile LAS unsigned*)(F.lds + MISC_OFF);
    for (int u = F.tid; u < (LDS_BYTES - MISC_OFF) / 4; u += NWAVES * 64) ((LAS unsigned*)(F.lds + MISC_OFF))[u] = 0u;
    __syncthreads();
    XcdBarrier bar = xcd_barrier_post((unsigned*)(args.ws + WS_CTL) + CW_BAR, MISC + 8);
    const int lo = args.ph_lo, hi = args.ph_hi;
#define IN(k) (lo <= (k) && (k) < hi)
#define SEAM(k) do { if (IN(k) && IN((k) + 1)) xcd_barrier(bar); } while (0)
    if (IN(0)) p0_prologue(args, F);   SEAM(0);
    if (IN(1)) p0b_modreduce(args, F); SEAM(1);
    if (IN(2)) p1_init(args, F);       SEAM(2);
    if (IN(3)) a1_qkv(args, F, 0);          SEAM(3);
    if (IN(4)) a1b_rope(args, F);           SEAM(4);
    if (IN(5)) a2_attention(args, F, 0, 0); SEAM(5);
    if (IN(6)) a3_wout(args, F, 0, 0);      SEAM(6);
    if (IN(7)) m0_route(args, F, 0);        SEAM(7);
    if (IN(8)) m1_gateup(args, F, 0);       SEAM(8);
    if (IN(9)) m2_down(args, F, 0);         SEAM(9);
    if (IN(10)) m3_combine(args, F, 0);     SEAM(10);
    if (IN(11)) s1_win(args, F);            SEAM(11);
    if (IN(12)) s2_scan(args, F);           SEAM(12);
    if (IN(13)) s2b_gelu(args, F);          SEAM(13);
    if (IN(14)) s3_glu(args, F, 1);         SEAM(14);
    if (IN(15)) m0_route(args, F, 1);       SEAM(15);
    if (IN(16)) m1_gateup(args, F, 1);      SEAM(16);
    if (IN(17)) m2_down(args, F, 1);        SEAM(17);
    if (IN(18)) m3_combine(args, F, 1);     SEAM(18);
    if (IN(19)) l1_win(args, F);            SEAM(19);
    if (IN(20)) lru_tiles<1>(args, F);      SEAM(20);
    if (IN(21)) l3_carry(args, F);          SEAM(21);
    if (IN(22)) lru_tiles<2>(args, F);      SEAM(22);
    if (IN(23)) l5_wout(args, F, 2);        SEAM(23);
    if (IN(24)) m0_route(args, F, 2);       SEAM(24);
    if (IN(25)) m1_gateup(args, F, 2);      SEAM(25);
    if (IN(26)) m2_down(args, F, 2);        SEAM(26);
    if (IN(27)) m3_combine(args, F, 2);     SEAM(27);
    if (IN(28)) a1_qkv(args, F, 1);         SEAM(28);
    if (IN(29)) a1b_rope(args, F);          SEAM(29);
    if (IN(30)) a2_attention(args, F, 3, 1); SEAM(30);
    if (IN(31)) a3_wout(args, F, 3, 1);     SEAM(31);
    if (IN(32)) m0_route(args, F, 3);       SEAM(32);
    if (IN(33)) m1_gateup(args, F, 3);      SEAM(33);
    if (IN(34)) m2_down(args, F, 3);        SEAM(34);
    if (IN(35)) m3_combine(args, F, 3);
#undef IN
#undef SEAM
}

extern "C" void kernel_launch(void* const* d_in, const int* in_sizes, int n_in, void* d_out, int out_size, void* d_ws, size_t ws_size, hipStream_t stream) {
    static int grid = 0;
    if (grid == 0) {
        if (n_in != 37 || ws_size < WS_END) { fprintf(stderr, "kernel_launch: unexpected n_in %d or ws_size %zu\n", n_in, ws_size); grid = -1; return; }
        if (hipFuncSetAttribute((const void*)fwd_kernel, hipFuncAttributeMaxDynamicSharedMemorySize, LDS_BYTES) != hipSuccess) { fprintf(stderr, "kernel_launch: hipFuncSetAttribute failed\n"); grid = -1; return; }
        int per_cu = 0;
        if (hipOccupancyMaxActiveBlocksPerMultiprocessor(&per_cu, (const void*)fwd_kernel, NWAVES * 64, LDS_BYTES) != hipSuccess || per_cu < 1) fprintf(stderr, "kernel_launch: occupancy query says %d\n", per_cu);
        (void)hipGetLastError();
        grid = 256;
    }
    if (grid < 0) return;
    (void)hipMemsetAsync((char*)d_ws + WS_CTL, 0, CTL_ZERO_BYTES, stream);
    Args a{};
    for (int i = 0; i < 37; ++i) a.in[i] = (const float*)d_in[i];
    a.out = (float*)d_out; a.ws = (unsigned char*)d_ws;
#if MK_N_LAUNCHES == 1
    a.ph_lo = 0; a.ph_hi = NPHASE;
    hipLaunchKernelGGL(fwd_kernel, dim3(grid), dim3(NWAVES * 64), LDS_BYTES, stream, a);
#else
    for (int p = 0; p < NPHASE; ++p) { a.ph_lo = p; a.ph_hi = p + 1; hipLaunchKernelGGL(fwd_kernel, dim3(grid), dim3(NWAVES * 64), LDS_BYTES, stream, a); }
#endif
    (void)in_sizes; (void)out_size;
}
```

```cpp
#include <hip/hip_runtime.h>
#include <cstdio>
#include <cstdint>

#ifndef PROBE_MASK
#define PROBE_MASK 0ull
#endif
#ifndef MK_N_LAUNCHES
#define MK_N_LAUNCHES 1
#endif

#define LAS __attribute__((address_space(3)))
#define GAS __attribute__((address_space(1)))
typedef unsigned short bf16_t;
typedef short bf16x8 __attribute__((ext_vector_type(8)));
typedef short s16x4 __attribute__((ext_vector_type(4)));
typedef float f32x4 __attribute__((ext_vector_type(4)));
typedef float f32x2 __attribute__((ext_vector_type(2)));
typedef float f32x16 __attribute__((ext_vector_type(16)));
typedef unsigned u32x4 __attribute__((ext_vector_type(4)));
typedef unsigned u32x2 __attribute__((ext_vector_type(2)));
typedef GAS unsigned gu32;
#define RLX_AGENT __ATOMIC_RELAXED, __HIP_MEMORY_SCOPE_AGENT
#define LDS_WAIT() asm volatile("s_waitcnt lgkmcnt(0)" ::: "memory")
#define VM_WAIT() asm volatile("s_waitcnt vmcnt(0)" ::: "memory")
#define DI __device__ __forceinline__

constexpr int D = 1024, NB = 8, TL = 2048, CN = 256, LSEQ = TL + CN  , MROWS = NB * LSEQ  , DEPTH = 4;
constexpr int NE = 16, DEXP = 1024, LRUW = 1408, LRUB = 88;
constexpr int S5G = 64, S5P = 64, S5N = 16;
constexpr float LN_EPS = 1e-5f;
constexpr float DN_ALPHA = 1.6817928305074292f;
constexpr int NWAVES = 8;

constexpr size_t MiB = 1u << 20;
constexpr size_t WS_CTL = 0, CTL_ZERO_BYTES = 1 * MiB;
constexpr size_t WS_MODP = 1 * MiB;
constexpr size_t WS_MOD = 16 * MiB;
constexpr size_t WS_PAR = 17 * MiB;
constexpr size_t WS_BD = 19 * MiB;
constexpr size_t WS_WATT_IN = 21 * MiB;
constexpr size_t WS_WATT_OUT = 33 * MiB;
constexpr size_t WS_WS5_IN = 37 * MiB;
constexpr size_t WS_WS5_GLU = 39 * MiB;
constexpr size_t WS_WLRU_IN = 43 * MiB;
constexpr size_t WS_WLRU_OUT = 49 * MiB;
constexpr size_t WS_WGU = 52 * MiB;
constexpr size_t WS_WD = 116 * MiB;
constexpr size_t WS_X = 148 * MiB;
constexpr size_t WS_H = 220 * MiB;
constexpr size_t WS_TOK = 256 * MiB;
constexpr size_t WS_HID = 258 * MiB;
constexpr size_t WS_YEXP = 338 * MiB;
constexpr size_t WS_MIX = 418 * MiB;
constexpr size_t WS_S5W1 = 670 * MiB;
constexpr size_t WS_S5W2 = 686 * MiB;
constexpr size_t WS_S5KT = 734 * MiB;
constexpr size_t WS_S5ZP = 738 * MiB;
constexpr size_t WS_END = 742 * MiB;
constexpr size_t MX_Q = WS_MIX, MX_K = WS_MIX + 36 * MiB, MX_V = WS_MIX + 72 * MiB, MX_AO = WS_MIX + 108 * MiB;
constexpr size_t MX_U = WS_MIX  , MX_E = WS_MIX + 72 * MiB  , MX_HIN = WS_MIX + 144 * MiB  , MX_G = WS_MIX + 216 * MiB;
constexpr size_t MX_UG = WS_MIX, MX_A2 = WS_MIX + 100 * MiB, MX_SUMM = WS_MIX + 150 * MiB, MX_CARRY = WS_MIX + 158 * MiB;
constexpr size_t PAR_ZR = 0, PAR_ZI = 32768, PAR_BBR = 65536, PAR_BBI = 65536 + 524288, PAR_ROPE = 65536 + 2 * 524288, PAR_SP = PAR_ROPE + 8192;
constexpr int CW_BAR = 4096;
constexpr int CW_CNT = 16384;

constexpr int RING_BYTES = 131072;
constexpr int MISC_OFF = RING_BYTES;
constexpr int TB_OFF = MISC_OFF + 512;
constexpr int TAB_OFF = TB_OFF + 512;
constexpr int LDS_BYTES = 147456;
static_assert(TAB_OFF + 8 * 1024 <= LDS_BYTES, "LDS map");

DI unsigned f2bf(float f) { unsigned u = __builtin_bit_cast(unsigned, f); return (u + 0x7fffu + ((u >> 16) & 1u)) >> 16; }
DI unsigned pk2(float lo, float hi) { return f2bf(lo) | (f2bf(hi) << 16); }
DI float bf2f(unsigned short b) { return __builtin_bit_cast(float, ((unsigned)b) << 16); }
DI float bflo(unsigned w) { return __builtin_bit_cast(float, w << 16); }
DI float bfhi(unsigned w) { return __builtin_bit_cast(float, w & 0xffff0000u); }
DI float wave_sum(float v) {
#pragma unroll
    for (int o = 1; o < 64; o <<= 1) v += __shfl_xor(v, o);
    return v;
}
DI float wave_max(float v) {
#pragma unroll
    for (int o = 1; o < 64; o <<= 1) v = fmaxf(v, __shfl_xor(v, o));
    return v;
}
DI float sigmoidf_(float x) { return __builtin_amdgcn_rcpf(1.0f + __expf(-x)); }
DI float gelu_tanh(float x) { const float u = 0.7978845608028654f * (x + 0.044715f * x * x * x); const float e = __expf(2.0f * u); return x - x * __builtin_amdgcn_rcpf(e + 1.0f); }
DI void sincos_cw(float x, float& s, float& c) {
    const float k = rintf(x * 0.6366197723675814f);
    float r = fmaf(k, -1.5707962512969971f, x); r = fmaf(k, -7.5497894158615964e-08f, r); r = fmaf(k, -5.3903029534742384e-15f, r);
    const float r2 = r * r;
    float sp = fmaf(r2, 2.7557313707070068e-6f, -1.9841270114006046e-4f); sp = fmaf(sp, r2, 8.3333337680e-3f); sp = fmaf(sp, r2, -1.6666667163e-1f); sp = fmaf(sp * r2, r, r);
    float cp = fmaf(r2, 2.4801587e-5f, -1.3888889225e-3f); cp = fmaf(cp, r2, 4.1666667908e-2f); cp = fmaf(cp, r2, -0.5f); cp = fmaf(cp, r2, 1.0f);
    const int q = ((int)k) & 3;
    const float ss = (q & 1) ? cp : sp, cc = (q & 1) ? sp : cp;
    s = (q & 2) ? -ss : ss; c = ((q + 1) & 2) ? -cc : cc;
}

#define XB_TMO      128
#define XB_XCNT(j)  (256  + 64 * (j))
#define XB_XSUB(j)  (1280 + 64 * (j))
#define XB_XGEN(j)  (2304 + 64 * (j))
#define XB_TOP      3328
#define XB_TOPGEN   3392
#define XCD_BAR_WORDS 3456
#define XB_SPIN_CAP (1u << 20)
DI unsigned xb_ld(unsigned* p)              { return __hip_atomic_load(p, __ATOMIC_RELAXED, __HIP_MEMORY_SCOPE_AGENT); }
DI unsigned xb_add(unsigned* p, unsigned v) { return __hip_atomic_fetch_add(p, v, __ATOMIC_RELAXED, __HIP_MEMORY_SCOPE_AGENT); }
DI unsigned xb_xcc_id() { return (unsigned)__builtin_amdgcn_s_getreg((3 << 11) | 20) & 0xFu; }
#define XB_SPIN(cond, bar) do { unsigned _sp = 0; while (cond) { __builtin_amdgcn_s_sleep(1); \
    if ((++_sp & 255u) == 0u) { if (xb_ld(&(bar)[XB_TMO])) break; if (_sp > XB_SPIN_CAP) { atomicAdd(&(bar)[XB_TMO], 1u); break; } } } } while (0)
struct XcdBarrier { unsigned* bar; unsigned x; volatile LAS unsigned* st; };
DI XcdBarrier xcd_barrier_post(unsigned* bar, volatile LAS unsigned* st) {
    XcdBarrier b; b.bar = bar; b.x = xb_xcc_id(); b.st = st;
    if (threadIdx.x == 0) (void)xb_add(&bar[XB_XCNT(b.x)], 1u);
    return b;
}
DI void xcd_barrier_complete(unsigned* bar, unsigned x, unsigned& nloc, unsigned& nx) {
    const unsigned G = gridDim.x * gridDim.y * gridDim.z;
    unsigned sum, cnt, mine, sp = 0u;
    for (;;) {
        sum = 0u; cnt = 0u; mine = 0u;
#pragma unroll
        for (unsigned j = 0; j < 16; ++j) { const unsigned c = xb_ld(&bar[XB_XCNT(j)]); sum += c; cnt += (c > 0u) ? 1u : 0u; mine = (j == x) ? c : mine; }
        if (sum == G) break;
        __builtin_amdgcn_s_sleep(1);
        if ((++sp & 255u) == 0u) { if (xb_ld(&bar[XB_TMO])) break; if (sp > XB_SPIN_CAP) { atomicAdd(&bar[XB_TMO], 1u); break; } }
    }
    nloc = mine > 0u ? mine : 1u; nx = cnt > 0u ? cnt : 1u;
}
DI void xcd_barrier(const XcdBarrier& b) {
    asm volatile("s_waitcnt vmcnt(0)" ::: "memory");
    __syncthreads();
    if (threadIdx.x == 0) {
        unsigned* bar = b.bar;
        __builtin_amdgcn_s_waitcnt(0);
        unsigned nloc = b.st[0], nx = b.st[1];
        if (nloc == 0u) { xcd_barrier_complete(bar, b.x, nloc, nx); b.st[0] = nloc; b.st[1] = nx; }
        const unsigned old = xb_add(&bar[XB_XSUB(b.x)], 1u);
        const unsigned gen = old / nloc;
        if (old + 1u == (gen + 1u) * nloc) {
            __builtin_amdgcn_fence(__ATOMIC_RELEASE, "agent");
            asm volatile("s_waitcnt vmcnt(0)" ::: "memory");
            const unsigned og = xb_add(&bar[XB_TOP], 1u);
            const unsigned tg = og / nx;
            if (og + 1u == (tg + 1u) * nx) xb_add(&bar[XB_TOPGEN], 1u);
            else XB_SPIN(xb_ld(&bar[XB_TOPGEN]) == tg, bar);
            __builtin_amdgcn_fence(__ATOMIC_ACQUIRE, "agent");
            xb_add(&bar[XB_XGEN(b.x)], 1u);
            asm volatile("s_waitcnt vmcnt(0)" ::: "memory");
        } else {
            XB_SPIN(xb_ld(&bar[XB_XGEN(b.x)]) == gen, bar);
            __builtin_amdgcn_fence(__ATOMIC_ACQUIRE, "agent");
            asm volatile("s_waitcnt vmcnt(0)" ::: "memory");
        }
    }
    __syncthreads();
}

namespace pg8 {
constexpr int BM = 256, BK = 64, HALF = 128, HTB = HALF * BK * 2, STAGE_BYTES = 8 * HTB, NXCD = 8, WGM = 8;
__host__ __device__ __forceinline__ int lds_byte(int r, int c) { const int st = (r >> 4) * 2 + (c >> 5), rr = r & 15, cc = c & 31, ob = rr * 64 + cc * 2; return st * 1024 + (ob ^ (((ob >> 9) & 1) << 5)); }
__host__ __device__ __forceinline__ void stage_rc(int b, int& R, int& C) { const int st = b / 1024, sb = b % 1024, swz = sb ^ (((sb >> 9) & 1) << 5); R = (st >> 1) * 16 + swz / 64; C = (st & 1) * 32 + (swz % 64) / 2; }
__host__ __device__ __forceinline__ int perm32(int rho) { const int n = rho >> 4, i = rho & 15; return 8 * (i >> 2) + 4 * n + (i & 3); }

struct Unit { int pm, pn, e; const char* A; const char* B; };
DI unsigned cvt_pk_bf16(float lo, float hi) { unsigned r; asm volatile("v_cvt_pk_bf16_f32 %0, %1, %2" : "=v"(r) : "v"(lo), "v"(hi)); return r; }

DI int xcd_remap(int wgid, int nwg) { const int q = nwg / NXCD, r = nwg % NXCD, xcd = wgid % NXCD, off = wgid / NXCD; return (xcd < r ? xcd * (q + 1) : r * (q + 1) + (xcd - r) * q) + off; }

struct DenseSched {
    static constexpr bool GATHER = false;
    const char* A; const char* Bt; int K, nM, nN, nwg, G, c;
    DI void init(const void* A_, const void* Bt_, int M, int N, int K_, int G_, int c_) { A = (const char*)A_; Bt = (const char*)Bt_; K = K_; nM = M / BM; nN = N / BM; nwg = nM * nN; G = G_; c = c_; }
    DI bool next(int i, Unit& u) const {
        const long L = (long)i * G + c; if (L >= nwg) return false;
        const int wgid = xcd_remap((int)L, nwg);
        const int nig = WGM * nN, gid = wgid / nig, fm = gid * WGM, gsz = (nM - fm) < WGM ? (nM - fm) : WGM;
        u.pm = fm + ((wgid % nig) % gsz); u.pn = (wgid % nig) / gsz; u.e = 0;
        u.A = A + (size_t)u.pm * BM * K * 2; u.B = Bt + (size_t)u.pn * BM * K * 2; return true;
    }
    DI void aoffs(int, const Unit&, const int (&R)[2], const int (&C)[2], unsigned (&vo)[2][2]) const {
#pragma unroll
        for (int h = 0; h < 2; ++h)
#pragma unroll
            for (int p = 0; p < 2; ++p) vo[h][p] = (unsigned)((h * HALF + R[p]) * K + C[p]) * 2u;
    }
};
template <bool GATHER_, int NPN>
struct MoeSched {
    static constexpr bool GATHER = GATHER_;
    const char* A; const char* Bt; const LAS int* tb; const LAS unsigned* tab; int NT, G, c; size_t estride;
    DI bool next(int i, Unit& u) const {
        const int nwg = NT * NPN; const long L = (long)i * G + c; if (L >= nwg) return false;
        const int id = xcd_remap((int)L, nwg);
        const int rt = id / NPN, pn = id % NPN; int e = 0;
#pragma unroll
        for (int j = 1; j < 16; ++j) e += (tb[j] <= rt) ? 1 : 0;
        u.pm = rt; u.pn = pn; u.e = e;
        u.A = GATHER ? A : A + (size_t)rt * BM * 1024 * 2; u.B = Bt + (size_t)e * estride + (size_t)pn * BM * 1024 * 2; return true;
    }
    DI void aoffs(int i, const Unit&, const int (&R)[2], const int (&C)[2], unsigned (&vo)[2][2]) const {
#pragma unroll
        for (int h = 0; h < 2; ++h)
#pragma unroll
            for (int p = 0; p < 2; ++p) vo[h][p] = GATHER ? (tab[i * 256 + h * HALF + R[p]] + (unsigned)C[p] * 2u) : (unsigned)((h * HALF + R[p]) * 1024 + C[p]) * 2u;
    }
};

struct EpiBf16 {
    static constexpr bool PERM = true;
    bf16_t* O; int ldc; int split_cols; size_t split_stride;
    DI void operator()(const f32x4 (&acc)[2][2][4][2], const Unit& u, int wr, int wc, int fr, int fq) const {
        const int row0 = u.pm * BM + wr * 64 + fr; int colt = u.pn * BM; bf16_t* base = O;
        if (split_cols) { const int t = colt / split_cols; base += (size_t)t * split_stride; colt -= t * split_cols; }
        const int col0 = colt + wc * 32 + 8 * fq;
#pragma unroll
        for (int ai = 0; ai < 2; ++ai)
#pragma unroll
            for (int m = 0; m < 4; ++m) { bf16_t* rowp = base + (size_t)(row0 + ai * HALF + m * 16) * ldc + col0;
#pragma unroll
                for (int bj = 0; bj < 2; ++bj) { const f32x4 v0 = acc[ai][bj][m][0], v1 = acc[ai][bj][m][1];
                    u32x4 w; w.x = cvt_pk_bf16(v0[0], v0[1]); w.y = cvt_pk_bf16(v0[2], v0[3]); w.z = cvt_pk_bf16(v1[0], v1[1]); w.w = cvt_pk_bf16(v1[2], v1[3]);
                    *(u32x4*)(rowp + bj * HALF) = w; } }
    }
};
struct EpiF32 {
    static constexpr bool PERM = false;
    float* C; int ldc;
    DI void operator()(const f32x4 (&acc)[2][2][4][2], const Unit& u, int wr, int wc, int fr, int fq) const {
        const int row0 = u.pm * BM + wr * 64 + fr, col0 = u.pn * BM + wc * 32 + 4 * fq;
#pragma unroll
        for (int ai = 0; ai < 2; ++ai)
#pragma unroll
            for (int m = 0; m < 4; ++m) { float* rowp = C + (size_t)(row0 + ai * HALF + m * 16) * ldc + col0;
#pragma unroll
                for (int bj = 0; bj < 2; ++bj)
#pragma unroll
                    for (int n = 0; n < 2; ++n) *(f32x4*)(rowp + bj * HALF + n * 16) = acc[ai][bj][m][n]; }
    }
};
struct EpiResid {
    static constexpr bool PERM = false;
    float* X; const float* gate;
    DI void operator()(const f32x4 (&acc)[2][2][4][2], const Unit& u, int wr, int wc, int fr, int fq) const {
        const int row0 = u.pm * BM + wr * 64 + fr, col0 = u.pn * BM + wc * 32 + 4 * fq;
        const int r9 = (u.pm % 9 == 0) ? 8 : u.pm / 9; const float* g = gate + (size_t)r9 * 6144 + col0;
        f32x4 gv[2][2];
#pragma unroll
        for (int bj = 0; bj < 2; ++bj)
#pragma unroll
            for (int n = 0; n < 2; ++n) gv[bj][n] = *(const f32x4*)(g + bj * HALF + n * 16);
#pragma unroll
        for (int ai = 0; ai < 2; ++ai)
#pragma unroll
            for (int m = 0; m < 4; ++m) { float* rowp = X + (size_t)(row0 + ai * HALF + m * 16) * D + col0;
#pragma unroll
                for (int bj = 0; bj < 2; ++bj)
#pragma unroll
                    for (int n = 0; n < 2; ++n) { const f32x4 x = *(const f32x4*)(rowp + bj * HALF + n * 16); *(f32x4*)(rowp + bj * HALF + n * 16) = x * DN_ALPHA + gv[bj][n] * acc[ai][bj][m][n]; } }
    }
};
struct EpiGluResid {
    static constexpr bool PERM = false;
    float* X; const float* gate;
    DI void operator()(const f32x4 (&acc)[2][2][4][2], const Unit& u, int wr, int wc, int fr, int fq) const {
        const int row0 = u.pm * BM + wr * 64 + fr, col0 = u.pn * HALF + wc * 32 + 4 * fq;
        const int r9 = (u.pm % 9 == 0) ? 8 : u.pm / 9; const float* g = gate + (size_t)r9 * 6144 + col0;
        f32x4 gv[2];
#pragma unroll
        for (int n = 0; n < 2; ++n) gv[n] = *(const f32x4*)(g + n * 16);
#pragma unroll
        for (int ai = 0; ai < 2; ++ai)
#pragma unroll
            for (int m = 0; m < 4; ++m) { float* rowp = X + (size_t)(row0 + ai * HALF + m * 16) * D + col0;
#pragma unroll
                for (int n = 0; n < 2; ++n) { const f32x4 v = acc[ai][0][m][n], gg = acc[ai][1][m][n]; f32x4 o;
#pragma unroll
                    for (int j = 0; j < 4; ++j) o[j] = v[j] * sigmoidf_(gg[j]);
                    const f32x4 x = *(const f32x4*)(rowp + n * 16); *(f32x4*)(rowp + n * 16) = x * DN_ALPHA + gv[n] * o; } }
    }
};
struct EpiSwiGLU {
    static constexpr bool PERM = true;
    bf16_t* Hid;
    DI void operator()(const f32x4 (&acc)[2][2][4][2], const Unit& u, int wr, int wc, int fr, int fq) const {
        const int row0 = u.pm * BM + wr * 64 + fr, col0 = u.pn * HALF + wc * 32 + 8 * fq;
#pragma unroll
        for (int ai = 0; ai < 2; ++ai)
#pragma unroll
            for (int m = 0; m < 4; ++m) { bf16_t* rowp = Hid + (size_t)(row0 + ai * HALF + m * 16) * DEXP + col0;
                f32x4 h0, h1;
#pragma unroll
                for (int j = 0; j < 4; ++j) { const float g0 = acc[ai][0][m][0][j], g1 = acc[ai][0][m][1][j]; h0[j] = g0 * sigmoidf_(g0) * acc[ai][1][m][0][j]; h1[j] = g1 * sigmoidf_(g1) * acc[ai][1][m][1][j]; }
                u32x4 w; w.x = cvt_pk_bf16(h0[0], h0[1]); w.y = cvt_pk_bf16(h0[2], h0[3]); w.z = cvt_pk_bf16(h1[0], h1[1]); w.w = cvt_pk_bf16(h1[2], h1[3]);
                *(u32x4*)rowp = w; }
    }
};

template <class Epi, class Sched, bool ALIGN_EPI = true>
DI void gemm_phase(LAS unsigned char* lds, const int K, const Sched& S, const Epi& E) {
    const int tid = threadIdx.x, wid = __builtin_amdgcn_readfirstlane(tid >> 6), lane = tid & 63, wr = wid >> 2, wc = wid & 3, fr = lane & 15, fq = lane >> 4;
    const int nt = K / BK;
    int Rr[2], Cc[2]; unsigned voffB[2];
#pragma unroll
    for (int i = 0; i < 2; ++i) { int R, C; stage_rc(tid * 16 + i * 8192, R, C); Rr[i] = R; Cc[i] = C; const int Rb = Epi::PERM ? ((R & ~31) + perm32(R & 31)) : R; voffB[i] = (unsigned)(Rb * K + C) * 2u; }
    const size_t kstep = (size_t)(BK * 2);
    const size_t hstep = (size_t)HALF * K * 2;
    const unsigned ldsw = (unsigned)wid * 1024u;
    const int aoff = lds_byte(wr * 64 + fr, fq * 8), boff = lds_byte(wc * 32 + fr, fq * 8);
#define PG8_SA(b, h) (((b) * 2 + (h)) * HTB)
#define PG8_SB(b, h) ((4 + (b) * 2 + (h)) * HTB)
#define PG8_STAGE(bufoff, gbase, o0, o1) do { \
        __builtin_amdgcn_global_load_lds((const unsigned*)((const char*)(gbase) + (o0)), (LAS unsigned*)(lds + (bufoff) + ldsw), 16, 0, 0); \
        __builtin_amdgcn_global_load_lds((const unsigned*)((const char*)(gbase) + (o1)), (LAS unsigned*)(lds + (bufoff) + ldsw + 8192), 16, 0, 0); } while (0)
#define PG8_STAGEB(bufoff, gbase) PG8_STAGE(bufoff, gbase, voffB[0], voffB[1])
#define PG8_LDA(dst, b, h) do { _Pragma("unroll") for (int m = 0; m < 4; ++m) _Pragma("unroll") for (int k = 0; k < 2; ++k) dst[m][k] = *(const LAS bf16x8*)(lds + PG8_SA(b, h) + aoff + m * 2048 + k * 1024); } while (0)
#define PG8_LDB(dst, b, h) do { _Pragma("unroll") for (int n = 0; n < 2; ++n) _Pragma("unroll") for (int k = 0; k < 2; ++k) dst[n][k] = *(const LAS bf16x8*)(lds + PG8_SB(b, h) + boff + n * 2048 + k * 1024); } while (0)
#define PG8_MMA(ai, bj, At, Bt) do { __builtin_amdgcn_s_setprio(1); _Pragma("unroll") for (int m = 0; m < 4; ++m) _Pragma("unroll") for (int n = 0; n < 2; ++n) _Pragma("unroll") for (int k = 0; k < 2; ++k) \
        acc[ai][bj][m][n] = __builtin_amdgcn_mfma_f32_16x16x32_bf16(Bt[n][k], At[m][k], acc[ai][bj][m][n], 0, 0, 0); __builtin_amdgcn_s_setprio(0); } while (0)
#define PG8_WAIT_V(n) asm volatile("s_waitcnt vmcnt(" #n ")" ::: "memory")
#define PG8_WAIT_L(n) asm volatile("s_waitcnt lgkmcnt(" #n ")" ::: "memory")
#define PG8_BAR __builtin_amdgcn_s_barrier()
#define PG8_SCHED __builtin_amdgcn_sched_barrier(0)
    Unit cur, nxt; int ui = 0;
    if (!S.next(0, cur)) return;
    f32x4 acc[2][2][4][2];
#pragma unroll
    for (int a = 0; a < 2; ++a)
#pragma unroll
        for (int b = 0; b < 2; ++b)
#pragma unroll
            for (int m = 0; m < 4; ++m)
#pragma unroll
                for (int n = 0; n < 2; ++n) acc[a][b][m][n] = (f32x4){0.f, 0.f, 0.f, 0.f};
    bf16x8 At[4][2], B0[2][2], B1[2][2];
    unsigned voA[2][2], voN[2][2];
    S.aoffs(0, cur, Rr, Cc, voA);
#pragma unroll
    for (int h = 0; h < 2; ++h)
#pragma unroll
        for (int p = 0; p < 2; ++p) voN[h][p] = voA[h][p];
    const char* cA = cur.A; const char* cB = cur.B;
    PG8_STAGEB(PG8_SB(0, 0), cB); PG8_STAGEB(PG8_SB(0, 1), cB + hstep); PG8_STAGE(PG8_SA(0, 0), cA, voA[0][0], voA[0][1]); PG8_STAGE(PG8_SA(0, 1), cA, voA[1][0], voA[1][1]);
    if (wr == 1) PG8_BAR;
    PG8_WAIT_V(2); PG8_BAR;
    PG8_STAGEB(PG8_SB(1, 0), cB + kstep); PG8_STAGE(PG8_SA(1, 0), cA + kstep, voA[0][0], voA[0][1]); PG8_STAGEB(PG8_SB(1, 1), cB + hstep + kstep);
    PG8_WAIT_V(6); PG8_BAR;
    for (;;) {
        const bool has_next = S.next(ui + 1, nxt);
        const char* nA = has_next ? nxt.A : cA; const char* nB = has_next ? nxt.B : cB;
        for (int t = 0; t < nt; t += 2) {
            const bool last = (t == nt - 2);
            const char* a1 = cA + (size_t)(t + 1) * kstep;
            const char* a2 = last ? nA : cA + (size_t)(t + 2) * kstep; const char* b2 = last ? nB : cB + (size_t)(t + 2) * kstep;
            const char* a3 = a2 + kstep; const char* b3 = b2 + kstep;
            if (Sched::GATHER) { if (last && has_next) S.aoffs(ui + 1, nxt, Rr, Cc, voN); }
            unsigned s00 = voA[0][0], s01 = voA[0][1], s10 = voA[1][0], s11 = voA[1][1];
            if (Sched::GATHER) { if (last) { s00 = voN[0][0]; s01 = voN[0][1]; s10 = voN[1][0]; s11 = voN[1][1]; } }
            PG8_LDB(B0, 0, 0); PG8_LDB(B1, 0, 1); PG8_SCHED; PG8_LDA(At, 0, 0); PG8_STAGE(PG8_SA(1, 1), a1, voA[1][0], voA[1][1]);
            PG8_WAIT_V(8); PG8_WAIT_L(0); PG8_BAR; PG8_MMA(0, 0, At, B0); PG8_MMA(0, 1, At, B1); PG8_BAR; PG8_SCHED;
            PG8_LDA(At, 0, 1); PG8_STAGEB(PG8_SB(0, 0), b2); PG8_STAGEB(PG8_SB(0, 1), b2 + hstep); PG8_STAGE(PG8_SA(0, 0), a2, s00, s01);
            PG8_WAIT_V(8); PG8_WAIT_L(0); PG8_BAR; PG8_MMA(1, 0, At, B0); PG8_MMA(1, 1, At, B1); PG8_BAR; PG8_SCHED;
            PG8_LDB(B0, 1, 0); PG8_LDB(B1, 1, 1); PG8_SCHED; PG8_LDA(At, 1, 0); PG8_STAGE(PG8_SA(0, 1), a2, s10, s11);
            PG8_WAIT_V(8); PG8_WAIT_L(0); PG8_BAR; PG8_MMA(0, 0, At, B0); PG8_MMA(0, 1, At, B1); PG8_BAR; PG8_SCHED;
            PG8_LDA(At, 1, 1); PG8_STAGEB(PG8_SB(1, 0), b3); PG8_STAGEB(PG8_SB(1, 1), b3 + hstep); PG8_STAGE(PG8_SA(1, 0), a3, s00, s01);
            PG8_WAIT_V(8); PG8_WAIT_L(0); PG8_BAR; PG8_MMA(1, 0, At, B0); PG8_MMA(1, 1, At, B1); PG8_BAR; PG8_SCHED;
        }
        if constexpr (ALIGN_EPI) { if (wr == 0) PG8_BAR; }
        E(acc, cur, wr, wc, fr, fq);
        if (!has_next) break;
#pragma unroll
        for (int a = 0; a < 2; ++a)
#pragma unroll
            for (int b = 0; b < 2; ++b)
#pragma unroll
                for (int m = 0; m < 4; ++m)
#pragma unroll
                    for (int n = 0; n < 2; ++n) acc[a][b][m][n] = (f32x4){0.f, 0.f, 0.f, 0.f};
        cur = nxt; cA = nA; cB = nB; ++ui;
        if (Sched::GATHER) {
#pragma unroll
            for (int h = 0; h < 2; ++h)
#pragma unroll
                for (int p = 0; p < 2; ++p) voA[h][p] = voN[h][p];
        }
        if constexpr (ALIGN_EPI) { if (wr == 1) PG8_BAR; }
    }
    PG8_WAIT_V(0);
    if constexpr (!ALIGN_EPI) { if (wr == 0) PG8_BAR; }
    PG8_BAR;
#undef PG8_SA
#undef PG8_SB
#undef PG8_STAGE
#undef PG8_STAGEB
#undef PG8_LDA
#undef PG8_LDB
#undef PG8_MMA
#undef PG8_WAIT_V
#undef PG8_WAIT_L
#undef PG8_BAR
#undef PG8_SCHED
}
}

namespace att {
constexpr int KVBLK = 64;
constexpr float SCALE = 0.125f;
constexpr float THR = 8.f;
constexpr int SHM_V = KVBLK * 128 * 2, SHM_K = KVBLK * 128 * 2;
constexpr int ATT_LDS = 2 * SHM_V + 2 * SHM_K + 8 * 64 * 4;
#define KSWZ(row, colB) ((row) * 256 + ((colB) ^ (((row) & 7) << 4)))
#define SBAR() __builtin_amdgcn_sched_barrier(0)
DI int crow(int r, int hi) { return (r & 3) + 8 * (r >> 2) + 4 * hi; }
DI unsigned cvtpk(float lo, float hi) { unsigned r; asm volatile("v_cvt_pk_bf16_f32 %0, %1, %2" : "=v"(r) : "v"(lo), "v"(hi)); return r; }
DI void partialSM(f32x16& p0, f32x16& p1, float& m_reg, float& mn, float& alpha) {
  constexpr float C = SCALE * 1.4426950408889634f;
  float pmax = p0[0];
#pragma unroll
  for (int r = 1; r < 16; ++r) pmax = fmaxf(pmax, p0[r]);
#pragma unroll
  for (int r = 0; r < 16; ++r) pmax = fmaxf(pmax, p1[r]);
  { auto rr = __builtin_amdgcn_permlane32_swap(__float_as_uint(pmax), __float_as_uint(pmax), false, false);
    pmax = fmaxf(__uint_as_float(rr[0]), __uint_as_float(rr[1])); }
  if (__builtin_expect(__all(pmax - m_reg <= THR / SCALE), 1)) { mn = m_reg; alpha = 1.f; }
  else { mn = fmaxf(m_reg, pmax); alpha = __builtin_amdgcn_exp2f((m_reg - mn) * C); m_reg = mn; }
  float mnC = -mn * C;
#pragma unroll
  for (int r = 0; r < 16; ++r) p0[r] = fmaf(p0[r], C, mnC);
#pragma unroll
  for (int r = 0; r < 16; ++r) p1[r] = fmaf(p1[r], C, mnC);
#pragma unroll
  for (int r = 0; r < 16; ++r) p0[r] = __builtin_amdgcn_exp2f(p0[r]);
}
DI void finishSM(f32x16& p0, f32x16& p1, float alpha, float& l_reg, bf16x8& pa0, bf16x8& pa1, bf16x8& pa2, bf16x8& pa3) {
#pragma unroll
  for (int r = 0; r < 16; ++r) p1[r] = __builtin_amdgcn_exp2f(p1[r]);
  float ps = 0;
#pragma unroll
  for (int r = 0; r < 16; ++r) ps += p0[r];
#pragma unroll
  for (int r = 0; r < 16; ++r) ps += p1[r];
  { auto rr = __builtin_amdgcn_permlane32_swap(__float_as_uint(ps), __float_as_uint(ps), false, false);
    ps = __uint_as_float(rr[0]) + __uint_as_float(rr[1]); }
  l_reg = l_reg * alpha + ps;
#define PK4(P, BASE, OUT) do { unsigned a0 = cvtpk(P[BASE + 0], P[BASE + 1]), a1 = cvtpk(P[BASE + 2], P[BASE + 3]);   \
    unsigned b0 = cvtpk(P[BASE + 4], P[BASE + 5]), b1 = cvtpk(P[BASE + 6], P[BASE + 7]);                              \
    auto r0 = __builtin_amdgcn_permlane32_swap(a0, b0, false, false); auto r1 = __builtin_amdgcn_permlane32_swap(a1, b1, false, false); \
    u32x4 w = {r0[0], r1[0], r0[1], r1[1]}; OUT = __builtin_bit_cast(bf16x8, w); } while (0)
  PK4(p0, 0, pa0); PK4(p0, 8, pa1); PK4(p1, 0, pa2); PK4(p1, 8, pa3);
#undef PK4
}
DI void qkt(f32x16& p0, f32x16& p1, const LAS char* Ks, const bf16x8* qr, int r32, int hi, int mo) {
  p0 = f32x16{}; p1 = f32x16{};
#pragma unroll
  for (int d0 = 0; d0 < 4; ++d0) { const int cb = mo + (d0 * 16 + hi * 8) * 2;
    bf16x8 b0 = *(const LAS bf16x8*)(Ks + KSWZ(r32, cb));
    bf16x8 b1 = *(const LAS bf16x8*)(Ks + KSWZ(32 + r32, cb));
    p0 = __builtin_amdgcn_mfma_f32_32x32x16_bf16(b0, qr[d0], p0, 0, 0, 0);
    p1 = __builtin_amdgcn_mfma_f32_32x32x16_bf16(b1, qr[d0], p1, 0, 0, 0); }
}
DI int v_st(int k, int c) { const int kk = (k & ~0xC) | ((k & 4) << 1) | ((k & 8) >> 1); return ((kk >> 3) * 4 + (c >> 5)) * 512 + ((kk & 7) * 32 + (c & 31)) * 2; }
DI int v_rd_base(int lane) { return ((lane & 3) << 3) | (((lane >> 2) & 3) << 6) | (((lane >> 4) & 1) << 5) | (((lane >> 5) & 1) << 8); }
constexpr int v_rd_off(int d0, int ks, int half) { return d0 * 512 + ks * 4096 + half * 2048; }
template <int OFF> DI s16x4 tr_read(int vb) { s16x4 r; asm volatile("ds_read_b64_tr_b16 %0, %1 offset:%2" : "=&v"(r) : "v"(vb), "i"(OFF) : "memory"); return r; }
template <int D0> DI void pv_one(f32x16& od, int vb, bf16x8 pa0, bf16x8 pa1, bf16x8 pa2, bf16x8 pa3) {
  const s16x4 l0 = tr_read<v_rd_off(D0, 0, 0)>(vb), h0 = tr_read<v_rd_off(D0, 0, 1)>(vb), l1 = tr_read<v_rd_off(D0, 1, 0)>(vb), h1 = tr_read<v_rd_off(D0, 1, 1)>(vb);
  const s16x4 l2 = tr_read<v_rd_off(D0, 2, 0)>(vb), h2 = tr_read<v_rd_off(D0, 2, 1)>(vb), l3 = tr_read<v_rd_off(D0, 3, 0)>(vb), h3 = tr_read<v_rd_off(D0, 3, 1)>(vb);
  asm volatile("s_waitcnt lgkmcnt(0)" ::: "memory"); SBAR();
#define PK(L, H) (bf16x8){L[0], L[1], L[2], L[3], H[0], H[1], H[2], H[3]}
  od = __builtin_amdgcn_mfma_f32_32x32x16_bf16(pa0, PK(l0, h0), od, 0, 0, 0);
  od = __builtin_amdgcn_mfma_f32_32x32x16_bf16(pa1, PK(l1, h1), od, 0, 0, 0);
  od = __builtin_amdgcn_mfma_f32_32x32x16_bf16(pa2, PK(l2, h2), od, 0, 0, 0);
  od = __builtin_amdgcn_mfma_f32_32x32x16_bf16(pa3, PK(l3, h3), od, 0, 0, 0);
#undef PK
}
DI void pv_d0(f32x16* o, int vb, bf16x8 pa0, bf16x8 pa1, bf16x8 pa2, bf16x8 pa3) {
  pv_one<0>(o[0], vb, pa0, pa1, pa2, pa3); pv_one<1>(o[1], vb, pa0, pa1, pa2, pa3); pv_one<2>(o[2], vb, pa0, pa1, pa2, pa3); pv_one<3>(o[3], vb, pa0, pa1, pa2, pa3);
}
DI void attn_unit(const bf16_t* Qb, const bf16_t* Kb, const bf16_t* Vb, bf16_t* Ob, int h, int seq, float lam, float osc, const float* subg, LAS char* lds) {
  const int tid = threadIdx.x, wid = __builtin_amdgcn_readfirstlane(tid >> 6), lane = tid & 63, r32 = lane & 31, hi = lane >> 5;
  const int mbr = wid >> 2, wq = wid & 3, mo = mbr * 128;
  LAS char* V_lds = lds; LAS char* K_lds = lds + 2 * SHM_V;
  LAS float* wsl = (LAS float*)(lds + 2 * SHM_V + 2 * SHM_K) + wid * 64; LAS float* li_l = wsl; LAS float* al_l = wsl + 32;
  float m_reg = -1e30f, l_reg = 0; f32x16 o[4] = {}; bf16x8 qr[4];
  const bf16_t* Qw = Qb + (size_t)(wq * 32 + r32) * 1024 + mbr * 512 + h * 64 + hi * 8;
#pragma unroll
  for (int d0 = 0; d0 < 4; ++d0) qr[d0] = *(const bf16x8*)(Qw + d0 * 16);
  const int sr = tid >> 4, sc = (tid & 15) * 8, vst0 = v_st(sr, sc), vst1 = v_st(32 + sr, sc);
  const int kcol = (sc >> 6) * 512 + h * 64 + (sc & 63), vcol = h * 128 + sc;
  const int vb0 = (int)(uintptr_t)V_lds + v_rd_base(lane);
  bf16x8 vsA0, vsA1, ksA0, ksA1, vsB0, vsB1, ksB0, ksB1;
#define SLOADA(k0) do { vsA0 = *(const bf16x8*)(Vb + (size_t)((k0) + sr) * 1024 + vcol); vsA1 = *(const bf16x8*)(Vb + (size_t)((k0) + 32 + sr) * 1024 + vcol); \
    ksA0 = *(const bf16x8*)(Kb + (size_t)((k0) + sr) * 1024 + kcol); ksA1 = *(const bf16x8*)(Kb + (size_t)((k0) + 32 + sr) * 1024 + kcol); } while (0)
#define SLOADB(k0) do { vsB0 = *(const bf16x8*)(Vb + (size_t)((k0) + sr) * 1024 + vcol); vsB1 = *(const bf16x8*)(Vb + (size_t)((k0) + 32 + sr) * 1024 + vcol); \
    ksB0 = *(const bf16x8*)(Kb + (size_t)((k0) + sr) * 1024 + kcol); ksB1 = *(const bf16x8*)(Kb + (size_t)((k0) + 32 + sr) * 1024 + kcol); } while (0)
#define SWRITE(b, v0, v1, k0_, k1_) do { *(LAS bf16x8*)(V_lds + (b) * SHM_V + vst0) = v0; *(LAS bf16x8*)(V_lds + (b) * SHM_V + vst1) = v1; const int kc = sc * 2; \
    *(LAS bf16x8*)(K_lds + (b) * SHM_K + KSWZ(sr, kc)) = k0_; *(LAS bf16x8*)(K_lds + (b) * SHM_K + KSWZ(32 + sr, kc)) = k1_; } while (0)
#define SWAIT() asm volatile("s_waitcnt vmcnt(4)" ::: "memory")
#define RESC(a) do { if (__any((a) < 1.f)) { if (hi == 0) al_l[r32] = (a); asm volatile("s_waitcnt lgkmcnt(0)" ::: "memory"); \
    _Pragma("unroll") for (int d = 0; d < 4; ++d) _Pragma("unroll") for (int r = 0; r < 16; ++r) o[d][r] *= al_l[crow(r, hi)]; } } while (0)
  f32x16 pA0, pA1, pB0, pB1; float mnA, mnB, alA, alB; bf16x8 pa0, pa1, pa2, pa3; const int NT = seq / KVBLK;
  SLOADA(0); asm volatile("s_waitcnt vmcnt(0)" ::: "memory"); SWRITE(0, vsA0, vsA1, ksA0, ksA1); __syncthreads();
  qkt(pA0, pA1, K_lds, qr, r32, hi, mo); partialSM(pA0, pA1, m_reg, mnA, alA);
  SLOADB(KVBLK); if (2 < NT) SLOADA(2 * KVBLK);
  SWAIT(); SWRITE(1, vsB0, vsB1, ksB0, ksB1); __syncthreads();
  for (int j = 1; j + 1 < NT; j += 2) {
    SBAR(); qkt(pB0, pB1, K_lds + SHM_K, qr, r32, hi, mo);
    finishSM(pA0, pA1, alA, l_reg, pa0, pa1, pa2, pa3); SBAR();
    SLOADB((j + 2) * KVBLK); SBAR();
    pv_d0(o, vb0, pa0, pa1, pa2, pa3); partialSM(pB0, pB1, m_reg, mnB, alB);
    __syncthreads(); SWAIT(); SWRITE(0, vsA0, vsA1, ksA0, ksA1);
    RESC(alB); __syncthreads();
    SBAR(); qkt(pA0, pA1, K_lds, qr, r32, hi, mo);
    finishSM(pB0, pB1, alB, l_reg, pa0, pa1, pa2, pa3); SBAR();
    if (j + 3 < NT) SLOADA((j + 3) * KVBLK); SBAR();
    pv_d0(o, vb0 + SHM_V, pa0, pa1, pa2, pa3); partialSM(pA0, pA1, m_reg, mnA, alA);
    __syncthreads(); SWAIT(); SWRITE(1, vsB0, vsB1, ksB0, ksB1);
    RESC(alA); __syncthreads();
  }
  SBAR(); qkt(pB0, pB1, K_lds + SHM_K, qr, r32, hi, mo);
  finishSM(pA0, pA1, alA, l_reg, pa0, pa1, pa2, pa3); SBAR();
  pv_d0(o, vb0, pa0, pa1, pa2, pa3); partialSM(pB0, pB1, m_reg, mnB, alB);
  __syncthreads(); RESC(alB);
  finishSM(pB0, pB1, alB, l_reg, pa0, pa1, pa2, pa3); SBAR();
  pv_d0(o, vb0 + SHM_V, pa0, pa1, pa2, pa3);
  if (hi == 0) li_l[r32] = l_reg; asm volatile("s_waitcnt lgkmcnt(0)" ::: "memory");
  float rli[16];
#pragma unroll
  for (int r = 0; r < 16; ++r) rli[r] = 1.0f / li_l[crow(r, hi)];
  asm volatile("s_waitcnt vmcnt(0)" ::: "memory");
  __syncthreads();
  LAS float* ex = (LAS float*)lds;
  if (mbr == 1) {
#pragma unroll
    for (int r = 0; r < 16; ++r)
#pragma unroll
      for (int d0 = 0; d0 < 4; ++d0) ex[((wq * 16 + r) * 4 + d0) * 64 + lane] = o[d0][r] * rli[r] * lam;
  }
  asm volatile("s_waitcnt lgkmcnt(0)" ::: "memory");
  __syncthreads();
  if (mbr == 0) {
    float g[4];
#pragma unroll
    for (int d0 = 0; d0 < 4; ++d0) g[d0] = subg[d0 * 32 + r32] * osc;
    bf16_t* Ow = Ob + (size_t)(wq * 32) * 1024 + h * 128;
#pragma unroll
    for (int r = 0; r < 16; ++r) {
      float v[4]; float ss = 0.f;
#pragma unroll
      for (int d0 = 0; d0 < 4; ++d0) { v[d0] = o[d0][r] * rli[r] - ex[((wq * 16 + r) * 4 + d0) * 64 + lane]; ss += v[d0] * v[d0]; }
#pragma unroll
      for (int of = 1; of < 32; of <<= 1) ss += __shfl_xor(ss, of);
      const float rs = 1.0f / sqrtf(ss * (1.0f / 128.0f) + LN_EPS);
      const int orow = crow(r, hi);
#pragma unroll
      for (int d0 = 0; d0 < 4; ++d0) Ow[(size_t)orow * 1024 + d0 * 32 + r32] = (bf16_t)f2bf(v[d0] * rs * g[d0]);
    }
  }
  asm volatile("s_waitcnt lgkmcnt(0)" ::: "memory");
  __syncthreads();
#undef SLOADA
#undef SLOADB
#undef SWRITE
#undef SWAIT
#undef RESC
}
}

struct Args { const float* in[37]; float* out; unsigned char* ws; int ph_lo, ph_hi; };
struct Frame { LAS unsigned char* lds; int tid, lane, wave, G, bid, gw, NGW; };
enum { I_X = 0, I_C, I_CTX, I_CCTX, I_WADA, I_BADA, I_LNG, I_LNB, I_AWIN, I_AWOUT, I_ALAM, I_ASUB, I_S5WIN, I_S5ARE, I_S5AIM, I_S5BRE, I_S5BIM, I_S5CRE, I_S5CIM, I_S5LDT, I_S5D, I_S5GV, I_S5GG,
       I_LWIN, I_LCW, I_LCB, I_LWA, I_LBA, I_LWX, I_LBX, I_LLAM, I_LWOUT, I_RW, I_RB, I_MG, I_MU, I_MD };

DI void transpose_tile(const float* W, int ldw, int k0, int n0, bf16_t* WT, int ldt, int drow0, LAS float* scr, int lane) {
#pragma unroll 8
    for (int i = 0; i < 32; ++i) { const int kk = 2 * i + (lane >> 5); scr[kk * 33 + (lane & 31)] = W[(size_t)(k0 + kk) * ldw + n0 + (lane & 31)]; }
    LDS_WAIT(); asm volatile("" ::: "memory");
    const int c = lane & 7;
#pragma unroll
    for (int j = 0; j < 4; ++j) { const int n = (lane >> 3) + 8 * j; const LAS float* s = scr + (8 * c) * 33 + n;
        u32x4 o; o.x = pk2(s[0 * 33], s[1 * 33]); o.y = pk2(s[2 * 33], s[3 * 33]); o.z = pk2(s[4 * 33], s[5 * 33]); o.w = pk2(s[6 * 33], s[7 * 33]);
        *(u32x4*)(WT + (size_t)(drow0 + n) * ldt + k0 + 8 * c) = o; }
    LDS_WAIT(); asm volatile("" ::: "memory");
}
DI void transpose_item(const float* W, int K, int N, bf16_t* WT, int item, int drow_base, LAS float* scr, int lane) {
    const int nblk = N / 32, kb = item / nblk, nb = item % nblk;
    transpose_tile(W, N, 64 * kb, 32 * nb, WT, K, drow_base + 32 * nb, scr, lane);
}
DI void convert_moe_weights(const Args& a, const Frame& F, int li) {
    LAS float* scr = (LAS float*)(F.lds + F.wave * 16384);
    bf16_t* WGU = (bf16_t*)(a.ws + WS_WGU); bf16_t* WD = (bf16_t*)(a.ws + WS_WD);
    constexpr int PER = 16 * 32;
    for (int it = F.gw; it < 3 * 16 * PER; it += F.NGW) {
        const int which = it / (16 * PER), r = it % (16 * PER), e = r / PER, item = r % PER, kb = item / 32, nb = item % 32, n0 = 32 * nb;
        const size_t moff = ((size_t)(li * 16 + e)) * 1024 * 1024;
        if (which == 0)      transpose_tile(a.in[I_MG] + moff, 1024, 64 * kb, n0, WGU, 1024, e * 2048 + (n0 >> 7) * 256 + (n0 & 127), scr, F.lane);
        else if (which == 1) transpose_tile(a.in[I_MU] + moff, 1024, 64 * kb, n0, WGU, 1024, e * 2048 + (n0 >> 7) * 256 + 128 + (n0 & 127), scr, F.lane);
        else                 transpose_tile(a.in[I_MD] + moff, 1024, 64 * kb, n0, WD, 1024, e * 1024 + n0, scr, F.lane);
    }
}

DI void p0_prologue(const Args& a, const Frame& F) {
    LAS float* scr = (LAS float*)(F.lds + F.wave * 16384);
    unsigned char* ws = a.ws;
    {
        constexpr int I_AIN = 16 * 96, I_AOUT = 16 * 32, I_S5 = 16 * 32, I_LIN = 16 * 88, I_LOUT = 22 * 32;
        constexpr int NIT = 2 * I_AIN + 2 * I_AOUT + 3 * I_S5 + I_LIN + I_LOUT;
        for (int it = F.gw; it < NIT; it += F.NGW) {
            int r = it;
            if (r < 2 * I_AIN) { const int s = r / I_AIN; transpose_item(a.in[I_AWIN] + (size_t)s * 1024 * 3072, 1024, 3072, (bf16_t*)(ws + WS_WATT_IN) + (size_t)s * 3072 * 1024, r % I_AIN, 0, scr, F.lane); continue; } r -= 2 * I_AIN;
            if (r < 2 * I_AOUT) { const int s = r / I_AOUT; transpose_item(a.in[I_AWOUT] + (size_t)s * 1024 * 1024, 1024, 1024, (bf16_t*)(ws + WS_WATT_OUT) + (size_t)s * 1024 * 1024, r % I_AOUT, 0, scr, F.lane); continue; } r -= 2 * I_AOUT;
            if (r < I_S5) { transpose_item(a.in[I_S5WIN], 1024, 1024, (bf16_t*)(ws + WS_WS5_IN), r, 0, scr, F.lane); continue; } r -= I_S5;
            if (r < 2 * I_S5) { const int which = r / I_S5, item = r % I_S5, kb = item / 32, nb = item % 32, n0 = 32 * nb;
                transpose_tile(a.in[which ? I_S5GG : I_S5GV], 1024, 64 * kb, n0, (bf16_t*)(ws + WS_WS5_GLU), 1024, (n0 >> 7) * 256 + which * 128 + (n0 & 127), scr, F.lane); continue; } r -= 2 * I_S5;
            if (r < I_LIN) { transpose_item(a.in[I_LWIN], 1024, 2816, (bf16_t*)(ws + WS_WLRU_IN), r, 0, scr, F.lane); continue; } r -= I_LIN;
            transpose_item(a.in[I_LWOUT], 1408, 1024, (bf16_t*)(ws + WS_WLRU_OUT), r, 0, scr, F.lane);
        }
    }
    __syncthreads();
    if (F.bid < 192) {
        LAS float* sl = (LAS float*)F.lds;
        for (int i = F.tid; i < 9 * 1024; i += 512) { const int r = i >> 10, k = i & 1023; const float v = (r < 8) ? a.in[I_C][r * 1024 + k] : a.in[I_CCTX][k]; sl[i] = v / (1.0f + __expf(-v)); }
        __syncthreads();
        const int ks = F.gw / 96, cg = F.gw % 96, col4 = cg * 64 + F.lane, layer = col4 / 1536, c4 = (col4 % 1536) * 4;
        f32x4 acc[9];
#pragma unroll
        for (int r = 0; r < 9; ++r) acc[r] = (f32x4){0.f, 0.f, 0.f, 0.f};
        const float* wp = a.in[I_WADA] + (size_t)layer * 1024 * 6144 + (size_t)(ks * 64) * 6144 + c4;
#pragma unroll 4
        for (int k = 0; k < 64; ++k) { const f32x4 w = *(const f32x4*)(wp + (size_t)k * 6144);
#pragma unroll
            for (int r = 0; r < 9; ++r) { const float s = sl[r * 1024 + ks * 64 + k]; acc[r] += w * s; } }
        float* mp = (float*)(ws + WS_MODP) + ((size_t)(ks * 4 + layer) * 9) * 6144 + c4;
#pragma unroll
        for (int r = 0; r < 9; ++r) *(f32x4*)(mp + (size_t)r * 6144) = acc[r];
        __syncthreads();
    }
    const int gt = F.bid * 512 + F.tid, NGT = F.G * 512;
    for (int t = gt; t < 8192; t += NGT) {
        const int p = t & 63;
        const float dt = expf(a.in[I_S5LDT][t >> 6]);
        const float Ar = a.in[I_S5ARE][t], Ai = a.in[I_S5AIM][t];
        const float mag = expf(Ar * dt); float sn, cs; sincos_cw(Ai * dt, sn, cs);
        const float zr = mag * cs, zi = mag * sn, den = Ar * Ar + Ai * Ai;
        const float kr = ((zr - 1.0f) * Ar + zi * Ai) / den, ki = (zi * Ar - (zr - 1.0f) * Ai) / den;
        ((float*)(ws + WS_PAR + PAR_ZR))[t] = zr; ((float*)(ws + WS_PAR + PAR_ZI))[t] = zi;
#pragma unroll
        for (int n = 0; n < 16; ++n) { const float br = a.in[I_S5BRE][(size_t)t * 16 + n], bi = a.in[I_S5BIM][(size_t)t * 16 + n];
            ((float*)(ws + WS_PAR + PAR_BBR))[(size_t)t * 16 + n] = kr * br - ki * bi; ((float*)(ws + WS_PAR + PAR_BBI))[(size_t)t * 16 + n] = kr * bi + ki * br; }
        (void)p;
    }
    for (int t = gt; t < 8192 * 33; t += NGT) {
        const int sidx = t / 33, tau = t % 33; const float dt = expf(a.in[I_S5LDT][sidx >> 6]);
        const float Ar = a.in[I_S5ARE][sidx], Ai = a.in[I_S5AIM][sidx]; const float mag = expf((float)tau * (Ar * dt)); float sn, cs; sincos_cw((float)tau * (Ai * dt), sn, cs);
        ((f32x2*)(ws + WS_S5ZP))[t] = (f32x2){mag * cs, mag * sn};
    }
    for (int t = gt; t < 1024; t += NGT) {
        const int pos = t >> 4, j = t & 15; const float freq = exp2f(-(float)j * (13.287712379549449f / 16.0f)); float sn, cs; sincos_cw((float)pos * freq, sn, cs);
        ((f32x2*)(ws + WS_PAR + PAR_ROPE))[t] = (f32x2){cs, sn};
    }
    for (int t = gt; t < 2 * LRUW; t += NGT) ((float*)(ws + WS_PAR + PAR_SP))[t] = log1pf(expf(-a.in[I_LLAM][t]));
    for (int t = gt; t < 2 * 2 * 16 * 96 * 96; t += NGT) {
        const int d = t % 96, e = (t / 96) % 96, n = (t / 9216) % 16, mat = (t / (9216 * 16)) % 2, dir = t / (9216 * 32);
        float v = 0.f; if (d < 88 && e < 88) v = a.in[mat ? I_LWX : I_LWA][(((size_t)dir * 16 + n) * 88 + d) * 88 + e];
        ((bf16_t*)(ws + WS_BD))[t] = (bf16_t)f2bf(v);
    }
}
DI void p0b_modreduce(const Args& a, const Frame& F) {
    const int gt = F.bid * 512 + F.tid, NGT = F.G * 512;
    for (int t = gt; t < 4 * 9 * 1536; t += NGT) {
        const int c4 = (t % 1536) * 4, lr = t / 1536, layer = lr / 9;
        f32x4 s = *(const f32x4*)(a.in[I_BADA] + (size_t)layer * 6144 + c4);
#pragma unroll
        for (int ks = 0; ks < 16; ++ks) s += *(const f32x4*)((const float*)(a.ws + WS_MODP) + ((size_t)ks * 36 + lr) * 6144 + c4);
        *(f32x4*)((float*)(a.ws + WS_MOD) + (size_t)lr * 6144 + c4) = s;
    }
}
DI void s5_tables_a(const Args& a, const Frame& F) {
    const int gt = F.bid * 512 + F.tid, NGT = F.G * 512;
    const f32x2* ZP = (const f32x2*)(a.ws + WS_S5ZP); const float* BBR = (const float*)(a.ws + WS_PAR + PAR_BBR); const float* BBI = (const float*)(a.ws + WS_PAR + PAR_BBI);
    for (int t = gt; t < 64 * 2 * 32 * 16; t += NGT) {
        const int no = t & 15, tau = (t >> 4) & 31, dir = (t >> 9) & 1, g = t >> 10;
        float acc[16];
#pragma unroll
        for (int ni = 0; ni < 16; ++ni) acc[ni] = 0.f;
        for (int p = 0; p < 64; ++p) {
            const int sidx = (dir * 64 + g) * 64 + p; const f32x2 z = ZP[sidx * 33 + tau];
            const float cr = a.in[I_S5CRE][((size_t)(dir * 64 + g) * 16 + no) * 64 + p], ci = a.in[I_S5CIM][((size_t)(dir * 64 + g) * 16 + no) * 64 + p];
            const float wr = cr * z.x - ci * z.y, wi = cr * z.y + ci * z.x;
#pragma unroll
            for (int ni = 0; ni < 16; ++ni) acc[ni] += wr * BBR[(size_t)sidx * 16 + ni] - wi * BBI[(size_t)sidx * 16 + ni];
        }
        float* kt = (float*)(a.ws + WS_S5KT) + (size_t)t * 16;
#pragma unroll
        for (int ni = 0; ni < 16; ++ni) kt[ni] = acc[ni];
    }
    for (int t = gt; t < 64 * 8 * 32 * 64; t += NGT) {
        const int lane = t & 63, ks = (t >> 6) & 31, cb = (t >> 11) & 7, g = t >> 14;
        const int col = cb * 32 + (lane & 31), dir = col >> 7, reim = (col >> 6) & 1, p = col & 63, n0 = 8 * (lane >> 5);
        const int sidx = (dir * 64 + g) * 64 + p; const f32x2 z = ZP[sidx * 33 + (dir ? ks : 31 - ks)];
        float v[8];
#pragma unroll
        for (int j = 0; j < 8; ++j) { const float br = BBR[(size_t)sidx * 16 + n0 + j], bi = BBI[(size_t)sidx * 16 + n0 + j]; v[j] = reim ? (z.x * bi + z.y * br) : (z.x * br - z.y * bi); }
        u32x4 o; o.x = pk2(v[0], v[1]); o.y = pk2(v[2], v[3]); o.z = pk2(v[4], v[5]); o.w = pk2(v[6], v[7]);
        *(u32x4*)((bf16_t*)(a.ws + WS_S5W1) + (size_t)t * 8) = o;
    }
    for (int t = gt; t < 64 * 16 * 16 * 64; t += NGT) {
        const int lane = t & 63, ks = 32 + ((t >> 6) & 15), cb = (t >> 10) & 15, g = t >> 14;
        const int col = cb * 32 + (lane & 31), to = col >> 4, no = col & 15, kk0 = (ks - 32) * 16 + 8 * (lane >> 5), dir = kk0 >> 7, reim = (kk0 >> 6) & 1, p0 = kk0 & 63;
        float v[8];
#pragma unroll
        for (int j = 0; j < 8; ++j) { const int p = p0 + j; const int sidx = (dir * 64 + g) * 64 + p; const f32x2 z = ZP[sidx * 33 + (dir ? 32 - to : to + 1)];
            const float cr = a.in[I_S5CRE][((size_t)(dir * 64 + g) * 16 + no) * 64 + p], ci = a.in[I_S5CIM][((size_t)(dir * 64 + g) * 16 + no) * 64 + p];
            v[j] = reim ? -(cr * z.y + ci * z.x) : (cr * z.x - ci * z.y); }
        u32x4 o; o.x = pk2(v[0], v[1]); o.y = pk2(v[2], v[3]); o.z = pk2(v[4], v[5]); o.w = pk2(v[6], v[7]);
        *(u32x4*)((bf16_t*)(a.ws + WS_S5W2) + (((size_t)(g * 16 + cb) * 48 + ks) * 64 + lane) * 8) = o;
    }
}
DI void s5_tables_b(const Args& a, const Frame& F) {
    const int gt = F.bid * 512 + F.tid, NGT = F.G * 512;
    const float* KT = (const float*)(a.ws + WS_S5KT);
    for (int t = gt; t < 64 * 16 * 32 * 64; t += NGT) {
        const int lane = t & 63, ti = (t >> 6) & 31, cb = (t >> 11) & 15, g = t >> 15;
        const int col = cb * 32 + (lane & 31), to = col >> 4, no = col & 15, n0 = 8 * (lane >> 5);
        float v[8];
#pragma unroll
        for (int j = 0; j < 8; ++j) v[j] = 0.f;
        if (ti <= to) { const float* k0 = KT + ((((size_t)(g * 2 + 0) * 32 + (to - ti)) * 16 + no) * 16 + n0);
#pragma unroll
            for (int j = 0; j < 8; ++j) v[j] += k0[j]; }
        if (ti >= to) { const float* k1 = KT + ((((size_t)(g * 2 + 1) * 32 + (ti - to)) * 16 + no) * 16 + n0);
#pragma unroll
            for (int j = 0; j < 8; ++j) v[j] += k1[j]; }
        if (ti == to) {
#pragma unroll
            for (int j = 0; j < 8; ++j) if (n0 + j == no) v[j] += a.in[I_S5D][g * 16 + no]; }
        u32x4 o; o.x = pk2(v[0], v[1]); o.y = pk2(v[2], v[3]); o.z = pk2(v[4], v[5]); o.w = pk2(v[6], v[7]);
        *(u32x4*)((bf16_t*)(a.ws + WS_S5W2) + (((size_t)(g * 16 + cb) * 48 + ti) * 64 + lane) * 8) = o;
    }
}
DI const float* mod_row(const Args& a, int li, int row) { const int p = row % LSEQ, b = row / LSEQ; return (const float*)(a.ws + WS_MOD) + (size_t)(li * 9 + (p < CN ? 8 : b)) * 6144; }
DI void store_h(bf16_t* hrow, int lane, const f32x4 (&v)[4]) {
#pragma unroll
    for (int j = 0; j < 4; ++j) { u32x2 w; w.x = pk2(v[j][0], v[j][1]); w.y = pk2(v[j][2], v[j][3]); *(u32x2*)(hrow + 4 * lane + 256 * j) = w; }
}
DI void p1_init(const Args& a, const Frame& F) {
    float* X = (float*)(a.ws + WS_X); bf16_t* H = (bf16_t*)(a.ws + WS_H);
    for (int row = F.gw; row < MROWS; row += F.NGW) {
        const int b = row / LSEQ, p = row % LSEQ;
        const float* src = (p < CN) ? a.in[I_CTX] + ((size_t)b * CN + p) * D : a.in[I_X] + ((size_t)b * TL + (p - CN)) * D;
        const float* mr = mod_row(a, 0, row);
        f32x4 v[4], h[4];
#pragma unroll
        for (int j = 0; j < 4; ++j) { const int c = 4 * F.lane + 256 * j; v[j] = *(const f32x4*)(src + c); const f32x4 sh = *(const f32x4*)(mr + c), sc = *(const f32x4*)(mr + 1024 + c);
            h[j] = v[j] * (sc + 1.0f) + sh; *(f32x4*)(X + (size_t)row * D + c) = v[j]; }
        store_h(H + (size_t)row * D, F.lane, h);
    }
}
DI void ln_row(f32x4 (&v)[4], const float* g, const float* bta, int lane) {
    float s = 0.f;
#pragma unroll
    for (int j = 0; j < 4; ++j) s += (v[j][0] + v[j][1]) + (v[j][2] + v[j][3]);
    const float mean = wave_sum(s) * (1.0f / D); float q = 0.f;
#pragma unroll
    for (int j = 0; j < 4; ++j) { v[j] = v[j] - mean; q += (v[j][0] * v[j][0] + v[j][1] * v[j][1]) + (v[j][2] * v[j][2] + v[j][3] * v[j][3]); }
    const float rstd = 1.0f / sqrtf(wave_sum(q) * (1.0f / D) + LN_EPS);
#pragma unroll
    for (int j = 0; j < 4; ++j) { const int c = 4 * lane + 256 * j; v[j] = v[j] * rstd * *(const f32x4*)(g + c) + *(const f32x4*)(bta + c); }
}

DI void m0_route(const Args& a, const Frame& F, int li) {
    convert_moe_weights(a, F, li);
    __syncthreads();
    LAS float* rw = (LAS float*)F.lds;
    LAS int* lcnt = (LAS int*)(F.lds + 65536);
    LAS int* rinfo = (LAS int*)(F.lds + 65536 + 256);
    LAS float* rwt = (LAS float*)(F.lds + 65536 + 256 + 8 * 9 * 16);
    for (int i = F.tid; i < 16 * 1024; i += 512) { const int k = i >> 4, e = i & 15; rw[e * 1024 + k] = a.in[I_RW][i]; }
    if (F.tid < 32) lcnt[F.tid] = 0;
    __syncthreads();
    float* X = (float*)(a.ws + WS_X); bf16_t* H = (bf16_t*)(a.ws + WS_H);
    const float* lg = a.in[I_LNG] + (size_t)(li * 2 + 0) * D; const float* lb = a.in[I_LNB] + (size_t)(li * 2 + 0) * D;
    int nrows = 0;
    for (int row = F.gw; row < MROWS; row += F.NGW, ++nrows) {
        const float* mr = mod_row(a, li, row);
        f32x4 v[4], h[4];
#pragma unroll
        for (int j = 0; j < 4; ++j) v[j] = *(const f32x4*)(X + (size_t)row * D + 4 * F.lane + 256 * j);
        ln_row(v, lg, lb, F.lane);
#pragma unroll
        for (int j = 0; j < 4; ++j) { const int c = 4 * F.lane + 256 * j; *(f32x4*)(X + (size_t)row * D + c) = v[j]; const f32x4 sh = *(const f32x4*)(mr + 3072 + c), sc = *(const f32x4*)(mr + 4096 + c); h[j] = v[j] * (sc + 1.0f) + sh; }
        store_h(H + (size_t)row * D, F.lane, h);
        float lg16[16];
#pragma unroll
        for (int e = 0; e < 16; ++e) { float s = 0.f;
#pragma unroll
            for (int j = 0; j < 4; ++j) { const f32x4 w = *(const LAS f32x4*)(rw + e * 1024 + 4 * F.lane + 256 * j); s += (h[j][0] * w[0] + h[j][1] * w[1]) + (h[j][2] * w[2] + h[j][3] * w[3]); }
            lg16[e] = wave_sum(s); }
        float mx = lg16[0];
#pragma unroll
        for (int e = 1; e < 16; ++e) mx = fmaxf(mx, lg16[e]);
        float pr[16], sum = 0.f;
#pragma unroll
        for (int e = 0; e < 16; ++e) { pr[e] = expf(lg16[e] - mx); sum += pr[e]; }
        const float inv = 1.0f / sum;
        float bestg = -3.0e38f; int e1 = 0, e2 = 1; float p1 = 0.f, p2 = 0.f;
#pragma unroll
        for (int g = 0; g < 4; ++g) {
            float b1 = -3.0e38f, b2 = -3.0e38f; int i1 = 0, i2 = 0; float q1 = 0.f, q2 = 0.f;
#pragma unroll
            for (int k = 0; k < 4; ++k) { const float p = pr[4 * g + k] * inv; const float sv = p + a.in[I_RB][4 * g + k];
                if (sv > b1) { b2 = b1; i2 = i1; q2 = q1; b1 = sv; i1 = 4 * g + k; q1 = p; } else if (sv > b2) { b2 = sv; i2 = 4 * g + k; q2 = p; } }
            const float gs = b1 + b2;
            if (gs > bestg) { bestg = gs; e1 = i1; e2 = i2; p1 = q1; p2 = q2; }
        }
        const float wn = 1.0f / (p1 + p2);
        if (F.lane == 0) { const int lp1 = atomicAdd((int*)&lcnt[e1], 1), lp2 = atomicAdd((int*)&lcnt[e2], 1);
            LAS int* ri = rinfo + (F.wave * 9 + nrows) * 4; ri[0] = e1; ri[1] = lp1; ri[2] = e2; ri[3] = lp2;
            rwt[(F.wave * 9 + nrows) * 2 + 0] = p1 * wn; rwt[(F.wave * 9 + nrows) * 2 + 1] = p2 * wn; }
    }
    LDS_WAIT();
    __syncthreads();
    if (F.tid < 16) lcnt[16 + F.tid] = (int)__hip_atomic_fetch_add((unsigned*)(a.ws + WS_CTL) + CW_CNT + (li * 16 + F.tid) * 64, (unsigned)lcnt[F.tid], RLX_AGENT);
    LDS_WAIT();
    __syncthreads();
    if (F.lane == 0) {
        unsigned* tok = (unsigned*)(a.ws + WS_TOK); int* lists = (int*)(a.ws + WS_TOK + MiB);
        int k = 0;
        for (int row = F.gw; row < MROWS; row += F.NGW, ++k) {
            const LAS int* ri = rinfo + (F.wave * 9 + k) * 4; const int e1 = ri[0], e2 = ri[2]; const int pos1 = lcnt[16 + e1] + ri[1], pos2 = lcnt[16 + e2] + ri[3];
            lists[(size_t)e1 * MROWS + pos1] = row; lists[(size_t)e2 * MROWS + pos2] = row;
            u32x4 w0; w0.x = (unsigned)e1; w0.y = (unsigned)pos1; w0.z = (unsigned)e2; w0.w = (unsigned)pos2;
            *(u32x4*)(tok + (size_t)row * 8) = w0; tok[(size_t)row * 8 + 4] = __float_as_uint(rwt[(F.wave * 9 + k) * 2]); tok[(size_t)row * 8 + 5] = __float_as_uint(rwt[(F.wave * 9 + k) * 2 + 1]);
        }
    }
}
DI int moe_tile_table(const Args& a, const Frame& F, int li) {
    LAS int* tb = (LAS int*)(F.lds + TB_OFF);
    if (F.tid < 64) {
        int c = 0; if (F.lane < 16) c = (int)__hip_atomic_load((unsigned*)(a.ws + WS_CTL) + CW_CNT + (li * 16 + F.lane) * 64, RLX_AGENT);
        const int nt = (c + 255) >> 8; int inc = nt;
#pragma unroll
        for (int o = 1; o < 16; o <<= 1) { const int t = __shfl_up(inc, o); if (F.lane >= o) inc += t; }
        if (F.lane < 16) { tb[F.lane] = inc - nt; tb[32 + F.lane] = c; }
        if (F.lane == 15) tb[16] = inc;
    }
    LDS_WAIT();
    __syncthreads();
    return tb[16];
}
DI void m1_gateup(const Args& a, const Frame& F, int li) {
    const int NT = moe_tile_table(a, F, li);
    LAS int* tb = (LAS int*)(F.lds + TB_OFF); LAS unsigned* tab = (LAS unsigned*)(F.lds + TAB_OFF);
    pg8::MoeSched<true, 8> S; S.A = (const char*)(a.ws + WS_H); S.Bt = (const char*)(a.ws + WS_WGU); S.tb = tb; S.tab = tab; S.NT = NT; S.G = F.G; S.c = F.bid; S.estride = (size_t)2048 * 1024 * 2;
    const int* lists = (const int*)(a.ws + WS_TOK + MiB);
    pg8::Unit u;
    for (int i = 0; i < 8 && S.next(i, u); ++i) {
        if (F.tid < 256) { const int cnt = tb[32 + u.e], idx = (u.pm - tb[u.e]) * 256 + F.tid; const int tokr = lists[(size_t)u.e * MROWS + (idx < cnt ? idx : 0)]; tab[i * 256 + F.tid] = (unsigned)tokr * 2048u; }
    }
    LDS_WAIT();
    __syncthreads();
    pg8::EpiSwiGLU E{(bf16_t*)(a.ws + WS_HID)};
    pg8::gemm_phase<pg8::EpiSwiGLU, pg8::MoeSched<true, 8>>(F.lds, 1024, S, E);
}
DI void m2_down(const Args& a, const Frame& F, int li) {
    const int NT = moe_tile_table(a, F, li);
    LAS int* tb = (LAS int*)(F.lds + TB_OFF);
    pg8::MoeSched<false, 4> S; S.A = (const char*)(a.ws + WS_HID); S.Bt = (const char*)(a.ws + WS_WD); S.tb = tb; S.tab = nullptr; S.NT = NT; S.G = F.G; S.c = F.bid; S.estride = (size_t)1024 * 1024 * 2;
    pg8::EpiBf16 E{(bf16_t*)(a.ws + WS_YEXP), 1024, 0, 0};
    pg8::gemm_phase<pg8::EpiBf16, pg8::MoeSched<false, 4>>(F.lds, 1024, S, E);
}
DI void m3_combine(const Args& a, const Frame& F, int li) {
    (void)moe_tile_table(a, F, li);
    const LAS int* tb = (const LAS int*)(F.lds + TB_OFF);
    float* X = (float*)(a.ws + WS_X); bf16_t* H = (bf16_t*)(a.ws + WS_H); const bf16_t* Y = (const bf16_t*)(a.ws + WS_YEXP);
    const unsigned* tok = (const unsigned*)(a.ws + WS_TOK);
    const float* lg = a.in[I_LNG] + (size_t)(li * 2 + 1) * D; const float* lb = a.in[I_LNB] + (size_t)(li * 2 + 1) * D;
    for (int row = F.gw; row < MROWS; row += F.NGW) {
        const u32x4 t0 = *(const u32x4*)(tok + (size_t)row * 8); const float w1 = __uint_as_float(tok[(size_t)row * 8 + 4]), w2 = __uint_as_float(tok[(size_t)row * 8 + 5]);
        const int e1 = __builtin_amdgcn_readfirstlane((int)t0.x), e2 = __builtin_amdgcn_readfirstlane((int)t0.z);
        const size_t s1 = (size_t)tb[e1] * 256 + t0.y, s2 = (size_t)tb[e2] * 256 + t0.w;
        const float* mr = mod_row(a, li, row);
        f32x4 v[4];
#pragma unroll
        for (int j = 0; j < 4; ++j) { const int c = 4 * F.lane + 256 * j;
            const u32x2 y1 = *(const u32x2*)(Y + s1 * 1024 + c), y2 = *(const u32x2*)(Y + s2 * 1024 + c);
            f32x4 y; y[0] = w1 * bflo(y1.x) + w2 * bflo(y2.x); y[1] = w1 * bfhi(y1.x) + w2 * bfhi(y2.x); y[2] = w1 * bflo(y1.y) + w2 * bflo(y2.y); y[3] = w1 * bfhi(y1.y) + w2 * bfhi(y2.y);
            const f32x4 g2 = *(const f32x4*)(mr + 5120 + c);
            v[j] = *(const f32x4*)(X + (size_t)row * D + c) * DN_ALPHA + g2 * y; }
        ln_row(v, lg, lb, F.lane);
        if (li < DEPTH - 1) {
            const float* mn = mod_row(a, li + 1, row); f32x4 h[4];
#pragma unroll
            for (int j = 0; j < 4; ++j) { const int c = 4 * F.lane + 256 * j; *(f32x4*)(X + (size_t)row * D + c) = v[j]; const f32x4 sh = *(const f32x4*)(mn + c), sc = *(const f32x4*)(mn + 1024 + c); h[j] = v[j] * (sc + 1.0f) + sh; }
            store_h(H + (size_t)row * D, F.lane, h);
        } else {
            const int b = row / LSEQ, p = row % LSEQ;
            if (p >= CN) { float* o = a.out + ((size_t)b * TL + (p - CN)) * D;
#pragma unroll
                for (int j = 0; j < 4; ++j) *(f32x4*)(o + 4 * F.lane + 256 * j) = v[j]; }
        }
    }
}

DI void a1_qkv(const Args& a, const Frame& F, int slot) {
    pg8::DenseSched S; S.init(a.ws + WS_H, a.ws + WS_WATT_IN + (size_t)slot * 3072 * 1024 * 2, MROWS, 3072, 1024, F.G, F.bid);
    pg8::EpiBf16 E{(bf16_t*)(a.ws + MX_Q), 1024, 1024, (size_t)MROWS * 1024};
    pg8::gemm_phase<pg8::EpiBf16, pg8::DenseSched>(F.lds, 1024, S, E);
}
DI void a1b_rope(const Args& a, const Frame& F) {
    const f32x2* tabl = (const f32x2*)(a.ws + WS_PAR + PAR_ROPE);
    const int quarter = F.lane & 3, colb = (F.lane >> 2) * 64 + quarter * 16;
    for (int it = F.gw; it < 2 * NB * TL; it += F.NGW) {
        const int which = it & 1, lr = it >> 1, b = lr / TL, t = lr % TL;
        bf16_t* p = (bf16_t*)(a.ws + (which ? MX_K : MX_Q)) + ((size_t)b * LSEQ + CN + t) * 1024 + colb;
        const int pos = (quarter < 2) ? (t >> 6) : (t & 63);
        u32x4 w0 = *(const u32x4*)p, w1 = *(const u32x4*)(p + 8);
        unsigned wi[8] = {w0.x, w0.y, w0.z, w0.w, w1.x, w1.y, w1.z, w1.w}; unsigned wo[8];
#pragma unroll
        for (int q = 0; q < 8; ++q) {
            const float m0 = bflo(wi[q]), m1 = bfhi(wi[q]);
            const float o0 = __shfl_xor(m0, 1), o1 = __shfl_xor(m1, 1);
            const f32x2 cs0 = tabl[pos * 16 + 2 * q], cs1 = tabl[pos * 16 + 2 * q + 1];
            const float sg = (quarter & 1) ? 1.0f : -1.0f;
            wo[q] = pk2(m0 * cs0.x + sg * o0 * cs0.y, m1 * cs1.x + sg * o1 * cs1.y);
        }
        *(u32x4*)p = (u32x4){wo[0], wo[1], wo[2], wo[3]}; *(u32x4*)(p + 8) = (u32x4){wo[4], wo[5], wo[6], wo[7]};
    }
}
DI void a2_attention(const Args& a, const Frame& F, int li, int slot) {
    const float lam_init = (li == 0) ? 0.2f : 0.55605820415562f;
    const float* lm = a.in[I_ALAM] + (size_t)slot * 4 * 64;
    const float s0 = wave_sum(lm[F.lane] * lm[64 + F.lane]), s1 = wave_sum(lm[128 + F.lane] * lm[192 + F.lane]);
    const float lamf = expf(s0) - expf(s1) + lam_init;
    const bf16_t* Q = (const bf16_t*)(a.ws + MX_Q); const bf16_t* K = (const bf16_t*)(a.ws + MX_K); const bf16_t* V = (const bf16_t*)(a.ws + MX_V); bf16_t* AO = (bf16_t*)(a.ws + MX_AO);
    const float* subg = a.in[I_ASUB] + (size_t)slot * 128;
    const int v = (F.G % 8 == 0) ? (F.bid % 8) * (F.G / 8) + F.bid / 8 : F.bid;
    for (int u = v; u < 1024 + 128; u += F.G) {
        int b, h, row0, seq;
        if (u < 1024) { const int bh = u >> 4, qb = u & 15; b = bh >> 3; h = bh & 7; row0 = b * LSEQ + CN + qb * 128; seq = LSEQ; }
        else { const int w = u - 1024, bh = w >> 1, qb = w & 1; b = bh >> 3; h = bh & 7; row0 = b * LSEQ + qb * 128; seq = CN; }
        att::attn_unit(Q + (size_t)row0 * 1024, K + (size_t)b * LSEQ * 1024, V + (size_t)b * LSEQ * 1024, AO + (size_t)row0 * 1024, h, seq, lamf, 1.0f - lam_init, subg, (LAS char*)F.lds);
    }
}
DI void a3_wout(const Args& a, const Frame& F, int li, int slot) {
    pg8::DenseSched S; S.init(a.ws + MX_AO, a.ws + WS_WATT_OUT + (size_t)slot * 1024 * 1024 * 2, MROWS, 1024, 1024, F.G, F.bid);
    pg8::EpiResid E{(float*)(a.ws + WS_X), (const float*)(a.ws + WS_MOD) + (size_t)li * 9 * 6144 + 2048};
    pg8::gemm_phase<pg8::EpiResid, pg8::DenseSched>(F.lds, 1024, S, E);
}

DI void s1_win(const Args& a, const Frame& F) {
    pg8::DenseSched S; S.init(a.ws + WS_H, a.ws + WS_WS5_IN, MROWS, 1024, 1024, F.G, F.bid);
    pg8::EpiBf16 E{(bf16_t*)(a.ws + MX_U), 1024, 0, 0};
    pg8::gemm_phase<pg8::EpiBf16, pg8::DenseSched>(F.lds, 1024, S, E);
}
template <int MODE> DI void s5_mm(const Args& a, const Frame& F) {
    constexpr int KS = MODE == 1 ? 32 : 48, NCB = MODE == 1 ? 1 : 2, NCBT = 8 * NCB, LDA = KS * 16 + 8;
    LAS bf16_t* At = (LAS bf16_t*)F.lds;
    const bf16_t* Ub = (const bf16_t*)(a.ws + MX_U); const bf16_t* Hin = (const bf16_t*)(a.ws + MX_HIN);
    const bf16_t* Wf = (const bf16_t*)(a.ws + (MODE == 1 ? WS_S5W1 : WS_S5W2));
    const int r32 = F.lane & 31, hh = F.lane >> 5;
    const int v = (F.G % 8 == 0) ? (F.bid % 8) * (F.G / 8) + F.bid / 8 : F.bid;
    for (int u = v; u < 576; u += F.G) {
        const int g = u / 9, rt = u % 9;
        for (int idx = F.tid; idx < 4096; idx += 512) { const int i = idx >> 6, rem = idx & 63, t = rem >> 1, nh = rem & 1, r = rt * 64 + i, b = r / 72, c = r % 72;
            const u32x4 w = *(const u32x4*)(Ub + ((size_t)(b * LSEQ + c * 32 + t) * 1024 + g * 16 + nh * 8)); *(LAS u32x4*)(At + i * LDA + t * 16 + nh * 8) = w; }
        if (MODE == 2) {
            for (int idx = F.tid; idx < 2048; idx += 512) { const int i = idx >> 5, q = idx & 31, r = rt * 64 + i;
                const u32x4 w = *(const u32x4*)(Hin + ((size_t)r * 64 + g) * 256 + q * 8); *(LAS u32x4*)(At + i * LDA + 512 + q * 8) = w; }
        }
        LDS_WAIT();
        __syncthreads();
        f32x16 acc[2][NCB];
#pragma unroll
        for (int rb = 0; rb < 2; ++rb)
#pragma unroll
            for (int cb = 0; cb < NCB; ++cb) acc[rb][cb] = f32x16{};
        const bf16_t* wb = Wf + ((size_t)(g * NCBT + F.wave * NCB) * KS) * 512 + F.lane * 8;
        bf16x8 bq[4][NCB], bn[4][NCB];
#pragma unroll
        for (int q = 0; q < 4; ++q)
#pragma unroll
            for (int cb = 0; cb < NCB; ++cb) bq[q][cb] = *(const bf16x8*)(wb + ((size_t)cb * KS + q) * 512);
        for (int k0 = 0; k0 < KS; k0 += 4) {
            if (k0 + 4 < KS) {
#pragma unroll
                for (int q = 0; q < 4; ++q)
#pragma unroll
                    for (int cb = 0; cb < NCB; ++cb) bn[q][cb] = *(const bf16x8*)(wb + ((size_t)cb * KS + k0 + 4 + q) * 512);
            }
#pragma unroll
            for (int q = 0; q < 4; ++q) {
                const bf16x8 a0 = *(const LAS bf16x8*)(At + r32 * LDA + (k0 + q) * 16 + 8 * hh), a1 = *(const LAS bf16x8*)(At + (32 + r32) * LDA + (k0 + q) * 16 + 8 * hh);
#pragma unroll
                for (int cb = 0; cb < NCB; ++cb) { acc[0][cb] = __builtin_amdgcn_mfma_f32_32x32x16_bf16(a0, bq[q][cb], acc[0][cb], 0, 0, 0); acc[1][cb] = __builtin_amdgcn_mfma_f32_32x32x16_bf16(a1, bq[q][cb], acc[1][cb], 0, 0, 0); }
            }
#pragma unroll
            for (int q = 0; q < 4; ++q)
#pragma unroll
                for (int cb = 0; cb < NCB; ++cb) bq[q][cb] = bn[q][cb];
        }
#pragma unroll
        for (int rb = 0; rb < 2; ++rb)
#pragma unroll
            for (int reg = 0; reg < 16; ++reg) {
                const int r = rt * 64 + rb * 32 + att::crow(reg, hh);
                if (MODE == 1) { float* E = (float*)(a.ws + MX_E); E[((size_t)r * 64 + g) * 256 + F.wave * 32 + r32] = acc[rb][0][reg]; }
                else { const int b = r / 72, c = r % 72; bf16_t* Gb = (bf16_t*)(a.ws + MX_G);
#pragma unroll
                    for (int cb = 0; cb < NCB; ++cb) { const int col = (F.wave * NCB + cb) * 32 + r32, to = col >> 4, no = col & 15;
                        Gb[(size_t)(b * LSEQ + c * 32 + to) * 1024 + g * 16 + no] = (bf16_t)f2bf(gelu_tanh(acc[rb][cb][reg])); } }
            }
        __syncthreads();
    }
}
DI void s5_carry(const Args& a, const Frame& F) {
    const int gt = F.bid * 512 + F.tid; if (gt >= 65536) return;
    const int p = gt & 63, dir = (gt >> 6) & 1, g = (gt >> 7) & 63, b = gt >> 13;
    const f32x2 z32 = ((const f32x2*)(a.ws + WS_S5ZP))[((dir * 64 + g) * 64 + p) * 33 + 32];
    const float* E = (const float*)(a.ws + MX_E); bf16_t* Hin = (bf16_t*)(a.ws + MX_HIN);
    float hr = 0.f, hi = 0.f;
#define S5_CH(s) (dir ? ((s) < 8 ? 7 - (s) : 79 - (s)) : (s))
    for (int s0 = 0; s0 < 72; s0 += 8) {
        float er[8], ei[8];
#pragma unroll
        for (int q = 0; q < 8; ++q) { const size_t idx = ((size_t)(b * 72 + S5_CH(s0 + q)) * 64 + g) * 256 + dir * 128 + p; er[q] = E[idx]; ei[q] = E[idx + 64]; }
#pragma unroll
        for (int q = 0; q < 8; ++q) { const size_t idx = ((size_t)(b * 72 + S5_CH(s0 + q)) * 64 + g) * 256 + dir * 128 + p;
            Hin[idx] = (bf16_t)f2bf(hr); Hin[idx + 64] = (bf16_t)f2bf(hi);
            const float nr = z32.x * hr - z32.y * hi + er[q], ni = z32.x * hi + z32.y * hr + ei[q]; hr = nr; hi = ni; }
    }
#undef S5_CH
}
DI void s3_glu(const Args& a, const Frame& F, int li) {
    pg8::DenseSched S; S.init(a.ws + MX_G, a.ws + WS_WS5_GLU, MROWS, 2048, 1024, F.G, F.bid);
    pg8::EpiGluResid E{(float*)(a.ws + WS_X), (const float*)(a.ws + WS_MOD) + (size_t)li * 9 * 6144 + 2048};
    pg8::gemm_phase<pg8::EpiGluResid, pg8::DenseSched>(F.lds, 1024, S, E);
}

DI void l1_win(const Args& a, const Frame& F) {
    pg8::DenseSched S; S.init(a.ws + WS_H, a.ws + WS_WLRU_IN, MROWS, 2816, 1024, F.G, F.bid);
    pg8::EpiBf16 E{(bf16_t*)(a.ws + MX_UG), 2816, 0, 0};
    pg8::gemm_phase<pg8::EpiBf16, pg8::DenseSched>(F.lds, 1024, S, E);
}
template <int PASS> DI void lru_tiles(const Args& a, const Frame& F) {
    const int half = F.wave >> 2, wq = F.wave & 3, dir = wq >> 1, nbh = wq & 1, ht = F.tid & 255;
    LAS unsigned char* ub = F.lds + half * 58368;
    LAS bf16_t* XB = (LAS bf16_t*)ub;
    LAS float* HS = (LAS float*)(ub + 13312);
    LAS bf16_t* RAW = (LAS bf16_t*)(ub + 13312);
    const bf16_t* Ug = (const bf16_t*)(a.ws + MX_UG); const bf16_t* BD = (const bf16_t*)(a.ws + WS_BD);
    const float* SP = (const float*)(a.ws + WS_PAR + PAR_SP);
    f32x2* SUMM = (f32x2*)(a.ws + MX_SUMM); const float* CARRY = (const float*)(a.ws + MX_CARRY); bf16_t* A2 = (bf16_t*)(a.ws + MX_A2);
    const int fr = F.lane & 15, fq = F.lane >> 4;
    const int src1 = dir ? F.lane + 16 : F.lane - 16, src2 = dir ? F.lane + 32 : F.lane - 32, lastl = dir ? fr : fr + 48;
    const bool val1 = dir ? (fq <= 2) : (fq >= 1), val2 = dir ? (fq <= 1) : (fq >= 2);
    const int slot = F.bid * 2 + half, n = slot & 15, rc0 = slot >> 4, nslots16 = (F.G * 2) >> 4;
#define LRU_LOADW(dst, nbi_) do { _Pragma("unroll") for (int mat = 0; mat < 2; ++mat) _Pragma("unroll") for (int ks = 0; ks < 3; ++ks) \
        dst[mat][ks] = *(const bf16x8*)(BD + ((size_t)((dir * 2 + mat) * 16 + n) * 96 + (nbh * 3 + (nbi_)) * 16 + fr) * 96 + ks * 32 + fq * 8); } while (0)
    u32x4 rawv[3], gwv[3];
#define LRU_LOAD_RAW(rc_) do { const int b_ = (rc_) / 36, c_ = (rc_) % 36, p0_ = c_ * 64, lo_ = (c_ < 4) ? 0 : CN, hi_ = (c_ < 4) ? CN : LSEQ; \
        _Pragma("unroll") for (int it = 0; it < 3; ++it) { const int pi = ht + 256 * it; rawv[it] = (u32x4){0u, 0u, 0u, 0u}; \
            if (pi < 737) { const int j = pi / 11, cg = pi % 11, q = p0_ - 1 + j; if (q >= lo_ && q < hi_) rawv[it] = *(const u32x4*)(Ug + ((size_t)b_ * LSEQ + q) * 2816 + LRUW + n * 88 + cg * 8); } } } while (0)
#define LRU_LOAD_GATE(rc_) do { const int b_ = (rc_) / 36, c_ = (rc_) % 36, p0_ = c_ * 64; \
        _Pragma("unroll") for (int it = 0; it < 3; ++it) { const int gi = ht + 256 * it; gwv[it] = (u32x4){0u, 0u, 0u, 0u}; \
            if (gi < 704) { const int row = gi / 11, cg = gi % 11; gwv[it] = *(const u32x4*)(Ug + ((size_t)b_ * LSEQ + p0_ + row) * 2816 + n * 88 + cg * 8); } } } while (0)
    if (rc0 < 288) LRU_LOAD_RAW(rc0);
    for (int rc = rc0; rc < 288; rc += nslots16) {
        const int b = rc / 36, c = rc % 36, p0 = c * 64;
        const size_t rowbase = (size_t)b * LSEQ + p0;
        bf16x8 wcur[2][3], wnxt[2][3];
        LRU_LOADW(wcur, 0);
#pragma unroll
        for (int it = 0; it < 3; ++it) { const int pi = ht + 256 * it; if (pi < 737) { const int j = pi / 11, cg = pi % 11; *(LAS u32x4*)(RAW + j * 88 + cg * 8) = rawv[it]; } }
        LDS_WAIT();
        __syncthreads();
        if (rc + nslots16 < 288) LRU_LOAD_RAW(rc + nslots16);
#pragma unroll
        for (int it = 0; it < 3; ++it) { const int gi = ht + 256 * it;
            if (gi < 704) { const int row = gi / 11, cg = gi % 11, c0 = n * 88 + cg * 8;
                float acc[8]; { const f32x4 b0 = *(const f32x4*)(a.in[I_LCB] + c0), b1 = *(const f32x4*)(a.in[I_LCB] + c0 + 4); acc[0] = b0[0]; acc[1] = b0[1]; acc[2] = b0[2]; acc[3] = b0[3]; acc[4] = b1[0]; acc[5] = b1[1]; acc[6] = b1[2]; acc[7] = b1[3]; }
#pragma unroll
                for (int k = 0; k < 4; ++k) { const u32x4 rw = *(const LAS u32x4*)(RAW + (row + k) * 88 + cg * 8); const f32x4 w0 = *(const f32x4*)(a.in[I_LCW] + k * LRUW + c0), w1 = *(const f32x4*)(a.in[I_LCW] + k * LRUW + c0 + 4);
                    acc[0] += w0[0] * bflo(rw.x); acc[1] += w0[1] * bfhi(rw.x); acc[2] += w0[2] * bflo(rw.y); acc[3] += w0[3] * bfhi(rw.y);
                    acc[4] += w1[0] * bflo(rw.z); acc[5] += w1[1] * bfhi(rw.z); acc[6] += w1[2] * bflo(rw.w); acc[7] += w1[3] * bfhi(rw.w); }
                u32x4 o; o.x = pk2(acc[0], acc[1]); o.y = pk2(acc[2], acc[3]); o.z = pk2(acc[4], acc[5]); o.w = pk2(acc[6], acc[7]);
                *(LAS u32x4*)(XB + row * 104 + cg * 8) = o; } }
        if (ht < 64) *(LAS u32x4*)(XB + ht * 104 + 88) = (u32x4){0u, 0u, 0u, 0u};
        LDS_WAIT();
        __syncthreads();
#pragma unroll
        for (int nbi = 0; nbi < 3; ++nbi) {
            if (nbi < 2) LRU_LOADW(wnxt, nbi + 1);
            const int e = (nbh * 3 + nbi) * 16 + fr, ecl = e < 88 ? e : 87, cch = n * 88 + ecl;
            const float ba = a.in[I_LBA][dir * LRUW + cch], bx = a.in[I_LBX][dir * LRUW + cch], sp = SP[dir * LRUW + cch];
            float Hc = 0.f, Pt = 1.f;
            if (PASS == 2) Hc = CARRY[((size_t)(dir * 8 + b) * 36 + c) * LRUW + cch];
#pragma unroll 1
            for (int mi = 0; mi < 4; ++mi) {
                const int mb = dir ? 3 - mi : mi;
                f32x4 acc0 = {0.f, 0.f, 0.f, 0.f}, acc1 = {0.f, 0.f, 0.f, 0.f};
#pragma unroll
                for (int ks = 0; ks < 3; ++ks) { const bf16x8 af = *(const LAS bf16x8*)(XB + (mb * 16 + fr) * 104 + ks * 32 + fq * 8);
                    acc0 = __builtin_amdgcn_mfma_f32_16x16x32_bf16(af, wcur[0][ks], acc0, 0, 0, 0); acc1 = __builtin_amdgcn_mfma_f32_16x16x32_bf16(af, wcur[1][ks], acc1, 0, 0, 0); }
                float av[4], bt[4];
#pragma unroll
                for (int j = 0; j < 4; ++j) { const float xs = bf2f(XB[(mb * 16 + fq * 4 + j) * 104 + ecl]);
                    const float r = __builtin_amdgcn_rcpf(1.0f + __expf(-(acc0[j] + ba))), ig = __builtin_amdgcn_rcpf(1.0f + __expf(-(acc1[j] + bx)));
                    const float la = -8.0f * r * sp; av[j] = __expf(la); bt[j] = __builtin_amdgcn_sqrtf(fmaxf(1.0f - av[j] * av[j], 0.f)) * ig * xs; }
                float Pl = 1.f, hl = 0.f;
#pragma unroll
                for (int jj = 0; jj < 4; ++jj) { const int j = dir ? 3 - jj : jj; hl = fmaf(av[j], hl, bt[j]); Pl *= av[j]; }
                float Pn = __shfl(Pl, src1), hn = __shfl(hl, src1);
                float Pi = val1 ? Pn * Pl : Pl, hi = val1 ? fmaf(Pl, hn, hl) : hl;
                Pn = __shfl(Pi, src2); hn = __shfl(hi, src2);
                const float Pi2 = val2 ? Pn * Pi : Pi, hi2 = val2 ? fmaf(Pi, hn, hi) : hi;
                const float Pex = __shfl(Pi2, src1), hex = __shfl(hi2, src1);
                const float Pe = val1 ? Pex : 1.f, he = val1 ? hex : 0.f;
                const float Ptot = __shfl(Pi2, lastl), htot = __shfl(hi2, lastl);
                if (PASS == 2) {
                    float h = fmaf(Pe, Hc, he);
#pragma unroll
                    for (int jj = 0; jj < 4; ++jj) { const int j = dir ? 3 - jj : jj; h = fmaf(av[j], h, bt[j]); if (e < 88) HS[(dir * 64 + mb * 16 + fq * 4 + j) * 88 + e] = h; }
                }
                Hc = fmaf(Ptot, Hc, htot); Pt *= Ptot;
            }
            if (PASS == 1) { if (fq == 0 && e < 88) SUMM[((size_t)(dir * 8 + b) * 36 + c) * LRUW + n * 88 + e] = (f32x2){Pt, Hc}; }
            if (nbi < 2) {
#pragma unroll
                for (int mat = 0; mat < 2; ++mat)
#pragma unroll
                    for (int ks = 0; ks < 3; ++ks) wcur[mat][ks] = wnxt[mat][ks];
            }
        }
        if (PASS == 2) {
            LRU_LOAD_GATE(rc);
            LDS_WAIT();
            __syncthreads();
#pragma unroll
            for (int it = 0; it < 3; ++it) { const int gi = ht + 256 * it;
                if (gi < 704) { const int row = gi / 11, cg = gi % 11;
                    const f32x4 f0 = *(const LAS f32x4*)(HS + row * 88 + cg * 8), f1 = *(const LAS f32x4*)(HS + row * 88 + cg * 8 + 4), g0 = *(const LAS f32x4*)(HS + (64 + row) * 88 + cg * 8), g1 = *(const LAS f32x4*)(HS + (64 + row) * 88 + cg * 8 + 4);
                    const u32x4 gw = gwv[it]; u32x4 o;
                    o.x = pk2((f0[0] + g0[0]) * gelu_tanh(bflo(gw.x)), (f0[1] + g0[1]) * gelu_tanh(bfhi(gw.x))); o.y = pk2((f0[2] + g0[2]) * gelu_tanh(bflo(gw.y)), (f0[3] + g0[3]) * gelu_tanh(bfhi(gw.y)));
                    o.z = pk2((f1[0] + g1[0]) * gelu_tanh(bflo(gw.z)), (f1[1] + g1[1]) * gelu_tanh(bfhi(gw.z))); o.w = pk2((f1[2] + g1[2]) * gelu_tanh(bflo(gw.w)), (f1[3] + g1[3]) * gelu_tanh(bfhi(gw.w)));
                    *(u32x4*)(A2 + (rowbase + row) * LRUW + n * 88 + cg * 8) = o; } }
        }
        LDS_WAIT();
        __syncthreads();
    }
#undef LRU_LOAD_RAW
#undef LRU_LOAD_GATE
#undef LRU_LOADW
}
DI void l3_carry(const Args& a, const Frame& F) {
    const f32x2* SUMM = (const f32x2*)(a.ws + MX_SUMM); float* CARRY = (float*)(a.ws + MX_CARRY);
    const int gt = F.bid * 512 + F.tid;
    if (gt < 2 * NB * LRUW) {
        const int dir = gt / (NB * LRUW), b = (gt / LRUW) % NB, ch = gt % LRUW; float h = 0.f;
        for (int s = 0; s < 36; ++s) { const int c = dir ? (s < 4 ? 3 - s : 39 - s) : s; const size_t idx = ((size_t)(dir * 8 + b) * 36 + c) * LRUW + ch;
            CARRY[idx] = h; const f32x2 ph = SUMM[idx]; h = fmaf(ph.x, h, ph.y); }
    }
}
DI void l5_wout(const Args& a, const Frame& F, int li) {
    pg8::DenseSched S; S.init(a.ws + MX_A2, a.ws + WS_WLRU_OUT, MROWS, 1024, LRUW, F.G, F.bid);
    pg8::EpiResid E{(float*)(a.ws + WS_X), (const float*)(a.ws + WS_MOD) + (size_t)li * 9 * 6144 + 2048};
    pg8::gemm_phase<pg8::EpiResid, pg8::DenseSched>(F.lds, LRUW, S, E);
}

constexpr int NPHASE = 37;
__global__ void __launch_bounds__(NWAVES * 64, 2) fwd_kernel(Args args) {
    extern __shared__ __attribute__((aligned(16))) unsigned char lds_raw[];
    Frame F;
    F.lds = (LAS unsigned char*)lds_raw;
    F.tid = threadIdx.x; F.lane = F.tid & 63; F.wave = __builtin_amdgcn_readfirstlane(F.tid >> 6);
    F.G = gridDim.x; F.bid = blockIdx.x; F.gw = F.bid * NWAVES + F.wave; F.NGW = F.G * NWAVES;
    volatile LAS unsigned* MISC = (volatile LAS unsigned*)(F.lds + MISC_OFF);
    for (int u = F.tid; u < (LDS_BYTES - MISC_OFF) / 4; u += NWAVES * 64) ((LAS unsigned*)(F.lds + MISC_OFF))[u] = 0u;
    __syncthreads();
    XcdBarrier bar = xcd_barrier_post((unsigned*)(args.ws + WS_CTL) + CW_BAR, MISC + 8);
    const int lo = args.ph_lo, hi = args.ph_hi;
#define IN(k) (lo <= (k) && (k) < hi)
#define NREP(k) ((((PROBE_MASK) >> (k)) & 1ull) ? (args.ph_hi >= NPHASE ? 2 : 1) : 1)
#define SEAM(k) do { if (IN(k) && IN((k) + 1)) xcd_barrier(bar); } while (0)
    if (IN(0)) { for (int rep = 0; rep < NREP(0); ++rep) p0_prologue(args, F); }   SEAM(0);
    if (IN(1)) { for (int rep = 0; rep < NREP(1); ++rep) { p0b_modreduce(args, F); s5_tables_a(args, F); } } SEAM(1);
    if (IN(2)) { for (int rep = 0; rep < NREP(2); ++rep) { p1_init(args, F); s5_tables_b(args, F); } }       SEAM(2);
    if (IN(3)) { for (int rep = 0; rep < NREP(3); ++rep) a1_qkv(args, F, 0); }          SEAM(3);
    if (IN(4)) { for (int rep = 0; rep < NREP(4); ++rep) a1b_rope(args, F); }           SEAM(4);
    if (IN(5)) { for (int rep = 0; rep < NREP(5); ++rep) a2_attention(args, F, 0, 0); } SEAM(5);
    if (IN(6)) { for (int rep = 0; rep < NREP(6); ++rep) a3_wout(args, F, 0, 0); }      SEAM(6);
    if (IN(7)) { for (int rep = 0; rep < NREP(7); ++rep) m0_route(args, F, 0); }        SEAM(7);
    if (IN(8)) { for (int rep = 0; rep < NREP(8); ++rep) m1_gateup(args, F, 0); }       SEAM(8);
    if (IN(9)) { for (int rep = 0; rep < NREP(9); ++rep) m2_down(args, F, 0); }         SEAM(9);
    if (IN(10)) { for (int rep = 0; rep < NREP(10); ++rep) m3_combine(args, F, 0); }     SEAM(10);
    if (IN(11)) { for (int rep = 0; rep < NREP(11); ++rep) s1_win(args, F); }            SEAM(11);
    if (IN(12)) { for (int rep = 0; rep < NREP(12); ++rep) s5_mm<1>(args, F); }           SEAM(12);
    if (IN(13)) { for (int rep = 0; rep < NREP(13); ++rep) s5_carry(args, F); }          SEAM(13);
    if (IN(14)) { for (int rep = 0; rep < NREP(14); ++rep) s5_mm<2>(args, F); }         SEAM(14);
    if (IN(15)) { for (int rep = 0; rep < NREP(15); ++rep) s3_glu(args, F, 1); }         SEAM(15);
    if (IN(16)) { for (int rep = 0; rep < NREP(16); ++rep) m0_route(args, F, 1); }       SEAM(16);
    if (IN(17)) { for (int rep = 0; rep < NREP(17); ++rep) m1_gateup(args, F, 1); }      SEAM(17);
    if (IN(18)) { for (int rep = 0; rep < NREP(18); ++rep) m2_down(args, F, 1); }        SEAM(18);
    if (IN(19)) { for (int rep = 0; rep < NREP(19); ++rep) m3_combine(args, F, 1); }     SEAM(19);
    if (IN(20)) { for (int rep = 0; rep < NREP(20); ++rep) l1_win(args, F); }            SEAM(20);
    if (IN(21)) { for (int rep = 0; rep < NREP(21); ++rep) lru_tiles<1>(args, F); }      SEAM(21);
    if (IN(22)) { for (int rep = 0; rep < NREP(22); ++rep) l3_carry(args, F); }          SEAM(22);
    if (IN(23)) { for (int rep = 0; rep < NREP(23); ++rep) lru_tiles<2>(args, F); }      SEAM(23);
    if (IN(24)) { for (int rep = 0; rep < NREP(24); ++rep) l5_wout(args, F, 2); }        SEAM(24);
    if (IN(25)) { for (int rep = 0; rep < NREP(25); ++rep) m0_route(args, F, 2); }       SEAM(25);
    if (IN(26)) { for (int rep = 0; rep < NREP(26); ++rep) m1_gateup(args, F, 2); }      SEAM(26);
    if (IN(27)) { for (int rep = 0; rep < NREP(27); ++rep) m2_down(args, F, 2); }        SEAM(27);
    if (IN(28)) { for (int rep = 0; rep < NREP(28); ++rep) m3_combine(args, F, 2); }     SEAM(28);
    if (IN(29)) { for (int rep = 0; rep < NREP(29); ++rep) a1_qkv(args, F, 1); }         SEAM(29);
    if (IN(30)) { for (int rep = 0; rep < NREP(30); ++rep) a1b_rope(args, F); }          SEAM(30);
    if (IN(31)) { for (int rep = 0; rep < NREP(31); ++rep) a2_attention(args, F, 3, 1); } SEAM(31);
    if (IN(32)) { for (int rep = 0; rep < NREP(32); ++rep) a3_wout(args, F, 3, 1); }     SEAM(32);
    if (IN(33)) { for (int rep = 0; rep < NREP(33); ++rep) m0_route(args, F, 3); }       SEAM(33);
    if (IN(34)) { for (int rep = 0; rep < NREP(34); ++rep) m1_gateup(args, F, 3); }      SEAM(34);
    if (IN(35)) { for (int rep = 0; rep < NREP(35); ++rep) m2_down(args, F, 3); }        SEAM(35);
    if (IN(36)) { for (int rep = 0; rep < NREP(36); ++rep) m3_combine(args, F, 3); }
#undef IN
#undef SEAM
}

extern "C" void kernel_launch(void* const* d_in, const int* in_sizes, int n_in, void* d_out, int out_size, void* d_ws, size_t ws_size, hipStream_t stream) {
    static int grid = 0;
    if (grid == 0) {
        if (n_in != 37 || ws_size < WS_END) { fprintf(stderr, "kernel_launch: unexpected n_in %d or ws_size %zu\n", n_in, ws_size); grid = -1; return; }
        if (hipFuncSetAttribute((const void*)fwd_kernel, hipFuncAttributeMaxDynamicSharedMemorySize, LDS_BYTES) != hipSuccess) { fprintf(stderr, "kernel_launch: hipFuncSetAttribute failed\n"); grid = -1; return; }
        int per_cu = 0;
        if (hipOccupancyMaxActiveBlocksPerMultiprocessor(&per_cu, (const void*)fwd_kernel, NWAVES * 64, LDS_BYTES) != hipSuccess || per_cu < 1) fprintf(stderr, "kernel_launch: occupancy query says %d\n", per_cu);
        (void)hipGetLastError();
        grid = 256;
    }
    if (grid < 0) return;
    (void)hipMemsetAsync((char*)d_ws + WS_CTL, 0, CTL_ZERO_BYTES, stream);
    Args a{};
    for (int i = 0; i < 37; ++i) a.in[i] = (const float*)d_in[i];
    a.out = (float*)d_out; a.ws = (unsigned char*)d_ws;
#if MK_N_LAUNCHES == 1
    a.ph_lo = 0; a.ph_hi = NPHASE;
    hipLaunchKernelGGL(fwd_kernel, dim3(grid), dim3(NWAVES * 64), LDS_BYTES, stream, a);
#else
    for (int p = 0; p < NPHASE; ++p) { a.ph_lo = p; a.ph_hi = p + 1; hipLaunchKernelGGL(fwd_kernel, dim3(grid), dim3(NWAVES * 64), LDS_BYTES, stream, a); }
#endif
    (void)in_sizes; (void)out_size;
}
```

```cpp
#include <hip/hip_runtime.h>
#include <cstdio>
#include <cstdint>

#ifndef PROBE_MASK
#define PROBE_MASK 0ull
#endif
#ifndef MK_N_LAUNCHES
#define MK_N_LAUNCHES 1
#endif

#define LAS __attribute__((address_space(3)))
#define GAS __attribute__((address_space(1)))
typedef unsigned short bf16_t;
typedef short bf16x8 __attribute__((ext_vector_type(8)));
typedef short s16x4 __attribute__((ext_vector_type(4)));
typedef float f32x4 __attribute__((ext_vector_type(4)));
typedef float f32x2 __attribute__((ext_vector_type(2)));
typedef float f32x16 __attribute__((ext_vector_type(16)));
typedef unsigned u32x4 __attribute__((ext_vector_type(4)));
typedef unsigned u32x2 __attribute__((ext_vector_type(2)));
typedef int i32x4 __attribute__((ext_vector_type(4)));
typedef GAS unsigned gu32;
#define RLX_AGENT __ATOMIC_RELAXED, __HIP_MEMORY_SCOPE_AGENT
#define LDS_WAIT() asm volatile("s_waitcnt lgkmcnt(0)" ::: "memory")
#define VM_WAIT() asm volatile("s_waitcnt vmcnt(0)" ::: "memory")
#define DI __device__ __forceinline__

constexpr int D = 1024, NB = 8, TL = 2048, CN = 256, LSEQ = TL + CN  , MROWS = NB * LSEQ  , DEPTH = 4;
constexpr int NE = 16, DEXP = 1024, LRUW = 1408, LRUB = 88;
constexpr int S5G = 64, S5P = 64, S5N = 16;
constexpr float LN_EPS = 1e-5f;
constexpr float DN_ALPHA = 1.6817928305074292f;
constexpr int NWAVES = 8;

constexpr size_t MiB = 1u << 20;
constexpr size_t WS_CTL = 0, CTL_ZERO_BYTES = 1 * MiB;
constexpr size_t WS_MODP = 1 * MiB;
constexpr size_t WS_MOD = 16 * MiB;
constexpr size_t WS_PAR = 17 * MiB;
constexpr size_t WS_BD = 19 * MiB;
constexpr size_t WS_WATT_IN = 21 * MiB;
constexpr size_t WS_WATT_OUT = 33 * MiB;
constexpr size_t WS_WS5_IN = 37 * MiB;
constexpr size_t WS_WS5_GLU = 39 * MiB;
constexpr size_t WS_WLRU_IN = 43 * MiB;
constexpr size_t WS_WLRU_OUT = 49 * MiB;
constexpr size_t WS_WGU = 52 * MiB;
constexpr size_t WS_WD = 116 * MiB;
constexpr size_t WS_X = 148 * MiB;
constexpr size_t WS_H = 220 * MiB;
constexpr size_t WS_TOK = 256 * MiB;
constexpr size_t WS_HID = 258 * MiB;
constexpr size_t WS_YEXP = 338 * MiB;
constexpr size_t WS_MIX = 418 * MiB;
constexpr size_t WS_S5W1 = 670 * MiB;
constexpr size_t WS_S5W2 = 686 * MiB;
constexpr size_t WS_S5KT = 734 * MiB;
constexpr size_t WS_S5ZP = 738 * MiB;
constexpr size_t WS_SCL = 742 * MiB;
constexpr size_t SCL_SA = 0, SCL_ATT = 131072, SCL_S5 = 163840, SCL_LRU = 180224, SCL_GU = 262144;
constexpr size_t WS_END = 743 * MiB;
constexpr size_t MX_Q = WS_MIX, MX_K = WS_MIX + 36 * MiB, MX_V = WS_MIX + 72 * MiB, MX_AO = WS_MIX + 108 * MiB;
constexpr size_t MX_U = WS_MIX  , MX_E = WS_MIX + 72 * MiB  , MX_HIN = WS_MIX + 144 * MiB  , MX_G = WS_MIX + 216 * MiB;
constexpr size_t MX_UG = WS_MIX, MX_A2 = WS_MIX + 100 * MiB, MX_SUMM = WS_MIX + 150 * MiB, MX_CARRY = WS_MIX + 158 * MiB;
constexpr size_t PAR_ZR = 0, PAR_ZI = 32768, PAR_BBR = 65536, PAR_BBI = 65536 + 524288, PAR_ROPE = 65536 + 2 * 524288, PAR_SP = PAR_ROPE + 8192;
constexpr int CW_BAR = 4096;
constexpr int CW_CNT = 16384;

constexpr int RING_BYTES = 131072;
constexpr int MISC_OFF = RING_BYTES;
constexpr int TB_OFF = MISC_OFF + 512;
constexpr int TAB_OFF = TB_OFF + 512;
constexpr int TABS_OFF = TAB_OFF + 8192;
constexpr int LDS_BYTES = 155648;
static_assert(TABS_OFF + 8 * 1024 <= LDS_BYTES, "LDS map");

DI unsigned f2bf(float f) { unsigned u = __builtin_bit_cast(unsigned, f); return (u + 0x7fffu + ((u >> 16) & 1u)) >> 16; }
DI unsigned pk2(float lo, float hi) { return f2bf(lo) | (f2bf(hi) << 16); }
DI float bf2f(unsigned short b) { return __builtin_bit_cast(float, ((unsigned)b) << 16); }
DI float bflo(unsigned w) { return __builtin_bit_cast(float, w << 16); }
DI float bfhi(unsigned w) { return __builtin_bit_cast(float, w & 0xffff0000u); }
DI float wave_sum(float v) {
#pragma unroll
    for (int o = 1; o < 64; o <<= 1) v += __shfl_xor(v, o);
    return v;
}
DI float wave_max(float v) {
#pragma unroll
    for (int o = 1; o < 64; o <<= 1) v = fmaxf(v, __shfl_xor(v, o));
    return v;
}
DI float sigmoidf_(float x) { return __builtin_amdgcn_rcpf(1.0f + __expf(-x)); }
DI float gelu_tanh(float x) { const float u = 0.7978845608028654f * (x + 0.044715f * x * x * x); const float e = __expf(2.0f * u); return x - x * __builtin_amdgcn_rcpf(e + 1.0f); }
DI void sincos_cw(float x, float& s, float& c) {
    const float k = rintf(x * 0.6366197723675814f);
    float r = fmaf(k, -1.5707962512969971f, x); r = fmaf(k, -7.5497894158615964e-08f, r); r = fmaf(k, -5.3903029534742384e-15f, r);
    const float r2 = r * r;
    float sp = fmaf(r2, 2.7557313707070068e-6f, -1.9841270114006046e-4f); sp = fmaf(sp, r2, 8.3333337680e-3f); sp = fmaf(sp, r2, -1.6666667163e-1f); sp = fmaf(sp * r2, r, r);
    float cp = fmaf(r2, 2.4801587e-5f, -1.3888889225e-3f); cp = fmaf(cp, r2, 4.1666667908e-2f); cp = fmaf(cp, r2, -0.5f); cp = fmaf(cp, r2, 1.0f);
    const int q = ((int)k) & 3;
    const float ss = (q & 1) ? cp : sp, cc = (q & 1) ? sp : cp;
    s = (q & 2) ? -ss : ss; c = ((q + 1) & 2) ? -cc : cc;
}

#define XB_TMO      128
#define XB_XCNT(j)  (256  + 64 * (j))
#define XB_XSUB(j)  (1280 + 64 * (j))
#define XB_XGEN(j)  (2304 + 64 * (j))
#define XB_TOP      3328
#define XB_TOPGEN   3392
#define XCD_BAR_WORDS 3456
#define XB_SPIN_CAP (1u << 20)
DI unsigned xb_ld(unsigned* p)              { return __hip_atomic_load(p, __ATOMIC_RELAXED, __HIP_MEMORY_SCOPE_AGENT); }
DI unsigned xb_add(unsigned* p, unsigned v) { return __hip_atomic_fetch_add(p, v, __ATOMIC_RELAXED, __HIP_MEMORY_SCOPE_AGENT); }
DI unsigned xb_xcc_id() { return (unsigned)__builtin_amdgcn_s_getreg((3 << 11) | 20) & 0xFu; }
#define XB_SPIN(cond, bar) do { unsigned _sp = 0; while (cond) { __builtin_amdgcn_s_sleep(1); \
    if ((++_sp & 255u) == 0u) { if (xb_ld(&(bar)[XB_TMO])) break; if (_sp > XB_SPIN_CAP) { atomicAdd(&(bar)[XB_TMO], 1u); break; } } } } while (0)
struct XcdBarrier { unsigned* bar; unsigned x; volatile LAS unsigned* st; };
DI XcdBarrier xcd_barrier_post(unsigned* bar, volatile LAS unsigned* st) {
    XcdBarrier b; b.bar = bar; b.x = xb_xcc_id(); b.st = st;
    if (threadIdx.x == 0) (void)xb_add(&bar[XB_XCNT(b.x)], 1u);
    return b;
}
DI void xcd_barrier_complete(unsigned* bar, unsigned x, unsigned& nloc, unsigned& nx) {
    const unsigned G = gridDim.x * gridDim.y * gridDim.z;
    unsigned sum, cnt, mine, sp = 0u;
    for (;;) {
        sum = 0u; cnt = 0u; mine = 0u;
#pragma unroll
        for (unsigned j = 0; j < 16; ++j) { const unsigned c = xb_ld(&bar[XB_XCNT(j)]); sum += c; cnt += (c > 0u) ? 1u : 0u; mine = (j == x) ? c : mine; }
        if (sum == G) break;
        __builtin_amdgcn_s_sleep(1);
        if ((++sp & 255u) == 0u) { if (xb_ld(&bar[XB_TMO])) break; if (sp > XB_SPIN_CAP) { atomicAdd(&bar[XB_TMO], 1u); break; } }
    }
    nloc = mine > 0u ? mine : 1u; nx = cnt > 0u ? cnt : 1u;
}
DI void xcd_barrier(const XcdBarrier& b) {
    asm volatile("s_waitcnt vmcnt(0)" ::: "memory");
    __syncthreads();
    if (threadIdx.x == 0) {
        unsigned* bar = b.bar;
        __builtin_amdgcn_s_waitcnt(0);
        unsigned nloc = b.st[0], nx = b.st[1];
        if (nloc == 0u) { xcd_barrier_complete(bar, b.x, nloc, nx); b.st[0] = nloc; b.st[1] = nx; }
        const unsigned old = xb_add(&bar[XB_XSUB(b.x)], 1u);
        const unsigned gen = old / nloc;
        if (old + 1u == (gen + 1u) * nloc) {
            __builtin_amdgcn_fence(__ATOMIC_RELEASE, "agent");
            asm volatile("s_waitcnt vmcnt(0)" ::: "memory");
            const unsigned og = xb_add(&bar[XB_TOP], 1u);
            const unsigned tg = og / nx;
            if (og + 1u == (tg + 1u) * nx) xb_add(&bar[XB_TOPGEN], 1u);
            else XB_SPIN(xb_ld(&bar[XB_TOPGEN]) == tg, bar);
            __builtin_amdgcn_fence(__ATOMIC_ACQUIRE, "agent");
            xb_add(&bar[XB_XGEN(b.x)], 1u);
            asm volatile("s_waitcnt vmcnt(0)" ::: "memory");
        } else {
            XB_SPIN(xb_ld(&bar[XB_XGEN(b.x)]) == gen, bar);
            __builtin_amdgcn_fence(__ATOMIC_ACQUIRE, "agent");
            asm volatile("s_waitcnt vmcnt(0)" ::: "memory");
        }
    }
    __syncthreads();
}

namespace pg8 {
constexpr int BM = 256, BK = 64, HALF = 128, HTB = HALF * BK * 2, STAGE_BYTES = 8 * HTB, NXCD = 8, WGM = 8;
__host__ __device__ __forceinline__ int lds_byte(int r, int c) { const int st = (r >> 4) * 2 + (c >> 5), rr = r & 15, cc = c & 31, ob = rr * 64 + cc * 2; return st * 1024 + (ob ^ (((ob >> 9) & 1) << 5)); }
__host__ __device__ __forceinline__ void stage_rc(int b, int& R, int& C) { const int st = b / 1024, sb = b % 1024, swz = sb ^ (((sb >> 9) & 1) << 5); R = (st >> 1) * 16 + swz / 64; C = (st & 1) * 32 + (swz % 64) / 2; }
__host__ __device__ __forceinline__ int perm32(int rho) { const int n = rho >> 4, i = rho & 15; return 8 * (i >> 2) + 4 * n + (i & 3); }

struct Unit { int pm, pn, e, ord; const char* A; const char* B; };
DI unsigned cvt_pk_bf16(float lo, float hi) { unsigned r; asm volatile("v_cvt_pk_bf16_f32 %0, %1, %2" : "=v"(r) : "v"(lo), "v"(hi)); return r; }

DI int xcd_remap(int wgid, int nwg) { const int q = nwg / NXCD, r = nwg % NXCD, xcd = wgid % NXCD, off = wgid / NXCD; return (xcd < r ? xcd * (q + 1) : r * (q + 1) + (xcd - r) * q) + off; }

struct DenseSched {
    static constexpr bool GATHER = false;
    const char* A; const char* Bt; int Kb, nM, nN, nwg, G, c;
    DI void init(const void* A_, const void* Bt_, int M, int N, int Kb_, int G_, int c_) { A = (const char*)A_; Bt = (const char*)Bt_; Kb = Kb_; nM = M / BM; nN = N / BM; nwg = nM * nN; G = G_; c = c_; }
    DI bool next(int i, Unit& u) const {
        const long L = (long)i * G + c; if (L >= nwg) return false;
        const int wgid = xcd_remap((int)L, nwg);
        const int nig = WGM * nN, gid = wgid / nig, fm = gid * WGM, gsz = (nM - fm) < WGM ? (nM - fm) : WGM;
        u.pm = fm + ((wgid % nig) % gsz); u.pn = (wgid % nig) / gsz; u.e = 0; u.ord = i;
        u.A = A + (size_t)u.pm * BM * Kb; u.B = Bt + (size_t)u.pn * BM * Kb; return true;
    }
    DI void aoffs(int, const Unit&, const int (&R)[2], const int (&C)[2], unsigned (&vo)[2][2]) const {
#pragma unroll
        for (int h = 0; h < 2; ++h)
#pragma unroll
            for (int p = 0; p < 2; ++p) vo[h][p] = (unsigned)((h * HALF + R[p]) * Kb + C[p] * 2);
    }
};
template <bool GATHER_, int NPN>
struct MoeSched {
    static constexpr bool GATHER = GATHER_;
    const char* A; const char* Bt; const LAS int* tb; const LAS unsigned* tab; int NT, G, c, Kb; size_t estride;
    DI bool next(int i, Unit& u) const {
        const int nwg = NT * NPN; const long L = (long)i * G + c; if (L >= nwg) return false;
        const int id = xcd_remap((int)L, nwg);
        const int rt = id / NPN, pn = id % NPN; int e = 0;
#pragma unroll
        for (int j = 1; j < 16; ++j) e += (tb[j] <= rt) ? 1 : 0;
        u.pm = rt; u.pn = pn; u.e = e; u.ord = i;
        u.A = GATHER ? A : A + (size_t)rt * BM * Kb; u.B = Bt + (size_t)e * estride + (size_t)pn * BM * Kb; return true;
    }
    DI void aoffs(int i, const Unit&, const int (&R)[2], const int (&C)[2], unsigned (&vo)[2][2]) const {
#pragma unroll
        for (int h = 0; h < 2; ++h)
#pragma unroll
            for (int p = 0; p < 2; ++p) vo[h][p] = GATHER ? (tab[i * 256 + h * HALF + R[p]] + (unsigned)C[p] * 2u) : (unsigned)((h * HALF + R[p]) * Kb + C[p] * 2);
    }
};

struct EpiBf16 {
    static constexpr bool PERM = true;
    bf16_t* O; int ldc; int split_cols; size_t split_stride;
    DI void operator()(const f32x4 (&acc)[2][2][4][2], const Unit& u, int wr, int wc, int fr, int fq) const {
        const int row0 = u.pm * BM + wr * 64 + fr; int colt = u.pn * BM; bf16_t* base = O;
        if (split_cols) { const int t = colt / split_cols; base += (size_t)t * split_stride; colt -= t * split_cols; }
        const int col0 = colt + wc * 32 + 8 * fq;
#pragma unroll
        for (int ai = 0; ai < 2; ++ai)
#pragma unroll
            for (int m = 0; m < 4; ++m) { bf16_t* rowp = base + (size_t)(row0 + ai * HALF + m * 16) * ldc + col0;
#pragma unroll
                for (int bj = 0; bj < 2; ++bj) { const f32x4 v0 = acc[ai][bj][m][0], v1 = acc[ai][bj][m][1];
                    u32x4 w; w.x = cvt_pk_bf16(v0[0], v0[1]); w.y = cvt_pk_bf16(v0[2], v0[3]); w.z = cvt_pk_bf16(v1[0], v1[1]); w.w = cvt_pk_bf16(v1[2], v1[3]);
                    *(u32x4*)(rowp + bj * HALF) = w; } }
    }
};
struct EpiF32 {
    static constexpr bool PERM = false;
    float* C; int ldc;
    DI void operator()(const f32x4 (&acc)[2][2][4][2], const Unit& u, int wr, int wc, int fr, int fq) const {
        const int row0 = u.pm * BM + wr * 64 + fr, col0 = u.pn * BM + wc * 32 + 4 * fq;
#pragma unroll
        for (int ai = 0; ai < 2; ++ai)
#pragma unroll
            for (int m = 0; m < 4; ++m) { float* rowp = C + (size_t)(row0 + ai * HALF + m * 16) * ldc + col0;
#pragma unroll
                for (int bj = 0; bj < 2; ++bj)
#pragma unroll
                    for (int n = 0; n < 2; ++n) *(f32x4*)(rowp + bj * HALF + n * 16) = acc[ai][bj][m][n]; }
    }
};
struct EpiResid {
    static constexpr bool PERM = false;
    float* X; const float* gate;
    DI void operator()(const f32x4 (&acc)[2][2][4][2], const Unit& u, int wr, int wc, int fr, int fq) const {
        const int row0 = u.pm * BM + wr * 64 + fr, col0 = u.pn * BM + wc * 32 + 4 * fq;
        const int r9 = (u.pm % 9 == 0) ? 8 : u.pm / 9; const float* g = gate + (size_t)r9 * 6144 + col0;
        f32x4 gv[2][2];
#pragma unroll
        for (int bj = 0; bj < 2; ++bj)
#pragma unroll
            for (int n = 0; n < 2; ++n) gv[bj][n] = *(const f32x4*)(g + bj * HALF + n * 16);
#pragma unroll
        for (int ai = 0; ai < 2; ++ai)
#pragma unroll
            for (int m = 0; m < 4; ++m) { float* rowp = X + (size_t)(row0 + ai * HALF + m * 16) * D + col0;
#pragma unroll
                for (int bj = 0; bj < 2; ++bj)
#pragma unroll
                    for (int n = 0; n < 2; ++n) { const f32x4 x = *(const f32x4*)(rowp + bj * HALF + n * 16); *(f32x4*)(rowp + bj * HALF + n * 16) = x * DN_ALPHA + gv[bj][n] * acc[ai][bj][m][n]; } }
    }
};
struct EpiGluResid {
    static constexpr bool PERM = false;
    float* X; const float* gate;
    DI void operator()(const f32x4 (&acc)[2][2][4][2], const Unit& u, int wr, int wc, int fr, int fq) const {
        const int row0 = u.pm * BM + wr * 64 + fr, col0 = u.pn * HALF + wc * 32 + 4 * fq;
        const int r9 = (u.pm % 9 == 0) ? 8 : u.pm / 9; const float* g = gate + (size_t)r9 * 6144 + col0;
        f32x4 gv[2];
#pragma unroll
        for (int n = 0; n < 2; ++n) gv[n] = *(const f32x4*)(g + n * 16);
#pragma unroll
        for (int ai = 0; ai < 2; ++ai)
#pragma unroll
            for (int m = 0; m < 4; ++m) { float* rowp = X + (size_t)(row0 + ai * HALF + m * 16) * D + col0;
#pragma unroll
                for (int n = 0; n < 2; ++n) { const f32x4 v = acc[ai][0][m][n], gg = acc[ai][1][m][n]; f32x4 o;
#pragma unroll
                    for (int j = 0; j < 4; ++j) o[j] = v[j] * sigmoidf_(gg[j]);
                    const f32x4 x = *(const f32x4*)(rowp + n * 16); *(f32x4*)(rowp + n * 16) = x * DN_ALPHA + gv[n] * o; } }
    }
};
struct EpiSwiGLU {
    static constexpr bool PERM = true;
    bf16_t* Hid;
    DI void operator()(const f32x4 (&acc)[2][2][4][2], const Unit& u, int wr, int wc, int fr, int fq) const {
        const int row0 = u.pm * BM + wr * 64 + fr, col0 = u.pn * HALF + wc * 32 + 8 * fq;
#pragma unroll
        for (int ai = 0; ai < 2; ++ai)
#pragma unroll
            for (int m = 0; m < 4; ++m) { bf16_t* rowp = Hid + (size_t)(row0 + ai * HALF + m * 16) * DEXP + col0;
                f32x4 h0, h1;
#pragma unroll
                for (int j = 0; j < 4; ++j) { const float g0 = acc[ai][0][m][0][j], g1 = acc[ai][0][m][1][j]; h0[j] = g0 * sigmoidf_(g0) * acc[ai][1][m][0][j]; h1[j] = g1 * sigmoidf_(g1) * acc[ai][1][m][1][j]; }
                u32x4 w; w.x = cvt_pk_bf16(h0[0], h0[1]); w.y = cvt_pk_bf16(h0[2], h0[3]); w.z = cvt_pk_bf16(h1[0], h1[1]); w.w = cvt_pk_bf16(h1[2], h1[3]);
                *(u32x4*)rowp = w; }
    }
};

DI f32x4 i2f4(i32x4 v) { return (f32x4){(float)v[0], (float)v[1], (float)v[2], (float)v[3]}; }
struct EpiBf16S {
    static constexpr bool PERM = true;
    bf16_t* O; int ldc; int split_cols; size_t split_stride; const float* sa; const float* sb;
    DI void operator()(const i32x4 (&acc)[2][2][4][2], const Unit& u, int wr, int wc, int fr, int fq) const {
        const int row0 = u.pm * BM + wr * 64 + fr; int colt = u.pn * BM; bf16_t* base = O;
        const int gcol0 = colt + wc * 32 + 8 * fq;
        if (split_cols) { const int t = colt / split_cols; base += (size_t)t * split_stride; colt -= t * split_cols; }
        const int col0 = colt + wc * 32 + 8 * fq;
        f32x4 sbv[2][2];
#pragma unroll
        for (int bj = 0; bj < 2; ++bj)
#pragma unroll
            for (int n = 0; n < 2; ++n) sbv[bj][n] = *(const f32x4*)(sb + gcol0 + bj * HALF + 4 * n);
#pragma unroll
        for (int ai = 0; ai < 2; ++ai)
#pragma unroll
            for (int m = 0; m < 4; ++m) { const int row = row0 + ai * HALF + m * 16; const float sar = sa[row]; bf16_t* rowp = base + (size_t)row * ldc + col0;
#pragma unroll
                for (int bj = 0; bj < 2; ++bj) { const f32x4 v0 = i2f4(acc[ai][bj][m][0]) * sbv[bj][0] * sar, v1 = i2f4(acc[ai][bj][m][1]) * sbv[bj][1] * sar;
                    u32x4 w; w.x = cvt_pk_bf16(v0[0], v0[1]); w.y = cvt_pk_bf16(v0[2], v0[3]); w.z = cvt_pk_bf16(v1[0], v1[1]); w.w = cvt_pk_bf16(v1[2], v1[3]);
                    *(u32x4*)(rowp + bj * HALF) = w; } }
    }
};
struct EpiSwiGLUS {
    static constexpr bool PERM = true;
    bf16_t* Hid; const LAS float* tabs; const float* sb;
    DI void operator()(const i32x4 (&acc)[2][2][4][2], const Unit& u, int wr, int wc, int fr, int fq) const {
        const int row0 = u.pm * BM + wr * 64 + fr, col0 = u.pn * HALF + wc * 32 + 8 * fq;
        const float* sbp = sb + (size_t)u.e * 2048 + u.pn * BM + wc * 32 + 8 * fq;
        f32x4 sg[2], su[2];
#pragma unroll
        for (int n = 0; n < 2; ++n) { sg[n] = *(const f32x4*)(sbp + 4 * n); su[n] = *(const f32x4*)(sbp + HALF + 4 * n); }
#pragma unroll
        for (int ai = 0; ai < 2; ++ai)
#pragma unroll
            for (int m = 0; m < 4; ++m) { const float sar = tabs[u.ord * 256 + ai * HALF + wr * 64 + m * 16 + fr]; bf16_t* rowp = Hid + (size_t)(row0 + ai * HALF + m * 16) * DEXP + col0;
                const f32x4 g0v = i2f4(acc[ai][0][m][0]) * sg[0] * sar, g1v = i2f4(acc[ai][0][m][1]) * sg[1] * sar, u0v = i2f4(acc[ai][1][m][0]) * su[0] * sar, u1v = i2f4(acc[ai][1][m][1]) * su[1] * sar;
                f32x4 h0, h1;
#pragma unroll
                for (int j = 0; j < 4; ++j) { h0[j] = g0v[j] * sigmoidf_(g0v[j]) * u0v[j]; h1[j] = g1v[j] * sigmoidf_(g1v[j]) * u1v[j]; }
                u32x4 w; w.x = cvt_pk_bf16(h0[0], h0[1]); w.y = cvt_pk_bf16(h0[2], h0[3]); w.z = cvt_pk_bf16(h1[0], h1[1]); w.w = cvt_pk_bf16(h1[2], h1[3]);
                *(u32x4*)rowp = w; }
    }
};
template <bool I8> struct AccSel { typedef f32x4 T; };
template <> struct AccSel<true> { typedef i32x4 T; };
DI f32x4 mma16(bf16x8 b, bf16x8 a, f32x4 c) { return __builtin_amdgcn_mfma_f32_16x16x32_bf16(b, a, c, 0, 0, 0); }
DI i32x4 mma16(bf16x8 b, bf16x8 a, i32x4 c) { return __builtin_amdgcn_mfma_i32_16x16x64_i8(__builtin_bit_cast(i32x4, b), __builtin_bit_cast(i32x4, a), c, 0, 0, 0); }
template <class Epi, class Sched, bool I8 = false, bool ALIGN_EPI = true>
DI void gemm_phase(LAS unsigned char* lds, const int Kb  , const Sched& S, const Epi& E) {
    const int tid = threadIdx.x, wid = __builtin_amdgcn_readfirstlane(tid >> 6), lane = tid & 63, wr = wid >> 2, wc = wid & 3, fr = lane & 15, fq = lane >> 4;
    const int nt = Kb / (BK * 2);
    int Rr[2], Cc[2]; unsigned voffB[2];
#pragma unroll
    for (int i = 0; i < 2; ++i) { int R, C; stage_rc(tid * 16 + i * 8192, R, C); Rr[i] = R; Cc[i] = C; const int Rb = Epi::PERM ? ((R & ~31) + perm32(R & 31)) : R; voffB[i] = (unsigned)(Rb * Kb + C * 2); }
    const size_t kstep = (size_t)(BK * 2);
    const size_t hstep = (size_t)HALF * Kb;
    const unsigned ldsw = (unsigned)wid * 1024u;
    const int aoff = lds_byte(wr * 64 + fr, fq * 8), boff = lds_byte(wc * 32 + fr, fq * 8);
#define PG8_SA(b, h) (((b) * 2 + (h)) * HTB)
#define PG8_SB(b, h) ((4 + (b) * 2 + (h)) * HTB)
#define PG8_STAGE(bufoff, gbase, o0, o1) do { \
        __builtin_amdgcn_global_load_lds((const unsigned*)((const char*)(gbase) + (o0)), (LAS unsigned*)(lds + (bufoff) + ldsw), 16, 0, 0); \
        __builtin_amdgcn_global_load_lds((const unsigned*)((const char*)(gbase) + (o1)), (LAS unsigned*)(lds + (bufoff) + ldsw + 8192), 16, 0, 0); } while (0)
#define PG8_STAGEB(bufoff, gbase) PG8_STAGE(bufoff, gbase, voffB[0], voffB[1])
#define PG8_LDA(dst, b, h) do { _Pragma("unroll") for (int m = 0; m < 4; ++m) _Pragma("unroll") for (int k = 0; k < 2; ++k) dst[m][k] = *(const LAS bf16x8*)(lds + PG8_SA(b, h) + aoff + m * 2048 + k * 1024); } while (0)
#define PG8_LDB(dst, b, h) do { _Pragma("unroll") for (int n = 0; n < 2; ++n) _Pragma("unroll") for (int k = 0; k < 2; ++k) dst[n][k] = *(const LAS bf16x8*)(lds + PG8_SB(b, h) + boff + n * 2048 + k * 1024); } while (0)
#define PG8_MMA(ai, bj, At, Bt) do { __builtin_amdgcn_s_setprio(1); _Pragma("unroll") for (int m = 0; m < 4; ++m) _Pragma("unroll") for (int n = 0; n < 2; ++n) _Pragma("unroll") for (int k = 0; k < 2; ++k) \
        acc[ai][bj][m][n] = mma16(Bt[n][k], At[m][k], acc[ai][bj][m][n]); __builtin_amdgcn_s_setprio(0); } while (0)
#define PG8_WAIT_V(n) asm volatile("s_waitcnt vmcnt(" #n ")" ::: "memory")
#define PG8_WAIT_L(n) asm volatile("s_waitcnt lgkmcnt(" #n ")" ::: "memory")
#define PG8_BAR __builtin_amdgcn_s_barrier()
#define PG8_SCHED __builtin_amdgcn_sched_barrier(0)
    Unit cur, nxt; int ui = 0;
    if (!S.next(0, cur)) return;
    typedef typename AccSel<I8>::T AccT;
    AccT acc[2][2][4][2];
#pragma unroll
    for (int a = 0; a < 2; ++a)
#pragma unroll
        for (int b = 0; b < 2; ++b)
#pragma unroll
            for (int m = 0; m < 4; ++m)
#pragma unroll
                for (int n = 0; n < 2; ++n) acc[a][b][m][n] = AccT{};
    bf16x8 At[4][2], B0[2][2], B1[2][2];
    unsigned voA[2][2], voN[2][2];
    S.aoffs(0, cur, Rr, Cc, voA);
#pragma unroll
    for (int h = 0; h < 2; ++h)
#pragma unroll
        for (int p = 0; p < 2; ++p) voN[h][p] = voA[h][p];
    const char* cA = cur.A; const char* cB = cur.B;
    PG8_STAGEB(PG8_SB(0, 0), cB); PG8_STAGEB(PG8_SB(0, 1), cB + hstep); PG8_STAGE(PG8_SA(0, 0), cA, voA[0][0], voA[0][1]); PG8_STAGE(PG8_SA(0, 1), cA, voA[1][0], voA[1][1]);
    if (wr == 1) PG8_BAR;
    PG8_WAIT_V(2); PG8_BAR;
    PG8_STAGEB(PG8_SB(1, 0), cB + kstep); PG8_STAGE(PG8_SA(1, 0), cA + kstep, voA[0][0], voA[0][1]); PG8_STAGEB(PG8_SB(1, 1), cB + hstep + kstep);
    PG8_WAIT_V(6); PG8_BAR;
    for (;;) {
        const bool has_next = S.next(ui + 1, nxt);
        const char* nA = has_next ? nxt.A : cA; const char* nB = has_next ? nxt.B : cB;
        for (int t = 0; t < nt; t += 2) {
            const bool last = (t == nt - 2);
            const char* a1 = cA + (size_t)(t + 1) * kstep;
            const char* a2 = last ? nA : cA + (size_t)(t + 2) * kstep; const char* b2 = last ? nB : cB + (size_t)(t + 2) * kstep;
            const char* a3 = a2 + kstep; const char* b3 = b2 + kstep;
            if (Sched::GATHER) { if (last && has_next) S.aoffs(ui + 1, nxt, Rr, Cc, voN); }
            unsigned s00 = voA[0][0], s01 = voA[0][1], s10 = voA[1][0], s11 = voA[1][1];
            if (Sched::GATHER) { if (last) { s00 = voN[0][0]; s01 = voN[0][1]; s10 = voN[1][0]; s11 = voN[1][1]; } }
            PG8_LDB(B0, 0, 0); PG8_LDB(B1, 0, 1); PG8_SCHED; PG8_LDA(At, 0, 0); PG8_STAGE(PG8_SA(1, 1), a1, voA[1][0], voA[1][1]);
            PG8_WAIT_V(8); PG8_WAIT_L(0); PG8_BAR; PG8_MMA(0, 0, At, B0); PG8_MMA(0, 1, At, B1); PG8_BAR; PG8_SCHED;
            PG8_LDA(At, 0, 1); PG8_STAGEB(PG8_SB(0, 0), b2); PG8_STAGEB(PG8_SB(0, 1), b2 + hstep); PG8_STAGE(PG8_SA(0, 0), a2, s00, s01);
            PG8_WAIT_V(8); PG8_WAIT_L(0); PG8_BAR; PG8_MMA(1, 0, At, B0); PG8_MMA(1, 1, At, B1); PG8_BAR; PG8_SCHED;
            PG8_LDB(B0, 1, 0); PG8_LDB(B1, 1, 1); PG8_SCHED; PG8_LDA(At, 1, 0); PG8_STAGE(PG8_SA(0, 1), a2, s10, s11);
            PG8_WAIT_V(8); PG8_WAIT_L(0); PG8_BAR; PG8_MMA(0, 0, At, B0); PG8_MMA(0, 1, At, B1); PG8_BAR; PG8_SCHED;
            PG8_LDA(At, 1, 1); PG8_STAGEB(PG8_SB(1, 0), b3); PG8_STAGEB(PG8_SB(1, 1), b3 + hstep); PG8_STAGE(PG8_SA(1, 0), a3, s00, s01);
            PG8_WAIT_V(8); PG8_WAIT_L(0); PG8_BAR; PG8_MMA(1, 0, At, B0); PG8_MMA(1, 1, At, B1); PG8_BAR; PG8_SCHED;
        }
        if constexpr (ALIGN_EPI) { if (wr == 0) PG8_BAR; }
        E(acc, cur, wr, wc, fr, fq);
        if (!has_next) break;
#pragma unroll
        for (int a = 0; a < 2; ++a)
#pragma unroll
            for (int b = 0; b < 2; ++b)
#pragma unroll
                for (int m = 0; m < 4; ++m)
#pragma unroll
                    for (int n = 0; n < 2; ++n) acc[a][b][m][n] = AccT{};
        cur = nxt; cA = nA; cB = nB; ++ui;
        if (Sched::GATHER) {
#pragma unroll
            for (int h = 0; h < 2; ++h)
#pragma unroll
                for (int p = 0; p < 2; ++p) voA[h][p] = voN[h][p];
        }
        if constexpr (ALIGN_EPI) { if (wr == 1) PG8_BAR; }
    }
    PG8_WAIT_V(0);
    if constexpr (!ALIGN_EPI) { if (wr == 0) PG8_BAR; }
    PG8_BAR;
#undef PG8_SA
#undef PG8_SB
#undef PG8_STAGE
#undef PG8_STAGEB
#undef PG8_LDA
#undef PG8_LDB
#undef PG8_MMA
#undef PG8_WAIT_V
#undef PG8_WAIT_L
#undef PG8_BAR
#undef PG8_SCHED
}
}

namespace att {
constexpr int KVBLK = 64;
constexpr float SCALE = 0.125f;
constexpr float THR = 8.f;
constexpr int SHM_V = KVBLK * 128 * 2, SHM_K = KVBLK * 128 * 2;
constexpr int ATT_LDS = 2 * SHM_V + 2 * SHM_K + 8 * 64 * 4;
#define KSWZ(row, colB) ((row) * 256 + ((colB) ^ (((row) & 7) << 4)))
#define SBAR() __builtin_amdgcn_sched_barrier(0)
DI int crow(int r, int hi) { return (r & 3) + 8 * (r >> 2) + 4 * hi; }
DI unsigned cvtpk(float lo, float hi) { unsigned r; asm volatile("v_cvt_pk_bf16_f32 %0, %1, %2" : "=v"(r) : "v"(lo), "v"(hi)); return r; }
DI void partialSM(f32x16& p0, f32x16& p1, float& m_reg, float& mn, float& alpha) {
  constexpr float C = SCALE * 1.4426950408889634f;
  float pmax = p0[0];
#pragma unroll
  for (int r = 1; r < 16; ++r) pmax = fmaxf(pmax, p0[r]);
#pragma unroll
  for (int r = 0; r < 16; ++r) pmax = fmaxf(pmax, p1[r]);
  { auto rr = __builtin_amdgcn_permlane32_swap(__float_as_uint(pmax), __float_as_uint(pmax), false, false);
    pmax = fmaxf(__uint_as_float(rr[0]), __uint_as_float(rr[1])); }
  if (__builtin_expect(__all(pmax - m_reg <= THR / SCALE), 1)) { mn = m_reg; alpha = 1.f; }
  else { mn = fmaxf(m_reg, pmax); alpha = __builtin_amdgcn_exp2f((m_reg - mn) * C); m_reg = mn; }
  float mnC = -mn * C;
#pragma unroll
  for (int r = 0; r < 16; ++r) p0[r] = fmaf(p0[r], C, mnC);
#pragma unroll
  for (int r = 0; r < 16; ++r) p1[r] = fmaf(p1[r], C, mnC);
#pragma unroll
  for (int r = 0; r < 16; ++r) p0[r] = __builtin_amdgcn_exp2f(p0[r]);
}
DI void finishSM(f32x16& p0, f32x16& p1, float alpha, float& l_reg, bf16x8& pa0, bf16x8& pa1, bf16x8& pa2, bf16x8& pa3) {
#pragma unroll
  for (int r = 0; r < 16; ++r) p1[r] = __builtin_amdgcn_exp2f(p1[r]);
  float ps = 0;
#pragma unroll
  for (int r = 0; r < 16; ++r) ps += p0[r];
#pragma unroll
  for (int r = 0; r < 16; ++r) ps += p1[r];
  { auto rr = __builtin_amdgcn_permlane32_swap(__float_as_uint(ps), __float_as_uint(ps), false, false);
    ps = __uint_as_float(rr[0]) + __uint_as_float(rr[1]); }
  l_reg = l_reg * alpha + ps;
#define PK4(P, BASE, OUT) do { unsigned a0 = cvtpk(P[BASE + 0], P[BASE + 1]), a1 = cvtpk(P[BASE + 2], P[BASE + 3]);   \
    unsigned b0 = cvtpk(P[BASE + 4], P[BASE + 5]), b1 = cvtpk(P[BASE + 6], P[BASE + 7]);                              \
    auto r0 = __builtin_amdgcn_permlane32_swap(a0, b0, false, false); auto r1 = __builtin_amdgcn_permlane32_swap(a1, b1, false, false); \
    u32x4 w = {r0[0], r1[0], r0[1], r1[1]}; OUT = __builtin_bit_cast(bf16x8, w); } while (0)
  PK4(p0, 0, pa0); PK4(p0, 8, pa1); PK4(p1, 0, pa2); PK4(p1, 8, pa3);
#undef PK4
}
DI void qkt(f32x16& p0, f32x16& p1, const LAS char* Ks, const bf16x8* qr, int r32, int hi, int mo) {
  p0 = f32x16{}; p1 = f32x16{};
#pragma unroll
  for (int d0 = 0; d0 < 4; ++d0) { const int cb = mo + (d0 * 16 + hi * 8) * 2;
    bf16x8 b0 = *(const LAS bf16x8*)(Ks + KSWZ(r32, cb));
    bf16x8 b1 = *(const LAS bf16x8*)(Ks + KSWZ(32 + r32, cb));
    p0 = __builtin_amdgcn_mfma_f32_32x32x16_bf16(b0, qr[d0], p0, 0, 0, 0);
    p1 = __builtin_amdgcn_mfma_f32_32x32x16_bf16(b1, qr[d0], p1, 0, 0, 0); }
}
DI int v_st(int k, int c) { const int kk = (k & ~0xC) | ((k & 4) << 1) | ((k & 8) >> 1); return ((kk >> 3) * 4 + (c >> 5)) * 512 + ((kk & 7) * 32 + (c & 31)) * 2; }
DI int v_rd_base(int lane) { return ((lane & 3) << 3) | (((lane >> 2) & 3) << 6) | (((lane >> 4) & 1) << 5) | (((lane >> 5) & 1) << 8); }
constexpr int v_rd_off(int d0, int ks, int half) { return d0 * 512 + ks * 4096 + half * 2048; }
template <int OFF> DI s16x4 tr_read(int vb) { s16x4 r; asm volatile("ds_read_b64_tr_b16 %0, %1 offset:%2" : "=&v"(r) : "v"(vb), "i"(OFF) : "memory"); return r; }
template <int D0> DI void pv_one(f32x16& od, int vb, bf16x8 pa0, bf16x8 pa1, bf16x8 pa2, bf16x8 pa3) {
  const s16x4 l0 = tr_read<v_rd_off(D0, 0, 0)>(vb), h0 = tr_read<v_rd_off(D0, 0, 1)>(vb), l1 = tr_read<v_rd_off(D0, 1, 0)>(vb), h1 = tr_read<v_rd_off(D0, 1, 1)>(vb);
  const s16x4 l2 = tr_read<v_rd_off(D0, 2, 0)>(vb), h2 = tr_read<v_rd_off(D0, 2, 1)>(vb), l3 = tr_read<v_rd_off(D0, 3, 0)>(vb), h3 = tr_read<v_rd_off(D0, 3, 1)>(vb);
  asm volatile("s_waitcnt lgkmcnt(0)" ::: "memory"); SBAR();
#define PK(L, H) (bf16x8){L[0], L[1], L[2], L[3], H[0], H[1], H[2], H[3]}
  od = __builtin_amdgcn_mfma_f32_32x32x16_bf16(pa0, PK(l0, h0), od, 0, 0, 0);
  od = __builtin_amdgcn_mfma_f32_32x32x16_bf16(pa1, PK(l1, h1), od, 0, 0, 0);
  od = __builtin_amdgcn_mfma_f32_32x32x16_bf16(pa2, PK(l2, h2), od, 0, 0, 0);
  od = __builtin_amdgcn_mfma_f32_32x32x16_bf16(pa3, PK(l3, h3), od, 0, 0, 0);
#undef PK
}
DI void pv_d0(f32x16* o, int vb, bf16x8 pa0, bf16x8 pa1, bf16x8 pa2, bf16x8 pa3) {
  pv_one<0>(o[0], vb, pa0, pa1, pa2, pa3); pv_one<1>(o[1], vb, pa0, pa1, pa2, pa3); pv_one<2>(o[2], vb, pa0, pa1, pa2, pa3); pv_one<3>(o[3], vb, pa0, pa1, pa2, pa3);
}
DI void attn_unit(const bf16_t* Qb, const bf16_t* Kb, const bf16_t* Vb, bf16_t* Ob, int h, int seq, float lam, float osc, const float* subg, LAS char* lds) {
  const int tid = threadIdx.x, wid = __builtin_amdgcn_readfirstlane(tid >> 6), lane = tid & 63, r32 = lane & 31, hi = lane >> 5;
  const int mbr = wid >> 2, wq = wid & 3, mo = mbr * 128;
  LAS char* V_lds = lds; LAS char* K_lds = lds + 2 * SHM_V;
  LAS float* wsl = (LAS float*)(lds + 2 * SHM_V + 2 * SHM_K) + wid * 64; LAS float* li_l = wsl; LAS float* al_l = wsl + 32;
  float m_reg = -1e30f, l_reg = 0; f32x16 o[4] = {}; bf16x8 qr[4];
  const bf16_t* Qw = Qb + (size_t)(wq * 32 + r32) * 1024 + mbr * 512 + h * 64 + hi * 8;
#pragma unroll
  for (int d0 = 0; d0 < 4; ++d0) qr[d0] = *(const bf16x8*)(Qw + d0 * 16);
  const int sr = tid >> 4, sc = (tid & 15) * 8, vst0 = v_st(sr, sc), vst1 = v_st(32 + sr, sc);
  const int kcol = (sc >> 6) * 512 + h * 64 + (sc & 63), vcol = h * 128 + sc;
  const int vb0 = (int)(uintptr_t)V_lds + v_rd_base(lane);
  bf16x8 vsA0, vsA1, ksA0, ksA1, vsB0, vsB1, ksB0, ksB1;
#define SLOADA(k0) do { vsA0 = *(const bf16x8*)(Vb + (size_t)((k0) + sr) * 1024 + vcol); vsA1 = *(const bf16x8*)(Vb + (size_t)((k0) + 32 + sr) * 1024 + vcol); \
    ksA0 = *(const bf16x8*)(Kb + (size_t)((k0) + sr) * 1024 + kcol); ksA1 = *(const bf16x8*)(Kb + (size_t)((k0) + 32 + sr) * 1024 + kcol); } while (0)
#define SLOADB(k0) do { vsB0 = *(const bf16x8*)(Vb + (size_t)((k0) + sr) * 1024 + vcol); vsB1 = *(const bf16x8*)(Vb + (size_t)((k0) + 32 + sr) * 1024 + vcol); \
    ksB0 = *(const bf16x8*)(Kb + (size_t)((k0) + sr) * 1024 + kcol); ksB1 = *(const bf16x8*)(Kb + (size_t)((k0) + 32 + sr) * 1024 + kcol); } while (0)
#define SWRITE(b, v0, v1, k0_, k1_) do { *(LAS bf16x8*)(V_lds + (b) * SHM_V + vst0) = v0; *(LAS bf16x8*)(V_lds + (b) * SHM_V + vst1) = v1; const int kc = sc * 2; \
    *(LAS bf16x8*)(K_lds + (b) * SHM_K + KSWZ(sr, kc)) = k0_; *(LAS bf16x8*)(K_lds + (b) * SHM_K + KSWZ(32 + sr, kc)) = k1_; } while (0)
#define SWAIT() asm volatile("s_waitcnt vmcnt(4)" ::: "memory")
#define RESC(a) do { if (__any((a) < 1.f)) { if (hi == 0) al_l[r32] = (a); asm volatile("s_waitcnt lgkmcnt(0)" ::: "memory"); \
    _Pragma("unroll") for (int d = 0; d < 4; ++d) _Pragma("unroll") for (int r = 0; r < 16; ++r) o[d][r] *= al_l[crow(r, hi)]; } } while (0)
  f32x16 pA0, pA1, pB0, pB1; float mnA, mnB, alA, alB; bf16x8 pa0, pa1, pa2, pa3; const int NT = seq / KVBLK;
  SLOADA(0); asm volatile("s_waitcnt vmcnt(0)" ::: "memory"); SWRITE(0, vsA0, vsA1, ksA0, ksA1); __syncthreads();
  qkt(pA0, pA1, K_lds, qr, r32, hi, mo); partialSM(pA0, pA1, m_reg, mnA, alA);
  SLOADB(KVBLK); if (2 < NT) SLOADA(2 * KVBLK);
  SWAIT(); SWRITE(1, vsB0, vsB1, ksB0, ksB1); __syncthreads();
  for (int j = 1; j + 1 < NT; j += 2) {
    SBAR(); qkt(pB0, pB1, K_lds + SHM_K, qr, r32, hi, mo);
    finishSM(pA0, pA1, alA, l_reg, pa0, pa1, pa2, pa3); SBAR();
    SLOADB((j + 2) * KVBLK); SBAR();
    pv_d0(o, vb0, pa0, pa1, pa2, pa3); partialSM(pB0, pB1, m_reg, mnB, alB);
    __syncthreads(); SWAIT(); SWRITE(0, vsA0, vsA1, ksA0, ksA1);
    RESC(alB); __syncthreads();
    SBAR(); qkt(pA0, pA1, K_lds, qr, r32, hi, mo);
    finishSM(pB0, pB1, alB, l_reg, pa0, pa1, pa2, pa3); SBAR();
    if (j + 3 < NT) SLOADA((j + 3) * KVBLK); SBAR();
    pv_d0(o, vb0 + SHM_V, pa0, pa1, pa2, pa3); partialSM(pA0, pA1, m_reg, mnA, alA);
    __syncthreads(); SWAIT(); SWRITE(1, vsB0, vsB1, ksB0, ksB1);
    RESC(alA); __syncthreads();
  }
  SBAR(); qkt(pB0, pB1, K_lds + SHM_K, qr, r32, hi, mo);
  finishSM(pA0, pA1, alA, l_reg, pa0, pa1, pa2, pa3); SBAR();
  pv_d0(o, vb0, pa0, pa1, pa2, pa3); partialSM(pB0, pB1, m_reg, mnB, alB);
  __syncthreads(); RESC(alB);
  finishSM(pB0, pB1, alB, l_reg, pa0, pa1, pa2, pa3); SBAR();
  pv_d0(o, vb0 + SHM_V, pa0, pa1, pa2, pa3);
  if (hi == 0) li_l[r32] = l_reg; asm volatile("s_waitcnt lgkmcnt(0)" ::: "memory");
  float rli[16];
#pragma unroll
  for (int r = 0; r < 16; ++r) rli[r] = 1.0f / li_l[crow(r, hi)];
  asm volatile("s_waitcnt vmcnt(0)" ::: "memory");
  __syncthreads();
  LAS float* ex = (LAS float*)lds;
  if (mbr == 1) {
#pragma unroll
    for (int r = 0; r < 16; ++r)
#pragma unroll
      for (int d0 = 0; d0 < 4; ++d0) ex[((wq * 16 + r) * 4 + d0) * 64 + lane] = o[d0][r] * rli[r] * lam;
  }
  asm volatile("s_waitcnt lgkmcnt(0)" ::: "memory");
  __syncthreads();
  if (mbr == 0) {
    float g[4];
#pragma unroll
    for (int d0 = 0; d0 < 4; ++d0) g[d0] = subg[d0 * 32 + r32] * osc;
    bf16_t* Ow = Ob + (size_t)(wq * 32) * 1024 + h * 128;
#pragma unroll
    for (int r = 0; r < 16; ++r) {
      float v[4]; float ss = 0.f;
#pragma unroll
      for (int d0 = 0; d0 < 4; ++d0) { v[d0] = o[d0][r] * rli[r] - ex[((wq * 16 + r) * 4 + d0) * 64 + lane]; ss += v[d0] * v[d0]; }
#pragma unroll
      for (int of = 1; of < 32; of <<= 1) ss += __shfl_xor(ss, of);
      const float rs = 1.0f / sqrtf(ss * (1.0f / 128.0f) + LN_EPS);
      const int orow = crow(r, hi);
#pragma unroll
      for (int d0 = 0; d0 < 4; ++d0) Ow[(size_t)orow * 1024 + d0 * 32 + r32] = (bf16_t)f2bf(v[d0] * rs * g[d0]);
    }
  }
  asm volatile("s_waitcnt lgkmcnt(0)" ::: "memory");
  __syncthreads();
#undef SLOADA
#undef SLOADB
#undef SWRITE
#undef SWAIT
#undef RESC
}
}

struct Args { const float* in[37]; float* out; unsigned char* ws; int ph_lo, ph_hi; };
struct Frame { LAS unsigned char* lds; int tid, lane, wave, G, bid, gw, NGW; };
enum { I_X = 0, I_C, I_CTX, I_CCTX, I_WADA, I_BADA, I_LNG, I_LNB, I_AWIN, I_AWOUT, I_ALAM, I_ASUB, I_S5WIN, I_S5ARE, I_S5AIM, I_S5BRE, I_S5BIM, I_S5CRE, I_S5CIM, I_S5LDT, I_S5D, I_S5GV, I_S5GG,
       I_LWIN, I_LCW, I_LCB, I_LWA, I_LBA, I_LWX, I_LBX, I_LLAM, I_LWOUT, I_RW, I_RB, I_MG, I_MU, I_MD };

DI unsigned pack4_i8(f32x4 v, float inv) {
    const int a = (int)rintf(v[0] * inv), b = (int)rintf(v[1] * inv), c = (int)rintf(v[2] * inv), d = (int)rintf(v[3] * inv);
    return (unsigned)(a & 255) | ((unsigned)(b & 255) << 8) | ((unsigned)(c & 255) << 16) | ((unsigned)d << 24);
}
DI void store_h8(signed char* hrow, float* sa, int lane, const f32x4 (&v)[4]) {
    float m = 0.f;
#pragma unroll
    for (int j = 0; j < 4; ++j) m = fmaxf(m, fmaxf(fmaxf(fabsf(v[j][0]), fabsf(v[j][1])), fmaxf(fabsf(v[j][2]), fabsf(v[j][3]))));
    m = wave_max(m);
    const float inv = m > 0.f ? 127.0f / m : 0.f;
#pragma unroll
    for (int j = 0; j < 4; ++j) *(unsigned*)(hrow + 4 * lane + 256 * j) = pack4_i8(v[j], inv);
    if (lane == 0) *sa = m * (1.0f / 127.0f);
}
DI void quant_strip(const float* W, int ldw, int n0, signed char* WT8, float* SB, int drow0, LAS float* red, int tid) {
    const int c4 = (tid & 7) * 4, r0 = (tid >> 3) * 16, lane = tid & 63, wave = tid >> 6;
    f32x4 v[16]; const float* wp = W + (size_t)r0 * ldw + n0 + c4;
#pragma unroll
    for (int i = 0; i < 16; ++i) v[i] = *(const f32x4*)(wp + (size_t)i * ldw);
    f32x4 mx = {0.f, 0.f, 0.f, 0.f};
#pragma unroll
    for (int i = 0; i < 16; ++i)
#pragma unroll
        for (int q = 0; q < 4; ++q) mx[q] = fmaxf(mx[q], fabsf(v[i][q]));
#pragma unroll
    for (int q = 0; q < 4; ++q) { mx[q] = fmaxf(mx[q], __shfl_xor(mx[q], 8)); mx[q] = fmaxf(mx[q], __shfl_xor(mx[q], 16)); mx[q] = fmaxf(mx[q], __shfl_xor(mx[q], 32)); }
    if (lane < 8) *(LAS f32x4*)(red + wave * 32 + lane * 4) = mx;
    LDS_WAIT();
    __syncthreads();
    f32x4 m = *(const LAS f32x4*)(red + c4);
#pragma unroll
    for (int w = 1; w < 8; ++w) { const f32x4 t = *(const LAS f32x4*)(red + w * 32 + c4);
#pragma unroll
        for (int q = 0; q < 4; ++q) m[q] = fmaxf(m[q], t[q]); }
#pragma unroll
    for (int q = 0; q < 4; ++q) { const float inv = m[q] > 0.f ? 127.0f / m[q] : 0.f; u32x4 o;
        o.x = pack4_i8((f32x4){v[0][q], v[1][q], v[2][q], v[3][q]}, inv); o.y = pack4_i8((f32x4){v[4][q], v[5][q], v[6][q], v[7][q]}, inv);
        o.z = pack4_i8((f32x4){v[8][q], v[9][q], v[10][q], v[11][q]}, inv); o.w = pack4_i8((f32x4){v[12][q], v[13][q], v[14][q], v[15][q]}, inv);
        *(u32x4*)(WT8 + (size_t)(drow0 + c4 + q) * 1024 + r0) = o; }
    if (tid < 8) *(f32x4*)(SB + drow0 + c4) = m * (1.0f / 127.0f);
    __syncthreads();
}
DI void transpose_tile(const float* W, int ldw, int k0, int n0, bf16_t* WT, int ldt, int drow0, LAS float* scr, int lane) {
    float v[32];
    const float* wp = W + (size_t)(k0 + (lane >> 5)) * ldw + n0 + (lane & 31);
#pragma unroll
    for (int i = 0; i < 32; ++i) v[i] = wp[(size_t)(2 * i) * ldw];
#pragma unroll
    for (int i = 0; i < 32; ++i) scr[(2 * i + (lane >> 5)) * 33 + (lane & 31)] = v[i];
    LDS_WAIT(); asm volatile("" ::: "memory");
    const int c = lane & 7;
#pragma unroll
    for (int j = 0; j < 4; ++j) { const int n = (lane >> 3) + 8 * j; const LAS float* s = scr + (8 * c) * 33 + n;
        u32x4 o; o.x = pk2(s[0 * 33], s[1 * 33]); o.y = pk2(s[2 * 33], s[3 * 33]); o.z = pk2(s[4 * 33], s[5 * 33]); o.w = pk2(s[6 * 33], s[7 * 33]);
        *(u32x4*)(WT + (size_t)(drow0 + n) * ldt + k0 + 8 * c) = o; }
    LDS_WAIT(); asm volatile("" ::: "memory");
}
DI void transpose_item(const float* W, int K, int N, bf16_t* WT, int item, int drow_base, LAS float* scr, int lane) {
    const int nblk = N / 32, kb = item / nblk, nb = item % nblk;
    transpose_tile(W, N, 64 * kb, 32 * nb, WT, K, drow_base + 32 * nb, scr, lane);
}
DI void convert_moe_weights(const Args& a, const Frame& F, int li) {
    signed char* WGU = (signed char*)(a.ws + WS_WGU); float* SBG = (float*)(a.ws + WS_SCL + SCL_GU); bf16_t* WD = (bf16_t*)(a.ws + WS_WD);
    for (int st = F.bid; st < 2 * 16 * 32; st += F.G) {
        const int which = st >> 9, e = (st >> 5) & 15, n0 = (st & 31) * 32;
        const size_t moff = ((size_t)(li * 16 + e)) * 1024 * 1024;
        quant_strip(a.in[which ? I_MU : I_MG] + moff, 1024, n0, WGU, SBG, e * 2048 + (n0 >> 7) * 256 + which * 128 + (n0 & 127), (LAS float*)F.lds, F.tid);
    }
    LAS float* scr = (LAS float*)(F.lds + F.wave * 16384);
    constexpr int PER = 16 * 32;
    for (int it = F.gw; it < 16 * PER; it += F.NGW) {
        const int e = it / PER, item = it % PER, kb = item / 32, nb = item % 32, n0 = 32 * nb;
        transpose_tile(a.in[I_MD] + ((size_t)(li * 16 + e)) * 1024 * 1024, 1024, 64 * kb, n0, WD, 1024, e * 1024 + n0, scr, F.lane);
    }
}

DI void p0_prologue(const Args& a, const Frame& F) {
    LAS float* scr = (LAS float*)(F.lds + F.wave * 16384);
    unsigned char* ws = a.ws;
    {
        constexpr int I_AOUT = 16 * 32, I_S5 = 16 * 32, I_LOUT = 22 * 32;
        constexpr int NIT = 2 * I_AOUT + 2 * I_S5 + I_LOUT;
        for (int it = F.gw; it < NIT; it += F.NGW) {
            int r = it;
            if (r < 2 * I_AOUT) { const int sl = r / I_AOUT; transpose_item(a.in[I_AWOUT] + (size_t)sl * 1024 * 1024, 1024, 1024, (bf16_t*)(ws + WS_WATT_OUT) + (size_t)sl * 1024 * 1024, r % I_AOUT, 0, scr, F.lane); continue; } r -= 2 * I_AOUT;
            if (r < 2 * I_S5) { const int which = r / I_S5, item = r % I_S5, kb = item / 32, nb = item % 32, n0 = 32 * nb;
                transpose_tile(a.in[which ? I_S5GG : I_S5GV], 1024, 64 * kb, n0, (bf16_t*)(ws + WS_WS5_GLU), 1024, (n0 >> 7) * 256 + which * 128 + (n0 & 127), scr, F.lane); continue; } r -= 2 * I_S5;
            transpose_item(a.in[I_LWOUT], 1408, 1024, (bf16_t*)(ws + WS_WLRU_OUT), r, 0, scr, F.lane);
        }
        __syncthreads();
        for (int st = F.bid; st < 2 * 96 + 32 + 88; st += F.G) {
            if (st < 192) { const int sl = st / 96, n0 = (st % 96) * 32; quant_strip(a.in[I_AWIN] + (size_t)sl * 1024 * 3072, 3072, n0, (signed char*)(ws + WS_WATT_IN) + (size_t)sl * 3072 * 1024, (float*)(ws + WS_SCL + SCL_ATT) + sl * 3072, n0, (LAS float*)F.lds, F.tid); }
            else if (st < 224) { const int n0 = (st - 192) * 32; quant_strip(a.in[I_S5WIN], 1024, n0, (signed char*)(ws + WS_WS5_IN), (float*)(ws + WS_SCL + SCL_S5), n0, (LAS float*)F.lds, F.tid); }
            else { const int n0 = (st - 224) * 32; quant_strip(a.in[I_LWIN], 2816, n0, (signed char*)(ws + WS_WLRU_IN), (float*)(ws + WS_SCL + SCL_LRU), n0, (LAS float*)F.lds, F.tid); }
        }
    }
    __syncthreads();
    if (F.bid < 192) {
        LAS float* sl = (LAS float*)F.lds;
        for (int i = F.tid; i < 9 * 1024; i += 512) { const int r = i >> 10, k = i & 1023; const float v = (r < 8) ? a.in[I_C][r * 1024 + k] : a.in[I_CCTX][k]; sl[i] = v / (1.0f + __expf(-v)); }
        __syncthreads();
        const int ks = F.gw / 96, cg = F.gw % 96, col4 = cg * 64 + F.lane, layer = col4 / 1536, c4 = (col4 % 1536) * 4;
        f32x4 acc[9];
#pragma unroll
        for (int r = 0; r < 9; ++r) acc[r] = (f32x4){0.f, 0.f, 0.f, 0.f};
        const float* wp = a.in[I_WADA] + (size_t)layer * 1024 * 6144 + (size_t)(ks * 64) * 6144 + c4;
#pragma unroll 4
        for (int k = 0; k < 64; ++k) { const f32x4 w = *(const f32x4*)(wp + (size_t)k * 6144);
#pragma unroll
            for (int r = 0; r < 9; ++r) { const float s = sl[r * 1024 + ks * 64 + k]; acc[r] += w * s; } }
        float* mp = (float*)(ws + WS_MODP) + ((size_t)(ks * 4 + layer) * 9) * 6144 + c4;
#pragma unroll
        for (int r = 0; r < 9; ++r) *(f32x4*)(mp + (size_t)r * 6144) = acc[r];
        __syncthreads();
    }
    const int gt = F.bid * 512 + F.tid, NGT = F.G * 512;
    for (int t = gt; t < 8192; t += NGT) {
        const int p = t & 63;
        const float dt = expf(a.in[I_S5LDT][t >> 6]);
        const float Ar = a.in[I_S5ARE][t], Ai = a.in[I_S5AIM][t];
        const float mag = expf(Ar * dt); float sn, cs; sincos_cw(Ai * dt, sn, cs);
        const float zr = mag * cs, zi = mag * sn, den = Ar * Ar + Ai * Ai;
        const float kr = ((zr - 1.0f) * Ar + zi * Ai) / den, ki = (zi * Ar - (zr - 1.0f) * Ai) / den;
        ((float*)(ws + WS_PAR + PAR_ZR))[t] = zr; ((float*)(ws + WS_PAR + PAR_ZI))[t] = zi;
#pragma unroll
        for (int n = 0; n < 16; ++n) { const float br = a.in[I_S5BRE][(size_t)t * 16 + n], bi = a.in[I_S5BIM][(size_t)t * 16 + n];
            ((float*)(ws + WS_PAR + PAR_BBR))[(size_t)t * 16 + n] = kr * br - ki * bi; ((float*)(ws + WS_PAR + PAR_BBI))[(size_t)t * 16 + n] = kr * bi + ki * br; }
        (void)p;
    }
    for (int t = gt; t < 8192 * 33; t += NGT) {
        const int sidx = t / 33, tau = t % 33; const float dt = expf(a.in[I_S5LDT][sidx >> 6]);
        const float Ar = a.in[I_S5ARE][sidx], Ai = a.in[I_S5AIM][sidx]; const float mag = expf((float)tau * (Ar * dt)); float sn, cs; sincos_cw((float)tau * (Ai * dt), sn, cs);
        ((f32x2*)(ws + WS_S5ZP))[t] = (f32x2){mag * cs, mag * sn};
    }
    for (int t = gt; t < 1024; t += NGT) {
        const int pos = t >> 4, j = t & 15; const float freq = exp2f(-(float)j * (13.287712379549449f / 16.0f)); float sn, cs; sincos_cw((float)pos * freq, sn, cs);
        ((f32x2*)(ws + WS_PAR + PAR_ROPE))[t] = (f32x2){cs, sn};
    }
    for (int t = gt; t < 2 * LRUW; t += NGT) ((float*)(ws + WS_PAR + PAR_SP))[t] = log1pf(expf(-a.in[I_LLAM][t]));
    for (int t = gt; t < 2 * 2 * 16 * 96 * 96; t += NGT) {
        const int d = t % 96, e = (t / 96) % 96, n = (t / 9216) % 16, mat = (t / (9216 * 16)) % 2, dir = t / (9216 * 32);
        float v = 0.f; if (d < 88 && e < 88) v = a.in[mat ? I_LWX : I_LWA][(((size_t)dir * 16 + n) * 88 + d) * 88 + e];
        ((bf16_t*)(ws + WS_BD))[t] = (bf16_t)f2bf(v);
    }
}
DI void p0b_modreduce(const Args& a, const Frame& F) {
    const int gt = F.bid * 512 + F.tid, NGT = F.G * 512;
    for (int t = gt; t < 4 * 9 * 1536; t += NGT) {
        const int c4 = (t % 1536) * 4, lr = t / 1536, layer = lr / 9;
        f32x4 s = *(const f32x4*)(a.in[I_BADA] + (size_t)layer * 6144 + c4);
#pragma unroll
        for (int ks = 0; ks < 16; ++ks) s += *(const f32x4*)((const float*)(a.ws + WS_MODP) + ((size_t)ks * 36 + lr) * 6144 + c4);
        *(f32x4*)((float*)(a.ws + WS_MOD) + (size_t)lr * 6144 + c4) = s;
    }
}
DI void s5_tables_a(const Args& a, const Frame& F) {
    const int gt = F.bid * 512 + F.tid, NGT = F.G * 512;
    const f32x2* ZP = (const f32x2*)(a.ws + WS_S5ZP); const float* BBR = (const float*)(a.ws + WS_PAR + PAR_BBR); const float* BBI = (const float*)(a.ws + WS_PAR + PAR_BBI);
    for (int t = gt; t < 64 * 2 * 32 * 16; t += NGT) {
        const int no = t & 15, tau = (t >> 4) & 31, dir = (t >> 9) & 1, g = t >> 10;
        float acc[16];
#pragma unroll
        for (int ni = 0; ni < 16; ++ni) acc[ni] = 0.f;
        for (int p = 0; p < 64; ++p) {
            const int sidx = (dir * 64 + g) * 64 + p; const f32x2 z = ZP[sidx * 33 + tau];
            const float cr = a.in[I_S5CRE][((size_t)(dir * 64 + g) * 16 + no) * 64 + p], ci = a.in[I_S5CIM][((size_t)(dir * 64 + g) * 16 + no) * 64 + p];
            const float wr = cr * z.x - ci * z.y, wi = cr * z.y + ci * z.x;
#pragma unroll
            for (int ni = 0; ni < 16; ++ni) acc[ni] += wr * BBR[(size_t)sidx * 16 + ni] - wi * BBI[(size_t)sidx * 16 + ni];
        }
        float* kt = (float*)(a.ws + WS_S5KT) + (size_t)t * 16;
#pragma unroll
        for (int ni = 0; ni < 16; ++ni) kt[ni] = acc[ni];
    }
    for (int t = gt; t < 64 * 8 * 32 * 64; t += NGT) {
        const int lane = t & 63, ks = (t >> 6) & 31, cb = (t >> 11) & 7, g = t >> 14;
        const int col = cb * 32 + (lane & 31), dir = col >> 7, reim = (col >> 6) & 1, p = col & 63, n0 = 8 * (lane >> 5);
        const int sidx = (dir * 64 + g) * 64 + p; const f32x2 z = ZP[sidx * 33 + (dir ? ks : 31 - ks)];
        float v[8];
#pragma unroll
        for (int j = 0; j < 8; ++j) { const float br = BBR[(size_t)sidx * 16 + n0 + j], bi = BBI[(size_t)sidx * 16 + n0 + j]; v[j] = reim ? (z.x * bi + z.y * br) : (z.x * br - z.y * bi); }
        u32x4 o; o.x = pk2(v[0], v[1]); o.y = pk2(v[2], v[3]); o.z = pk2(v[4], v[5]); o.w = pk2(v[6], v[7]);
        *(u32x4*)((bf16_t*)(a.ws + WS_S5W1) + (size_t)t * 8) = o;
    }
    for (int t = gt; t < 64 * 16 * 16 * 64; t += NGT) {
        const int lane = t & 63, ks = 32 + ((t >> 6) & 15), cb = (t >> 10) & 15, g = t >> 14;
        const int col = cb * 32 + (lane & 31), to = col >> 4, no = col & 15, kk0 = (ks - 32) * 16 + 8 * (lane >> 5), dir = kk0 >> 7, reim = (kk0 >> 6) & 1, p0 = kk0 & 63;
        float v[8];
#pragma unroll
        for (int j = 0; j < 8; ++j) { const int p = p0 + j; const int sidx = (dir * 64 + g) * 64 + p; const f32x2 z = ZP[sidx * 33 + (dir ? 32 - to : to + 1)];
            const float cr = a.in[I_S5CRE][((size_t)(dir * 64 + g) * 16 + no) * 64 + p], ci = a.in[I_S5CIM][((size_t)(dir * 64 + g) * 16 + no) * 64 + p];
            v[j] = reim ? -(cr * z.y + ci * z.x) : (cr * z.x - ci * z.y); }
        u32x4 o; o.x = pk2(v[0], v[1]); o.y = pk2(v[2], v[3]); o.z = pk2(v[4], v[5]); o.w = pk2(v[6], v[7]);
        *(u32x4*)((bf16_t*)(a.ws + WS_S5W2) + (((size_t)(g * 16 + cb) * 48 + ks) * 64 + lane) * 8) = o;
    }
}
DI void s5_tables_b(const Args& a, const Frame& F) {
    const int gt = F.bid * 512 + F.tid, NGT = F.G * 512;
    const float* KT = (const float*)(a.ws + WS_S5KT);
    for (int t = gt; t < 64 * 16 * 32 * 64; t += NGT) {
        const int lane = t & 63, ti = (t >> 6) & 31, cb = (t >> 11) & 15, g = t >> 15;
        const int col = cb * 32 + (lane & 31), to = col >> 4, no = col & 15, n0 = 8 * (lane >> 5);
        float v[8];
#pragma unroll
        for (int j = 0; j < 8; ++j) v[j] = 0.f;
        if (ti <= to) { const float* k0 = KT + ((((size_t)(g * 2 + 0) * 32 + (to - ti)) * 16 + no) * 16 + n0);
#pragma unroll
            for (int j = 0; j < 8; ++j) v[j] += k0[j]; }
        if (ti >= to) { const float* k1 = KT + ((((size_t)(g * 2 + 1) * 32 + (ti - to)) * 16 + no) * 16 + n0);
#pragma unroll
            for (int j = 0; j < 8; ++j) v[j] += k1[j]; }
        if (ti == to) {
#pragma unroll
            for (int j = 0; j < 8; ++j) if (n0 + j == no) v[j] += a.in[I_S5D][g * 16 + no]; }
        u32x4 o; o.x = pk2(v[0], v[1]); o.y = pk2(v[2], v[3]); o.z = pk2(v[4], v[5]); o.w = pk2(v[6], v[7]);
        *(u32x4*)((bf16_t*)(a.ws + WS_S5W2) + (((size_t)(g * 16 + cb) * 48 + ti) * 64 + lane) * 8) = o;
    }
}
DI const float* mod_row(const Args& a, int li, int row) { const int p = row % LSEQ, b = row / LSEQ; return (const float*)(a.ws + WS_MOD) + (size_t)(li * 9 + (p < CN ? 8 : b)) * 6144; }
DI void store_h(bf16_t* hrow, int lane, const f32x4 (&v)[4]) {
#pragma unroll
    for (int j = 0; j < 4; ++j) { u32x2 w; w.x = pk2(v[j][0], v[j][1]); w.y = pk2(v[j][2], v[j][3]); *(u32x2*)(hrow + 4 * lane + 256 * j) = w; }
}
DI void p1_init(const Args& a, const Frame& F) {
    float* X = (float*)(a.ws + WS_X); signed char* H = (signed char*)(a.ws + WS_H); float* SA = (float*)(a.ws + WS_SCL + SCL_SA);
    for (int row = F.gw; row < MROWS; row += F.NGW) {
        const int b = row / LSEQ, p = row % LSEQ;
        const float* src = (p < CN) ? a.in[I_CTX] + ((size_t)b * CN + p) * D : a.in[I_X] + ((size_t)b * TL + (p - CN)) * D;
        const float* mr = mod_row(a, 0, row);
        f32x4 v[4], h[4];
#pragma unroll
        for (int j = 0; j < 4; ++j) { const int c = 4 * F.lane + 256 * j; v[j] = *(const f32x4*)(src + c); const f32x4 sh = *(const f32x4*)(mr + c), sc = *(const f32x4*)(mr + 1024 + c);
            h[j] = v[j] * (sc + 1.0f) + sh; *(f32x4*)(X + (size_t)row * D + c) = v[j]; }
        store_h8(H + (size_t)row * D, SA + row, F.lane, h);
    }
}
DI void ln_row(f32x4 (&v)[4], const float* g, const float* bta, int lane) {
    float s = 0.f;
#pragma unroll
    for (int j = 0; j < 4; ++j) s += (v[j][0] + v[j][1]) + (v[j][2] + v[j][3]);
    const float mean = wave_sum(s) * (1.0f / D); float q = 0.f;
#pragma unroll
    for (int j = 0; j < 4; ++j) { v[j] = v[j] - mean; q += (v[j][0] * v[j][0] + v[j][1] * v[j][1]) + (v[j][2] * v[j][2] + v[j][3] * v[j][3]); }
    const float rstd = 1.0f / sqrtf(wave_sum(q) * (1.0f / D) + LN_EPS);
#pragma unroll
    for (int j = 0; j < 4; ++j) { const int c = 4 * lane + 256 * j; v[j] = v[j] * rstd * *(const f32x4*)(g + c) + *(const f32x4*)(bta + c); }
}

DI void m0_route(const Args& a, const Frame& F, int li) {
    convert_moe_weights(a, F, li);
    __syncthreads();
    LAS float* rw = (LAS float*)F.lds;
    LAS int* lcnt = (LAS int*)(F.lds + 65536);
    LAS int* rinfo = (LAS int*)(F.lds + 65536 + 256);
    LAS float* rwt = (LAS float*)(F.lds + 65536 + 256 + 8 * 9 * 16);
    for (int i = F.tid; i < 16 * 1024; i += 512) { const int k = i >> 4, e = i & 15; rw[e * 1024 + k] = a.in[I_RW][i]; }
    if (F.tid < 32) lcnt[F.tid] = 0;
    __syncthreads();
    float* X = (float*)(a.ws + WS_X); signed char* H = (signed char*)(a.ws + WS_H); float* SA = (float*)(a.ws + WS_SCL + SCL_SA);
    const float* lg = a.in[I_LNG] + (size_t)(li * 2 + 0) * D; const float* lb = a.in[I_LNB] + (size_t)(li * 2 + 0) * D;
    int nrows = 0;
    for (int row = F.gw; row < MROWS; row += F.NGW, ++nrows) {
        const float* mr = mod_row(a, li, row);
        f32x4 v[4], h[4];
#pragma unroll
        for (int j = 0; j < 4; ++j) v[j] = *(const f32x4*)(X + (size_t)row * D + 4 * F.lane + 256 * j);
        ln_row(v, lg, lb, F.lane);
#pragma unroll
        for (int j = 0; j < 4; ++j) { const int c = 4 * F.lane + 256 * j; *(f32x4*)(X + (size_t)row * D + c) = v[j]; const f32x4 sh = *(const f32x4*)(mr + 3072 + c), sc = *(const f32x4*)(mr + 4096 + c); h[j] = v[j] * (sc + 1.0f) + sh; }
        store_h8(H + (size_t)row * D, SA + row, F.lane, h);
        float part[16];
#pragma unroll
        for (int e = 0; e < 16; ++e) { float s = 0.f;
#pragma unroll
            for (int j = 0; j < 4; ++j) { const f32x4 w = *(const LAS f32x4*)(rw + e * 1024 + 4 * F.lane + 256 * j); s += (h[j][0] * w[0] + h[j][1] * w[1]) + (h[j][2] * w[2] + h[j][3] * w[3]); }
            part[e] = s; }
        float lg16[16];
        {
            const int b5 = F.lane & 32, b4 = F.lane & 16, b3 = F.lane & 8, b2 = F.lane & 4;
            float v8[8], v4[4], v2[2];
#pragma unroll
            for (int k = 0; k < 8; ++k) { const float send = b5 ? part[k] : part[k + 8], keep = b5 ? part[k + 8] : part[k]; v8[k] = keep + __shfl_xor(send, 32); }
#pragma unroll
            for (int k = 0; k < 4; ++k) { const float send = b4 ? v8[k] : v8[k + 4], keep = b4 ? v8[k + 4] : v8[k]; v4[k] = keep + __shfl_xor(send, 16); }
#pragma unroll
            for (int k = 0; k < 2; ++k) { const float send = b3 ? v4[k] : v4[k + 2], keep = b3 ? v4[k + 2] : v4[k]; v2[k] = keep + __shfl_xor(send, 8); }
            float v1; { const float send = b2 ? v2[0] : v2[1], keep = b2 ? v2[1] : v2[0]; v1 = keep + __shfl_xor(send, 4); }
            v1 += __shfl_xor(v1, 1); v1 += __shfl_xor(v1, 2);
#pragma unroll
            for (int e = 0; e < 16; ++e) lg16[e] = __shfl(v1, e * 4);
        }
        float mx = lg16[0];
#pragma unroll
        for (int e = 1; e < 16; ++e) mx = fmaxf(mx, lg16[e]);
        float pr[16], sum = 0.f;
#pragma unroll
        for (int e = 0; e < 16; ++e) { pr[e] = __expf(lg16[e] - mx); sum += pr[e]; }
        const float inv = 1.0f / sum;
        float bestg = -3.0e38f; int e1 = 0, e2 = 1; float p1 = 0.f, p2 = 0.f;
#pragma unroll
        for (int g = 0; g < 4; ++g) {
            float b1 = -3.0e38f, b2 = -3.0e38f; int i1 = 0, i2 = 0; float q1 = 0.f, q2 = 0.f;
#pragma unroll
            for (int k = 0; k < 4; ++k) { const float p = pr[4 * g + k] * inv; const float sv = p + a.in[I_RB][4 * g + k];
                if (sv > b1) { b2 = b1; i2 = i1; q2 = q1; b1 = sv; i1 = 4 * g + k; q1 = p; } else if (sv > b2) { b2 = sv; i2 = 4 * g + k; q2 = p; } }
            const float gs = b1 + b2;
            if (gs > bestg) { bestg = gs; e1 = i1; e2 = i2; p1 = q1; p2 = q2; }
        }
        const float wn = 1.0f / (p1 + p2);
        if (F.lane == 0) { const int lp1 = atomicAdd((int*)&lcnt[e1], 1), lp2 = atomicAdd((int*)&lcnt[e2], 1);
            LAS int* ri = rinfo + (F.wave * 9 + nrows) * 4; ri[0] = e1; ri[1] = lp1; ri[2] = e2; ri[3] = lp2;
            rwt[(F.wave * 9 + nrows) * 2 + 0] = p1 * wn; rwt[(F.wave * 9 + nrows) * 2 + 1] = p2 * wn; }
    }
    LDS_WAIT();
    __syncthreads();
    if (F.tid < 16) lcnt[16 + F.tid] = (int)__hip_atomic_fetch_add((unsigned*)(a.ws + WS_CTL) + CW_CNT + (li * 16 + F.tid) * 64, (unsigned)lcnt[F.tid], RLX_AGENT);
    LDS_WAIT();
    __syncthreads();
    if (F.lane == 0) {
        unsigned* tok = (unsigned*)(a.ws + WS_TOK); int* lists = (int*)(a.ws + WS_TOK + MiB);
        int k = 0;
        for (int row = F.gw; row < MROWS; row += F.NGW, ++k) {
            const LAS int* ri = rinfo + (F.wave * 9 + k) * 4; const int e1 = ri[0], e2 = ri[2]; const int pos1 = lcnt[16 + e1] + ri[1], pos2 = lcnt[16 + e2] + ri[3];
            lists[(size_t)e1 * MROWS + pos1] = row; lists[(size_t)e2 * MROWS + pos2] = row;
            u32x4 w0; w0.x = (unsigned)e1; w0.y = (unsigned)pos1; w0.z = (unsigned)e2; w0.w = (unsigned)pos2;
            *(u32x4*)(tok + (size_t)row * 8) = w0; tok[(size_t)row * 8 + 4] = __float_as_uint(rwt[(F.wave * 9 + k) * 2]); tok[(size_t)row * 8 + 5] = __float_as_uint(rwt[(F.wave * 9 + k) * 2 + 1]);
        }
    }
}
DI int moe_tile_table(const Args& a, const Frame& F, int li) {
    LAS int* tb = (LAS int*)(F.lds + TB_OFF);
    if (F.tid < 64) {
        int c = 0; if (F.lane < 16) c = (int)__hip_atomic_load((unsigned*)(a.ws + WS_CTL) + CW_CNT + (li * 16 + F.lane) * 64, RLX_AGENT);
        const int nt = (c + 255) >> 8; int inc = nt;
#pragma unroll
        for (int o = 1; o < 16; o <<= 1) { const int t = __shfl_up(inc, o); if (F.lane >= o) inc += t; }
        if (F.lane < 16) { tb[F.lane] = inc - nt; tb[32 + F.lane] = c; }
        if (F.lane == 15) tb[16] = inc;
    }
    LDS_WAIT();
    __syncthreads();
    return tb[16];
}
DI void m1_gateup(const Args& a, const Frame& F, int li) {
    const int NT = moe_tile_table(a, F, li);
    LAS int* tb = (LAS int*)(F.lds + TB_OFF); LAS unsigned* tab = (LAS unsigned*)(F.lds + TAB_OFF);
    pg8::MoeSched<true, 8> S; S.A = (const char*)(a.ws + WS_H); S.Bt = (const char*)(a.ws + WS_WGU); S.tb = tb; S.tab = tab; S.NT = NT; S.G = F.G; S.c = F.bid; S.Kb = 1024; S.estride = (size_t)2048 * 1024;
    LAS float* tabs = (LAS float*)(F.lds + TABS_OFF); const float* SA = (const float*)(a.ws + WS_SCL + SCL_SA);
    const int* lists = (const int*)(a.ws + WS_TOK + MiB);
    pg8::Unit u;
    for (int i = 0; i < 8 && S.next(i, u); ++i) {
        if (F.tid < 256) { const int cnt = tb[32 + u.e], idx = (u.pm - tb[u.e]) * 256 + F.tid; const int tokr = lists[(size_t)u.e * MROWS + (idx < cnt ? idx : 0)]; tab[i * 256 + F.tid] = (unsigned)tokr * 1024u; tabs[i * 256 + F.tid] = SA[tokr]; }
    }
    LDS_WAIT();
    __syncthreads();
    pg8::EpiSwiGLUS E{(bf16_t*)(a.ws + WS_HID), tabs, (const float*)(a.ws + WS_SCL + SCL_GU)};
    pg8::gemm_phase<pg8::EpiSwiGLUS, pg8::MoeSched<true, 8>, true>(F.lds, 1024, S, E);
}
DI void m2_down(const Args& a, const Frame& F, int li) {
    const int NT = moe_tile_table(a, F, li);
    LAS int* tb = (LAS int*)(F.lds + TB_OFF);
    pg8::MoeSched<false, 4> S; S.A = (const char*)(a.ws + WS_HID); S.Bt = (const char*)(a.ws + WS_WD); S.tb = tb; S.tab = nullptr; S.NT = NT; S.G = F.G; S.c = F.bid; S.Kb = 2048; S.estride = (size_t)1024 * 1024 * 2;
    pg8::EpiBf16 E{(bf16_t*)(a.ws + WS_YEXP), 1024, 0, 0};
    pg8::gemm_phase<pg8::EpiBf16, pg8::MoeSched<false, 4>>(F.lds, 2048, S, E);
}
DI void m3_combine(const Args& a, const Frame& F, int li) {
    (void)moe_tile_table(a, F, li);
    const LAS int* tb = (const LAS int*)(F.lds + TB_OFF);
    float* X = (float*)(a.ws + WS_X); signed char* H = (signed char*)(a.ws + WS_H); float* SA = (float*)(a.ws + WS_SCL + SCL_SA); const bf16_t* Y = (const bf16_t*)(a.ws + WS_YEXP);
    const unsigned* tok = (const unsigned*)(a.ws + WS_TOK);
    const float* lg = a.in[I_LNG] + (size_t)(li * 2 + 1) * D; const float* lb = a.in[I_LNB] + (size_t)(li * 2 + 1) * D;
    for (int row = F.gw; row < MROWS; row += F.NGW) {
        const u32x4 t0 = *(const u32x4*)(tok + (size_t)row * 8); const float w1 = __uint_as_float(tok[(size_t)row * 8 + 4]), w2 = __uint_as_float(tok[(size_t)row * 8 + 5]);
        const int e1 = __builtin_amdgcn_readfirstlane((int)t0.x), e2 = __builtin_amdgcn_readfirstlane((int)t0.z);
        const size_t s1 = (size_t)tb[e1] * 256 + t0.y, s2 = (size_t)tb[e2] * 256 + t0.w;
        const float* mr = mod_row(a, li, row);
        f32x4 v[4];
#pragma unroll
        for (int j = 0; j < 4; ++j) { const int c = 4 * F.lane + 256 * j;
            const u32x2 y1 = *(const u32x2*)(Y + s1 * 1024 + c), y2 = *(const u32x2*)(Y + s2 * 1024 + c);
            f32x4 y; y[0] = w1 * bflo(y1.x) + w2 * bflo(y2.x); y[1] = w1 * bfhi(y1.x) + w2 * bfhi(y2.x); y[2] = w1 * bflo(y1.y) + w2 * bflo(y2.y); y[3] = w1 * bfhi(y1.y) + w2 * bfhi(y2.y);
            const f32x4 g2 = *(const f32x4*)(mr + 5120 + c);
            v[j] = *(const f32x4*)(X + (size_t)row * D + c) * DN_ALPHA + g2 * y; }
        ln_row(v, lg, lb, F.lane);
        if (li < DEPTH - 1) {
            const float* mn = mod_row(a, li + 1, row); f32x4 h[4];
#pragma unroll
            for (int j = 0; j < 4; ++j) { const int c = 4 * F.lane + 256 * j; *(f32x4*)(X + (size_t)row * D + c) = v[j]; const f32x4 sh = *(const f32x4*)(mn + c), sc = *(const f32x4*)(mn + 1024 + c); h[j] = v[j] * (sc + 1.0f) + sh; }
            store_h8(H + (size_t)row * D, SA + row, F.lane, h);
        } else {
            const int b = row / LSEQ, p = row % LSEQ;
            if (p >= CN) { float* o = a.out + ((size_t)b * TL + (p - CN)) * D;
#pragma unroll
                for (int j = 0; j < 4; ++j) *(f32x4*)(o + 4 * F.lane + 256 * j) = v[j]; }
        }
    }
}

DI void a1_qkv(const Args& a, const Frame& F, int slot) {
    pg8::DenseSched S; S.init(a.ws + WS_H, a.ws + WS_WATT_IN + (size_t)slot * 3072 * 1024, MROWS, 3072, 1024, F.G, F.bid);
    pg8::EpiBf16S E{(bf16_t*)(a.ws + MX_Q), 1024, 1024, (size_t)MROWS * 1024, (const float*)(a.ws + WS_SCL + SCL_SA), (const float*)(a.ws + WS_SCL + SCL_ATT) + slot * 3072};
    pg8::gemm_phase<pg8::EpiBf16S, pg8::DenseSched, true>(F.lds, 1024, S, E);
}
DI void a1b_rope(const Args& a, const Frame& F) {
    const f32x2* tabl = (const f32x2*)(a.ws + WS_PAR + PAR_ROPE);
    const int quarter = F.lane & 3, colb = (F.lane >> 2) * 64 + quarter * 16;
    for (int it = F.gw; it < 2 * NB * TL; it += F.NGW) {
        const int which = it & 1, lr = it >> 1, b = lr / TL, t = lr % TL;
        bf16_t* p = (bf16_t*)(a.ws + (which ? MX_K : MX_Q)) + ((size_t)b * LSEQ + CN + t) * 1024 + colb;
        const int pos = (quarter < 2) ? (t >> 6) : (t & 63);
        u32x4 w0 = *(const u32x4*)p, w1 = *(const u32x4*)(p + 8);
        unsigned wi[8] = {w0.x, w0.y, w0.z, w0.w, w1.x, w1.y, w1.z, w1.w}; unsigned wo[8];
#pragma unroll
        for (int q = 0; q < 8; ++q) {
            const float m0 = bflo(wi[q]), m1 = bfhi(wi[q]);
            const float o0 = __shfl_xor(m0, 1), o1 = __shfl_xor(m1, 1);
            const f32x2 cs0 = tabl[pos * 16 + 2 * q], cs1 = tabl[pos * 16 + 2 * q + 1];
            const float sg = (quarter & 1) ? 1.0f : -1.0f;
            wo[q] = pk2(m0 * cs0.x + sg * o0 * cs0.y, m1 * cs1.x + sg * o1 * cs1.y);
        }
        *(u32x4*)p = (u32x4){wo[0], wo[1], wo[2], wo[3]}; *(u32x4*)(p + 8) = (u32x4){wo[4], wo[5], wo[6], wo[7]};
    }
}
DI void a2_attention(const Args& a, const Frame& F, int li, int slot) {
    const float lam_init = (li == 0) ? 0.2f : 0.55605820415562f;
    const float* lm = a.in[I_ALAM] + (size_t)slot * 4 * 64;
    const float s0 = wave_sum(lm[F.lane] * lm[64 + F.lane]), s1 = wave_sum(lm[128 + F.lane] * lm[192 + F.lane]);
    const float lamf = expf(s0) - expf(s1) + lam_init;
    const bf16_t* Q = (const bf16_t*)(a.ws + MX_Q); const bf16_t* K = (const bf16_t*)(a.ws + MX_K); const bf16_t* V = (const bf16_t*)(a.ws + MX_V); bf16_t* AO = (bf16_t*)(a.ws + MX_AO);
    const float* subg = a.in[I_ASUB] + (size_t)slot * 128;
    const int v = (F.G % 8 == 0) ? (F.bid % 8) * (F.G / 8) + F.bid / 8 : F.bid;
    for (int u = v; u < 1024 + 128; u += F.G) {
        int b, h, row0, seq;
        if (u < 1024) { const int bh = u >> 4, qb = u & 15; b = bh >> 3; h = bh & 7; row0 = b * LSEQ + CN + qb * 128; seq = LSEQ; }
        else { const int w = u - 1024, bh = w >> 1, qb = w & 1; b = bh >> 3; h = bh & 7; row0 = b * LSEQ + qb * 128; seq = CN; }
        att::attn_unit(Q + (size_t)row0 * 1024, K + (size_t)b * LSEQ * 1024, V + (size_t)b * LSEQ * 1024, AO + (size_t)row0 * 1024, h, seq, lamf, 1.0f - lam_init, subg, (LAS char*)F.lds);
    }
}
DI void a3_wout(const Args& a, const Frame& F, int li, int slot) {
    pg8::DenseSched S; S.init(a.ws + MX_AO, a.ws + WS_WATT_OUT + (size_t)slot * 1024 * 1024 * 2, MROWS, 1024, 2048, F.G, F.bid);
    pg8::EpiResid E{(float*)(a.ws + WS_X), (const float*)(a.ws + WS_MOD) + (size_t)li * 9 * 6144 + 2048};
    pg8::gemm_phase<pg8::EpiResid, pg8::DenseSched>(F.lds, 2048, S, E);
}

DI void s1_win(const Args& a, const Frame& F) {
    pg8::DenseSched S; S.init(a.ws + WS_H, a.ws + WS_WS5_IN, MROWS, 1024, 1024, F.G, F.bid);
    pg8::EpiBf16S E{(bf16_t*)(a.ws + MX_U), 1024, 0, 0, (const float*)(a.ws + WS_SCL + SCL_SA), (const float*)(a.ws + WS_SCL + SCL_S5)};
    pg8::gemm_phase<pg8::EpiBf16S, pg8::DenseSched, true>(F.lds, 1024, S, E);
}
template <int MODE> DI void s5_mm(const Args& a, const Frame& F) {
    constexpr int KS = MODE == 1 ? 32 : 48, NCB = MODE == 1 ? 1 : 2, NCBT = 8 * NCB, LDA = KS * 16 + 8;
    LAS bf16_t* At = (LAS bf16_t*)F.lds;
    const bf16_t* Ub = (const bf16_t*)(a.ws + MX_U); const bf16_t* Hin = (const bf16_t*)(a.ws + MX_HIN);
    const bf16_t* Wf = (const bf16_t*)(a.ws + (MODE == 1 ? WS_S5W1 : WS_S5W2));
    const int r32 = F.lane & 31, hh = F.lane >> 5;
    const int v = (F.G % 8 == 0) ? (F.bid % 8) * (F.G / 8) + F.bid / 8 : F.bid;
    for (int u = v; u < 576; u += F.G) {
        const int g = u / 9, rt = u % 9;
        for (int idx = F.tid; idx < 4096; idx += 512) { const int i = idx >> 6, rem = idx & 63, t = rem >> 1, nh = rem & 1, r = rt * 64 + i, b = r / 72, c = r % 72;
            const u32x4 w = *(const u32x4*)(Ub + ((size_t)(b * LSEQ + c * 32 + t) * 1024 + g * 16 + nh * 8)); *(LAS u32x4*)(At + i * LDA + t * 16 + nh * 8) = w; }
        if (MODE == 2) {
            for (int idx = F.tid; idx < 2048; idx += 512) { const int i = idx >> 5, q = idx & 31, r = rt * 64 + i;
                const u32x4 w = *(const u32x4*)(Hin + ((size_t)r * 64 + g) * 256 + q * 8); *(LAS u32x4*)(At + i * LDA + 512 + q * 8) = w; }
        }
        LDS_WAIT();
        __syncthreads();
        f32x16 acc[2][NCB];
#pragma unroll
        for (int rb = 0; rb < 2; ++rb)
#pragma unroll
            for (int cb = 0; cb < NCB; ++cb) acc[rb][cb] = f32x16{};
        const bf16_t* wb = Wf + ((size_t)(g * NCBT + F.wave * NCB) * KS) * 512 + F.lane * 8;
        bf16x8 bq[4][NCB], bn[4][NCB];
#pragma unroll
        for (int q = 0; q < 4; ++q)
#pragma unroll
            for (int cb = 0; cb < NCB; ++cb) bq[q][cb] = *(const bf16x8*)(wb + ((size_t)cb * KS + q) * 512);
        for (int k0 = 0; k0 < KS; k0 += 4) {
            if (k0 + 4 < KS) {
#pragma unroll
                for (int q = 0; q < 4; ++q)
#pragma unroll
                    for (int cb = 0; cb < NCB; ++cb) bn[q][cb] = *(const bf16x8*)(wb + ((size_t)cb * KS + k0 + 4 + q) * 512);
            }
#pragma unroll
            for (int q = 0; q < 4; ++q) {
                const bf16x8 a0 = *(const LAS bf16x8*)(At + r32 * LDA + (k0 + q) * 16 + 8 * hh), a1 = *(const LAS bf16x8*)(At + (32 + r32) * LDA + (k0 + q) * 16 + 8 * hh);
#pragma unroll
                for (int cb = 0; cb < NCB; ++cb) { acc[0][cb] = __builtin_amdgcn_mfma_f32_32x32x16_bf16(a0, bq[q][cb], acc[0][cb], 0, 0, 0); acc[1][cb] = __builtin_amdgcn_mfma_f32_32x32x16_bf16(a1, bq[q][cb], acc[1][cb], 0, 0, 0); }
            }
#pragma unroll
            for (int q = 0; q < 4; ++q)
#pragma unroll
                for (int cb = 0; cb < NCB; ++cb) bq[q][cb] = bn[q][cb];
        }
#pragma unroll
        for (int rb = 0; rb < 2; ++rb)
#pragma unroll
            for (int reg = 0; reg < 16; ++reg) {
                const int r = rt * 64 + rb * 32 + att::crow(reg, hh);
                if (MODE == 1) { float* E = (float*)(a.ws + MX_E); E[((size_t)r * 64 + g) * 256 + F.wave * 32 + r32] = acc[rb][0][reg]; }
                else { const int b = r / 72, c = r % 72; bf16_t* Gb = (bf16_t*)(a.ws + MX_G);
#pragma unroll
                    for (int cb = 0; cb < NCB; ++cb) { const int col = (F.wave * NCB + cb) * 32 + r32, to = col >> 4, no = col & 15;
                        Gb[(size_t)(b * LSEQ + c * 32 + to) * 1024 + g * 16 + no] = (bf16_t)f2bf(gelu_tanh(acc[rb][cb][reg])); } }
            }
        __syncthreads();
    }
}
DI void s5_carry(const Args& a, const Frame& F) {
    const int gt = F.bid * 512 + F.tid; if (gt >= 65536) return;
    const int p = gt & 63, dir = (gt >> 6) & 1, g = (gt >> 7) & 63, b = gt >> 13;
    const f32x2 z32 = ((const f32x2*)(a.ws + WS_S5ZP))[((dir * 64 + g) * 64 + p) * 33 + 32];
    const float* E = (const float*)(a.ws + MX_E); bf16_t* Hin = (bf16_t*)(a.ws + MX_HIN);
    float hr = 0.f, hi = 0.f;
#define S5_CH(s) (dir ? ((s) < 8 ? 7 - (s) : 79 - (s)) : (s))
    for (int s0 = 0; s0 < 72; s0 += 8) {
        float er[8], ei[8];
#pragma unroll
        for (int q = 0; q < 8; ++q) { const size_t idx = ((size_t)(b * 72 + S5_CH(s0 + q)) * 64 + g) * 256 + dir * 128 + p; er[q] = E[idx]; ei[q] = E[idx + 64]; }
#pragma unroll
        for (int q = 0; q < 8; ++q) { const size_t idx = ((size_t)(b * 72 + S5_CH(s0 + q)) * 64 + g) * 256 + dir * 128 + p;
            Hin[idx] = (bf16_t)f2bf(hr); Hin[idx + 64] = (bf16_t)f2bf(hi);
            const float nr = z32.x * hr - z32.y * hi + er[q], ni = z32.x * hi + z32.y * hr + ei[q]; hr = nr; hi = ni; }
    }
#undef S5_CH
}
DI void s3_glu(const Args& a, const Frame& F, int li) {
    pg8::DenseSched S; S.init(a.ws + MX_G, a.ws + WS_WS5_GLU, MROWS, 2048, 2048, F.G, F.bid);
    pg8::EpiGluResid E{(float*)(a.ws + WS_X), (const float*)(a.ws + WS_MOD) + (size_t)li * 9 * 6144 + 2048};
    pg8::gemm_phase<pg8::EpiGluResid, pg8::DenseSched>(F.lds, 2048, S, E);
}

DI void l1_win(const Args& a, const Frame& F) {
    pg8::DenseSched S; S.init(a.ws + WS_H, a.ws + WS_WLRU_IN, MROWS, 2816, 1024, F.G, F.bid);
    pg8::EpiBf16S E{(bf16_t*)(a.ws + MX_UG), 2816, 0, 0, (const float*)(a.ws + WS_SCL + SCL_SA), (const float*)(a.ws + WS_SCL + SCL_LRU)};
    pg8::gemm_phase<pg8::EpiBf16S, pg8::DenseSched, true>(F.lds, 1024, S, E);
}
template <int PASS> DI void lru_tiles(const Args& a, const Frame& F) {
    const int half = F.wave >> 2, wq = F.wave & 3, dir = wq >> 1, nbh = wq & 1, ht = F.tid & 255;
    LAS unsigned char* ub = F.lds + half * 58368;
    LAS bf16_t* XB = (LAS bf16_t*)ub;
    LAS float* HS = (LAS float*)(ub + 13312);
    LAS bf16_t* RAW = (LAS bf16_t*)(ub + 13312);
    const bf16_t* Ug = (const bf16_t*)(a.ws + MX_UG); const bf16_t* BD = (const bf16_t*)(a.ws + WS_BD);
    const float* SP = (const float*)(a.ws + WS_PAR + PAR_SP);
    f32x2* SUMM = (f32x2*)(a.ws + MX_SUMM); const float* CARRY = (const float*)(a.ws + MX_CARRY); bf16_t* A2 = (bf16_t*)(a.ws + MX_A2);
    const int fr = F.lane & 15, fq = F.lane >> 4;
    const int src1 = dir ? F.lane + 16 : F.lane - 16, src2 = dir ? F.lane + 32 : F.lane - 32, lastl = dir ? fr : fr + 48;
    const bool val1 = dir ? (fq <= 2) : (fq >= 1), val2 = dir ? (fq <= 1) : (fq >= 2);
    const int slot = F.bid * 2 + half, n = slot & 15, rc0 = slot >> 4, nslots16 = (F.G * 2) >> 4;
#define LRU_LOADW(dst, nbi_) do { _Pragma("unroll") for (int mat = 0; mat < 2; ++mat) _Pragma("unroll") for (int ks = 0; ks < 3; ++ks) \
        dst[mat][ks] = *(const bf16x8*)(BD + ((size_t)((dir * 2 + mat) * 16 + n) * 96 + (nbh * 3 + (nbi_)) * 16 + fr) * 96 + ks * 32 + fq * 8); } while (0)
    u32x4 rawv[3], gwv[3];
#define LRU_LOAD_RAW(rc_) do { const int b_ = (rc_) / 36, c_ = (rc_) % 36, p0_ = c_ * 64, lo_ = (c_ < 4) ? 0 : CN, hi_ = (c_ < 4) ? CN : LSEQ; \
        _Pragma("unroll") for (int it = 0; it < 3; ++it) { const int pi = ht + 256 * it; rawv[it] = (u32x4){0u, 0u, 0u, 0u}; \
            if (pi < 737) { const int j = pi / 11, cg = pi % 11, q = p0_ - 1 + j; if (q >= lo_ && q < hi_) rawv[it] = *(const u32x4*)(Ug + ((size_t)b_ * LSEQ + q) * 2816 + LRUW + n * 88 + cg * 8); } } } while (0)
#define LRU_LOAD_GATE(rc_) do { const int b_ = (rc_) / 36, c_ = (rc_) % 36, p0_ = c_ * 64; \
        _Pragma("unroll") for (int it = 0; it < 3; ++it) { const int gi = ht + 256 * it; gwv[it] = (u32x4){0u, 0u, 0u, 0u}; \
            if (gi < 704) { const int row = gi / 11, cg = gi % 11; gwv[it] = *(const u32x4*)(Ug + ((size_t)b_ * LSEQ + p0_ + row) * 2816 + n * 88 + cg * 8); } } } while (0)
    if (rc0 < 288) LRU_LOAD_RAW(rc0);
    for (int rc = rc0; rc < 288; rc += nslots16) {
        const int b = rc / 36, c = rc % 36, p0 = c * 64;
        const size_t rowbase = (size_t)b * LSEQ + p0;
        bf16x8 wcur[2][3], wnxt[2][3];
        LRU_LOADW(wcur, 0);
#pragma unroll
        for (int it = 0; it < 3; ++it) { const int pi = ht + 256 * it; if (pi < 737) { const int j = pi / 11, cg = pi % 11; *(LAS u32x4*)(RAW + j * 88 + cg * 8) = rawv[it]; } }
        LDS_WAIT();
        __syncthreads();
        if (rc + nslots16 < 288) LRU_LOAD_RAW(rc + nslots16);
#pragma unroll
        for (int it = 0; it < 3; ++it) { const int gi = ht + 256 * it;
            if (gi < 704) { const int row = gi / 11, cg = gi % 11, c0 = n * 88 + cg * 8;
                float acc[8]; { const f32x4 b0 = *(const f32x4*)(a.in[I_LCB] + c0), b1 = *(const f32x4*)(a.in[I_LCB] + c0 + 4); acc[0] = b0[0]; acc[1] = b0[1]; acc[2] = b0[2]; acc[3] = b0[3]; acc[4] = b1[0]; acc[5] = b1[1]; acc[6] = b1[2]; acc[7] = b1[3]; }
#pragma unroll
                for (int k = 0; k < 4; ++k) { const u32x4 rw = *(const LAS u32x4*)(RAW + (row + k) * 88 + cg * 8); const f32x4 w0 = *(const f32x4*)(a.in[I_LCW] + k * LRUW + c0), w1 = *(const f32x4*)(a.in[I_LCW] + k * LRUW + c0 + 4);
                    acc[0] += w0[0] * bflo(rw.x); acc[1] += w0[1] * bfhi(rw.x); acc[2] += w0[2] * bflo(rw.y); acc[3] += w0[3] * bfhi(rw.y);
                    acc[4] += w1[0] * bflo(rw.z); acc[5] += w1[1] * bfhi(rw.z); acc[6] += w1[2] * bflo(rw.w); acc[7] += w1[3] * bfhi(rw.w); }
                u32x4 o; o.x = pk2(acc[0], acc[1]); o.y = pk2(acc[2], acc[3]); o.z = pk2(acc[4], acc[5]); o.w = pk2(acc[6], acc[7]);
                *(LAS u32x4*)(XB + row * 104 + cg * 8) = o; } }
        if (ht < 64) *(LAS u32x4*)(XB + ht * 104 + 88) = (u32x4){0u, 0u, 0u, 0u};
        LDS_WAIT();
        __syncthreads();
#pragma unroll
        for (int nbi = 0; nbi < 3; ++nbi) {
            if (nbi < 2) LRU_LOADW(wnxt, nbi + 1);
            const int e = (nbh * 3 + nbi) * 16 + fr, ecl = e < 88 ? e : 87, cch = n * 88 + ecl;
            const float ba = a.in[I_LBA][dir * LRUW + cch], bx = a.in[I_LBX][dir * LRUW + cch], sp = SP[dir * LRUW + cch];
            float Hc = 0.f, Pt = 1.f;
            if (PASS == 2) Hc = CARRY[((size_t)(dir * 8 + b) * 36 + c) * LRUW + cch];
#pragma unroll 1
            for (int mi = 0; mi < 4; ++mi) {
                const int mb = dir ? 3 - mi : mi;
                f32x4 acc0 = {0.f, 0.f, 0.f, 0.f}, acc1 = {0.f, 0.f, 0.f, 0.f};
#pragma unroll
                for (int ks = 0; ks < 3; ++ks) { const bf16x8 af = *(const LAS bf16x8*)(XB + (mb * 16 + fr) * 104 + ks * 32 + fq * 8);
                    acc0 = __builtin_amdgcn_mfma_f32_16x16x32_bf16(af, wcur[0][ks], acc0, 0, 0, 0); acc1 = __builtin_amdgcn_mfma_f32_16x16x32_bf16(af, wcur[1][ks], acc1, 0, 0, 0); }
                float av[4], bt[4];
#pragma unroll
                for (int j = 0; j < 4; ++j) { const float xs = bf2f(XB[(mb * 16 + fq * 4 + j) * 104 + ecl]);
                    const float r = __builtin_amdgcn_rcpf(1.0f + __expf(-(acc0[j] + ba))), ig = __builtin_amdgcn_rcpf(1.0f + __expf(-(acc1[j] + bx)));
                    const float la = -8.0f * r * sp; av[j] = __expf(la); bt[j] = __builtin_amdgcn_sqrtf(fmaxf(1.0f - av[j] * av[j], 0.f)) * ig * xs; }
                float Pl = 1.f, hl = 0.f;
#pragma unroll
                for (int jj = 0; jj < 4; ++jj) { const int j = dir ? 3 - jj : jj; hl = fmaf(av[j], hl, bt[j]); Pl *= av[j]; }
                float Pn = __shfl(Pl, src1), hn = __shfl(hl, src1);
                float Pi = val1 ? Pn * Pl : Pl, hi = val1 ? fmaf(Pl, hn, hl) : hl;
                Pn = __shfl(Pi, src2); hn = __shfl(hi, src2);
                const float Pi2 = val2 ? Pn * Pi : Pi, hi2 = val2 ? fmaf(Pi, hn, hi) : hi;
                const float Pex = __shfl(Pi2, src1), hex = __shfl(hi2, src1);
                const float Pe = val1 ? Pex : 1.f, he = val1 ? hex : 0.f;
                const float Ptot = __shfl(Pi2, lastl), htot = __shfl(hi2, lastl);
                if (PASS == 2) {
                    float h = fmaf(Pe, Hc, he);
#pragma unroll
                    for (int jj = 0; jj < 4; ++jj) { const int j = dir ? 3 - jj : jj; h = fmaf(av[j], h, bt[j]); if (e < 88) HS[(dir * 64 + mb * 16 + fq * 4 + j) * 88 + e] = h; }
                }
                Hc = fmaf(Ptot, Hc, htot); Pt *= Ptot;
            }
            if (PASS == 1) { if (fq == 0 && e < 88) SUMM[((size_t)(dir * 8 + b) * 36 + c) * LRUW + n * 88 + e] = (f32x2){Pt, Hc}; }
            if (nbi < 2) {
#pragma unroll
                for (int mat = 0; mat < 2; ++mat)
#pragma unroll
                    for (int ks = 0; ks < 3; ++ks) wcur[mat][ks] = wnxt[mat][ks];
            }
        }
        if (PASS == 2) {
            LRU_LOAD_GATE(rc);
            LDS_WAIT();
            __syncthreads();
#pragma unroll
            for (int it = 0; it < 3; ++it) { const int gi = ht + 256 * it;
                if (gi < 704) { const int row = gi / 11, cg = gi % 11;
                    const f32x4 f0 = *(const LAS f32x4*)(HS + row * 88 + cg * 8), f1 = *(const LAS f32x4*)(HS + row * 88 + cg * 8 + 4), g0 = *(const LAS f32x4*)(HS + (64 + row) * 88 + cg * 8), g1 = *(const LAS f32x4*)(HS + (64 + row) * 88 + cg * 8 + 4);
                    const u32x4 gw = gwv[it]; u32x4 o;
                    o.x = pk2((f0[0] + g0[0]) * gelu_tanh(bflo(gw.x)), (f0[1] + g0[1]) * gelu_tanh(bfhi(gw.x))); o.y = pk2((f0[2] + g0[2]) * gelu_tanh(bflo(gw.y)), (f0[3] + g0[3]) * gelu_tanh(bfhi(gw.y)));
                    o.z = pk2((f1[0] + g1[0]) * gelu_tanh(bflo(gw.z)), (f1[1] + g1[1]) * gelu_tanh(bfhi(gw.z))); o.w = pk2((f1[2] + g1[2]) * gelu_tanh(bflo(gw.w)), (f1[3] + g1[3]) * gelu_tanh(bfhi(gw.w)));
                    *(u32x4*)(A2 + (rowbase + row) * LRUW + n * 88 + cg * 8) = o; } }
        }
        LDS_WAIT();
        __syncthreads();
    }
#undef LRU_LOAD_RAW
#undef LRU_LOAD_GATE
#undef LRU_LOADW
}
DI void l3_carry(const Args& a, const Frame& F) {
    const f32x2* SUMM = (const f32x2*)(a.ws + MX_SUMM); float* CARRY = (float*)(a.ws + MX_CARRY);
    const int gt = F.bid * 512 + F.tid;
    if (gt < 2 * NB * LRUW) {
        const int dir = gt / (NB * LRUW), b = (gt / LRUW) % NB, ch = gt % LRUW; float h = 0.f;
        for (int s = 0; s < 36; ++s) { const int c = dir ? (s < 4 ? 3 - s : 39 - s) : s; const size_t idx = ((size_t)(dir * 8 + b) * 36 + c) * LRUW + ch;
            CARRY[idx] = h; const f32x2 ph = SUMM[idx]; h = fmaf(ph.x, h, ph.y); }
    }
}
DI void l5_wout(const Args& a, const Frame& F, int li) {
    pg8::DenseSched S; S.init(a.ws + MX_A2, a.ws + WS_WLRU_OUT, MROWS, 1024, LRUW * 2, F.G, F.bid);
    pg8::EpiResid E{(float*)(a.ws + WS_X), (const float*)(a.ws + WS_MOD) + (size_t)li * 9 * 6144 + 2048};
    pg8::gemm_phase<pg8::EpiResid, pg8::DenseSched>(F.lds, LRUW * 2, S, E);
}

constexpr int NPHASE = 37;
__global__ void __launch_bounds__(NWAVES * 64, 2) fwd_kernel(Args args) {
    extern __shared__ __attribute__((aligned(16))) unsigned char lds_raw[];
    Frame F;
    F.lds = (LAS unsigned char*)lds_raw;
    F.tid = threadIdx.x; F.lane = F.tid & 63; F.wave = __builtin_amdgcn_readfirstlane(F.tid >> 6);
    F.G = gridDim.x; F.bid = blockIdx.x; F.gw = F.bid * NWAVES + F.wave; F.NGW = F.G * NWAVES;
    volatile LAS unsigned* MISC = (volatile LAS unsigned*)(F.lds + MISC_OFF);
    for (int u = F.tid; u < (LDS_BYTES - MISC_OFF) / 4; u += NWAVES * 64) ((LAS unsigned*)(F.lds + MISC_OFF))[u] = 0u;
    __syncthreads();
    XcdBarrier bar = xcd_barrier_post((unsigned*)(args.ws + WS_CTL) + CW_BAR, MISC + 8);
    const int lo = args.ph_lo, hi = args.ph_hi;
#define IN(k) (lo <= (k) && (k) < hi)
#define NREP(k) ((((PROBE_MASK) >> (k)) & 1ull) ? (args.ph_hi >= NPHASE ? 2 : 1) : 1)
#define SEAM(k) do { if (IN(k) && IN((k) + 1)) xcd_barrier(bar); } while (0)
    if (IN(0)) { for (int rep = 0; rep < NREP(0); ++rep) p0_prologue(args, F); }   SEAM(0);
    if (IN(1)) { for (int rep = 0; rep < NREP(1); ++rep) { p0b_modreduce(args, F); s5_tables_a(args, F); } } SEAM(1);
    if (IN(2)) { for (int rep = 0; rep < NREP(2); ++rep) { p1_init(args, F); s5_tables_b(args, F); } }       SEAM(2);
    if (IN(3)) { for (int rep = 0; rep < NREP(3); ++rep) a1_qkv(args, F, 0); }          SEAM(3);
    if (IN(4)) { for (int rep = 0; rep < NREP(4); ++rep) a1b_rope(args, F); }           SEAM(4);
    if (IN(5)) { for (int rep = 0; rep < NREP(5); ++rep) a2_attention(args, F, 0, 0); } SEAM(5);
    if (IN(6)) { for (int rep = 0; rep < NREP(6); ++rep) a3_wout(args, F, 0, 0); }      SEAM(6);
    if (IN(7)) { for (int rep = 0; rep < NREP(7); ++rep) m0_route(args, F, 0); }        SEAM(7);
    if (IN(8)) { for (int rep = 0; rep < NREP(8); ++rep) m1_gateup(args, F, 0); }       SEAM(8);
    if (IN(9)) { for (int rep = 0; rep < NREP(9); ++rep) m2_down(args, F, 0); }         SEAM(9);
    if (IN(10)) { for (int rep = 0; rep < NREP(10); ++rep) m3_combine(args, F, 0); }     SEAM(10);
    if (IN(11)) { for (int rep = 0; rep < NREP(11); ++rep) s1_win(args, F); }            SEAM(11);
    if (IN(12)) { for (int rep = 0; rep < NREP(12); ++rep) s5_mm<1>(args, F); }           SEAM(12);
    if (IN(13)) { for (int rep = 0; rep < NREP(13); ++rep) s5_carry(args, F); }          SEAM(13);
    if (IN(14)) { for (int rep = 0; rep < NREP(14); ++rep) s5_mm<2>(args, F); }         SEAM(14);
    if (IN(15)) { for (int rep = 0; rep < NREP(15); ++rep) s3_glu(args, F, 1); }         SEAM(15);
    if (IN(16)) { for (int rep = 0; rep < NREP(16); ++rep) m0_route(args, F, 1); }       SEAM(16);
    if (IN(17)) { for (int rep = 0; rep < NREP(17); ++rep) m1_gateup(args, F, 1); }      SEAM(17);
    if (IN(18)) { for (int rep = 0; rep < NREP(18); ++rep) m2_down(args, F, 1); }        SEAM(18);
    if (IN(19)) { for (int rep = 0; rep < NREP(19); ++rep) m3_combine(args, F, 1); }     SEAM(19);
    if (IN(20)) { for (int rep = 0; rep < NREP(20); ++rep) l1_win(args, F); }            SEAM(20);
    if (IN(21)) { for (int rep = 0; rep < NREP(21); ++rep) lru_tiles<1>(args, F); }      SEAM(21);
    if (IN(22)) { for (int rep = 0; rep < NREP(22); ++rep) l3_carry(args, F); }          SEAM(22);
    if (IN(23)) { for (int rep = 0; rep < NREP(23); ++rep) lru_tiles<2>(args, F); }      SEAM(23);
    if (IN(24)) { for (int rep = 0; rep < NREP(24); ++rep) l5_wout(args, F, 2); }        SEAM(24);
    if (IN(25)) { for (int rep = 0; rep < NREP(25); ++rep) m0_route(args, F, 2); }       SEAM(25);
    if (IN(26)) { for (int rep = 0; rep < NREP(26); ++rep) m1_gateup(args, F, 2); }      SEAM(26);
    if (IN(27)) { for (int rep = 0; rep < NREP(27); ++rep) m2_down(args, F, 2); }        SEAM(27);
    if (IN(28)) { for (int rep = 0; rep < NREP(28); ++rep) m3_combine(args, F, 2); }     SEAM(28);
    if (IN(29)) { for (int rep = 0; rep < NREP(29); ++rep) a1_qkv(args, F, 1); }         SEAM(29);
    if (IN(30)) { for (int rep = 0; rep < NREP(30); ++rep) a1b_rope(args, F); }          SEAM(30);
    if (IN(31)) { for (int rep = 0; rep < NREP(31); ++rep) a2_attention(args, F, 3, 1); } SEAM(31);
    if (IN(32)) { for (int rep = 0; rep < NREP(32); ++rep) a3_wout(args, F, 3, 1); }     SEAM(32);
    if (IN(33)) { for (int rep = 0; rep < NREP(33); ++rep) m0_route(args, F, 3); }       SEAM(33);
    if (IN(34)) { for (int rep = 0; rep < NREP(34); ++rep) m1_gateup(args, F, 3); }      SEAM(34);
    if (IN(35)) { for (int rep = 0; rep < NREP(35); ++rep) m2_down(args, F, 3); }        SEAM(35);
    if (IN(36)) { for (int rep = 0; rep < NREP(36); ++rep) m3_combine(args, F, 3); }
#undef IN
#undef SEAM
}

extern "C" void kernel_launch(void* const* d_in, const int* in_sizes, int n_in, void* d_out, int out_size, void* d_ws, size_t ws_size, hipStream_t stream) {
    static int grid = 0;
    if (grid == 0) {
        if (n_in != 37 || ws_size < WS_END) { fprintf(stderr, "kernel_launch: unexpected n_in %d or ws_size %zu\n", n_in, ws_size); grid = -1; return; }
        if (hipFuncSetAttribute((const void*)fwd_kernel, hipFuncAttributeMaxDynamicSharedMemorySize, LDS_BYTES) != hipSuccess) { fprintf(stderr, "kernel_launch: hipFuncSetAttribute failed\n"); grid = -1; return; }
        int per_cu = 0;
        if (hipOccupancyMaxActiveBlocksPerMultiprocessor(&per_cu, (const void*)fwd_kernel, NWAVES * 64, LDS_BYTES) != hipSuccess || per_cu < 1) fprintf(stderr, "kernel_launch: occupancy query says %d\n", per_cu);
        (void)hipGetLastError();
        grid = 256;
    }
    if (grid < 0) return;
    (void)hipMemsetAsync((char*)d_ws + WS_CTL, 0, CTL_ZERO_BYTES, stream);
    Args a{};
    for (int i = 0; i < 37; ++i) a.in[i] = (const float*)d_in[i];
    a.out = (float*)d_out; a.ws = (unsigned char*)d_ws;
#if MK_N_LAUNCHES == 1
    a.ph_lo = 0; a.ph_hi = NPHASE;
    hipLaunchKernelGGL(fwd_kernel, dim3(grid), dim3(NWAVES * 64), LDS_BYTES, stream, a);
#else
    for (int p = 0; p < NPHASE; ++p) { a.ph_lo = p; a.ph_hi = p + 1; hipLaunchKernelGGL(fwd_kernel, dim3(grid), dim3(NWAVES * 64), LDS_BYTES, stream, a); }
#endif
    (void)in_sizes; (void)out_size;
}
```

```cpp
#include <hip/hip_runtime.h>
#include <cstdio>
#include <cstdint>

#ifndef PROBE_MASK
#define PROBE_MASK 0ull
#endif
#ifndef MK_N_LAUNCHES
#define MK_N_LAUNCHES 1
#endif

#define LAS __attribute__((address_space(3)))
#define GAS __attribute__((address_space(1)))
typedef unsigned short bf16_t;
typedef short bf16x8 __attribute__((ext_vector_type(8)));
typedef short s16x4 __attribute__((ext_vector_type(4)));
typedef float f32x4 __attribute__((ext_vector_type(4)));
typedef float f32x2 __attribute__((ext_vector_type(2)));
typedef float f32x16 __attribute__((ext_vector_type(16)));
typedef unsigned u32x4 __attribute__((ext_vector_type(4)));
typedef unsigned u32x2 __attribute__((ext_vector_type(2)));
typedef int i32x4 __attribute__((ext_vector_type(4)));
typedef GAS unsigned gu32;
#define RLX_AGENT __ATOMIC_RELAXED, __HIP_MEMORY_SCOPE_AGENT
#define LDS_WAIT() asm volatile("s_waitcnt lgkmcnt(0)" ::: "memory")
#define VM_WAIT() asm volatile("s_waitcnt vmcnt(0)" ::: "memory")
#define DI __device__ __forceinline__

constexpr int D = 1024, NB = 8, TL = 2048, CN = 256, LSEQ = TL + CN  , MROWS = NB * LSEQ  , DEPTH = 4;
constexpr int NE = 16, DEXP = 1024, LRUW = 1408, LRUB = 88;
constexpr int S5G = 64, S5P = 64, S5N = 16;
constexpr float LN_EPS = 1e-5f;
constexpr float DN_ALPHA = 1.6817928305074292f;
constexpr int NWAVES = 8;

constexpr size_t MiB = 1u << 20;
constexpr size_t WS_CTL = 0, CTL_ZERO_BYTES = 1 * MiB;
constexpr size_t WS_MODP = 1 * MiB;
constexpr size_t WS_MOD = 16 * MiB;
constexpr size_t WS_PAR = 17 * MiB;
constexpr size_t WS_BD = 19 * MiB;
constexpr size_t WS_WATT_IN = 21 * MiB;
constexpr size_t WS_WATT_OUT = 33 * MiB;
constexpr size_t WS_WS5_IN = 37 * MiB;
constexpr size_t WS_WS5_GLU = 39 * MiB;
constexpr size_t WS_WLRU_IN = 43 * MiB;
constexpr size_t WS_WLRU_OUT = 49 * MiB;
constexpr size_t WS_WGU = 52 * MiB;
constexpr size_t WS_WD = 116 * MiB;
constexpr size_t WS_X = 148 * MiB;
constexpr size_t WS_H = 220 * MiB;
constexpr size_t WS_TOK = 256 * MiB;
constexpr size_t WS_HID = 258 * MiB;
constexpr size_t WS_YEXP = 338 * MiB;
constexpr size_t WS_MIX = 418 * MiB;
constexpr size_t WS_S5W1 = 670 * MiB;
constexpr size_t WS_S5W2 = 686 * MiB;
constexpr size_t WS_S5KT = 734 * MiB;
constexpr size_t WS_S5ZP = 738 * MiB;
constexpr size_t WS_SCL = 742 * MiB;
constexpr size_t SCL_SA = 0, SCL_ATT = 131072, SCL_S5 = 163840, SCL_LRU = 180224, SCL_GU = 262144  ;
constexpr size_t WS_MOEW = 744 * MiB;
constexpr size_t WS_END = 1000 * MiB;
constexpr size_t MX_Q = WS_MIX, MX_K = WS_MIX + 36 * MiB, MX_V = WS_MIX + 72 * MiB, MX_AO = WS_MIX + 108 * MiB;
constexpr size_t MX_U = WS_MIX  , MX_E = WS_MIX + 72 * MiB  , MX_HIN = WS_MIX + 144 * MiB  , MX_G = WS_MIX + 216 * MiB;
constexpr size_t MX_UG = WS_MIX, MX_A2 = WS_MIX + 100 * MiB, MX_SUMM = WS_MIX + 150 * MiB, MX_CARRY = WS_MIX + 158 * MiB;
constexpr size_t PAR_ZR = 0, PAR_ZI = 32768, PAR_BBR = 65536, PAR_BBI = 65536 + 524288, PAR_ROPE = 65536 + 2 * 524288, PAR_SP = PAR_ROPE + 8192;
constexpr int CW_BAR = 4096;
constexpr int CW_CNT = 16384;
constexpr int CW_BG = 32768;
constexpr int CW_DONE = 36864;

constexpr int RING_BYTES = 131072;
constexpr int MISC_OFF = RING_BYTES;
constexpr int TB_OFF = MISC_OFF + 512;
constexpr int TAB_OFF = TB_OFF + 512;
constexpr int TABS_OFF = TAB_OFF + 8192;
constexpr int LDS_BYTES = 155648;
static_assert(TABS_OFF + 8 * 1024 <= LDS_BYTES, "LDS map");

DI unsigned f2bf(float f) { unsigned u = __builtin_bit_cast(unsigned, f); return (u + 0x7fffu + ((u >> 16) & 1u)) >> 16; }
DI unsigned pk2(float lo, float hi) { return f2bf(lo) | (f2bf(hi) << 16); }
DI float bf2f(unsigned short b) { return __builtin_bit_cast(float, ((unsigned)b) << 16); }
DI float bflo(unsigned w) { return __builtin_bit_cast(float, w << 16); }
DI float bfhi(unsigned w) { return __builtin_bit_cast(float, w & 0xffff0000u); }
DI float wave_sum(float v) {
#pragma unroll
    for (int o = 1; o < 64; o <<= 1) v += __shfl_xor(v, o);
    return v;
}
DI float wave_max(float v) {
#pragma unroll
    for (int o = 1; o < 64; o <<= 1) v = fmaxf(v, __shfl_xor(v, o));
    return v;
}
DI float sigmoidf_(float x) { return __builtin_amdgcn_rcpf(1.0f + __expf(-x)); }
DI float gelu_tanh(float x) { const float u = 0.7978845608028654f * (x + 0.044715f * x * x * x); const float e = __expf(2.0f * u); return x - x * __builtin_amdgcn_rcpf(e + 1.0f); }
DI void sincos_cw(float x, float& s, float& c) {
    const float k = rintf(x * 0.6366197723675814f);
    float r = fmaf(k, -1.5707962512969971f, x); r = fmaf(k, -7.5497894158615964e-08f, r); r = fmaf(k, -5.3903029534742384e-15f, r);
    const float r2 = r * r;
    float sp = fmaf(r2, 2.7557313707070068e-6f, -1.9841270114006046e-4f); sp = fmaf(sp, r2, 8.3333337680e-3f); sp = fmaf(sp, r2, -1.6666667163e-1f); sp = fmaf(sp * r2, r, r);
    float cp = fmaf(r2, 2.4801587e-5f, -1.3888889225e-3f); cp = fmaf(cp, r2, 4.1666667908e-2f); cp = fmaf(cp, r2, -0.5f); cp = fmaf(cp, r2, 1.0f);
    const int q = ((int)k) & 3;
    const float ss = (q & 1) ? cp : sp, cc = (q & 1) ? sp : cp;
    s = (q & 2) ? -ss : ss; c = ((q + 1) & 2) ? -cc : cc;
}

#define XB_TMO      128
#define XB_XCNT(j)  (256  + 64 * (j))
#define XB_XSUB(j)  (1280 + 64 * (j))
#define XB_XGEN(j)  (2304 + 64 * (j))
#define XB_TOP      3328
#define XB_TOPGEN   3392
#define XCD_BAR_WORDS 3456
#define XB_SPIN_CAP (1u << 20)
DI unsigned xb_ld(unsigned* p)              { return __hip_atomic_load(p, __ATOMIC_RELAXED, __HIP_MEMORY_SCOPE_AGENT); }
DI unsigned xb_add(unsigned* p, unsigned v) { return __hip_atomic_fetch_add(p, v, __ATOMIC_RELAXED, __HIP_MEMORY_SCOPE_AGENT); }
DI unsigned xb_xcc_id() { return (unsigned)__builtin_amdgcn_s_getreg((3 << 11) | 20) & 0xFu; }
#define XB_SPIN(cond, bar) do { unsigned _sp = 0; while (cond) { __builtin_amdgcn_s_sleep(1); \
    if ((++_sp & 255u) == 0u) { if (xb_ld(&(bar)[XB_TMO])) break; if (_sp > XB_SPIN_CAP) { atomicAdd(&(bar)[XB_TMO], 1u); break; } } } } while (0)
struct XcdBarrier { unsigned* bar; unsigned x; volatile LAS unsigned* st; };
DI XcdBarrier xcd_barrier_post(unsigned* bar, volatile LAS unsigned* st) {
    XcdBarrier b; b.bar = bar; b.x = xb_xcc_id(); b.st = st;
    if (threadIdx.x == 0) (void)xb_add(&bar[XB_XCNT(b.x)], 1u);
    return b;
}
DI void xcd_barrier_complete(unsigned* bar, unsigned x, unsigned& nloc, unsigned& nx) {
    const unsigned G = gridDim.x * gridDim.y * gridDim.z;
    unsigned sum, cnt, mine, sp = 0u;
    for (;;) {
        sum = 0u; cnt = 0u; mine = 0u;
#pragma unroll
        for (unsigned j = 0; j < 16; ++j) { const unsigned c = xb_ld(&bar[XB_XCNT(j)]); sum += c; cnt += (c > 0u) ? 1u : 0u; mine = (j == x) ? c : mine; }
        if (sum == G) break;
        __builtin_amdgcn_s_sleep(1);
        if ((++sp & 255u) == 0u) { if (xb_ld(&bar[XB_TMO])) break; if (sp > XB_SPIN_CAP) { atomicAdd(&bar[XB_TMO], 1u); break; } }
    }
    nloc = mine > 0u ? mine : 1u; nx = cnt > 0u ? cnt : 1u;
}
DI void xcd_barrier(const XcdBarrier& b, const bool leader) {
    asm volatile("s_waitcnt vmcnt(0)" ::: "memory");
    __syncthreads();
    if (leader) {
        unsigned* bar = b.bar;
        __builtin_amdgcn_s_waitcnt(0);
        unsigned nloc = b.st[0], nx = b.st[1];
        if (nloc == 0u) { xcd_barrier_complete(bar, b.x, nloc, nx); b.st[0] = nloc; b.st[1] = nx; }
        const unsigned old = xb_add(&bar[XB_XSUB(b.x)], 1u);
        const unsigned gen = old / nloc;
        if (old + 1u == (gen + 1u) * nloc) {
            __builtin_amdgcn_fence(__ATOMIC_RELEASE, "agent");
            asm volatile("s_waitcnt vmcnt(0)" ::: "memory");
            const unsigned og = xb_add(&bar[XB_TOP], 1u);
            const unsigned tg = og / nx;
            if (og + 1u == (tg + 1u) * nx) xb_add(&bar[XB_TOPGEN], 1u);
            else XB_SPIN(xb_ld(&bar[XB_TOPGEN]) == tg, bar);
            __builtin_amdgcn_fence(__ATOMIC_ACQUIRE, "agent");
            xb_add(&bar[XB_XGEN(b.x)], 1u);
            asm volatile("s_waitcnt vmcnt(0)" ::: "memory");
        } else {
            XB_SPIN(xb_ld(&bar[XB_XGEN(b.x)]) == gen, bar);
            __builtin_amdgcn_fence(__ATOMIC_ACQUIRE, "agent");
            asm volatile("s_waitcnt vmcnt(0)" ::: "memory");
        }
    }
    __syncthreads();
}

namespace pg8 {
constexpr int BM = 256, BK = 64, HALF = 128, HTB = HALF * BK * 2, STAGE_BYTES = 8 * HTB, NXCD = 8, WGM = 8;
__host__ __device__ __forceinline__ int lds_byte(int r, int c) { const int st = (r >> 4) * 2 + (c >> 5), rr = r & 15, cc = c & 31, ob = rr * 64 + cc * 2; return st * 1024 + (ob ^ (((ob >> 9) & 1) << 5)); }
__host__ __device__ __forceinline__ void stage_rc(int b, int& R, int& C) { const int st = b / 1024, sb = b % 1024, swz = sb ^ (((sb >> 9) & 1) << 5); R = (st >> 1) * 16 + swz / 64; C = (st & 1) * 32 + (swz % 64) / 2; }
__host__ __device__ __forceinline__ int perm32(int rho) { const int n = rho >> 4, i = rho & 15; return 8 * (i >> 2) + 4 * n + (i & 3); }

struct Unit { int pm, pn, e, ord; const char* A; const char* B; };
DI unsigned cvt_pk_bf16(float lo, float hi) { unsigned r; asm volatile("v_cvt_pk_bf16_f32 %0, %1, %2" : "=v"(r) : "v"(lo), "v"(hi)); return r; }

DI int xcd_remap(int wgid, int nwg) { const int q = nwg / NXCD, r = nwg % NXCD, xcd = wgid % NXCD, off = wgid / NXCD; return (xcd < r ? xcd * (q + 1) : r * (q + 1) + (xcd - r) * q) + off; }

struct DenseSched {
    static constexpr bool GATHER = false;
    const char* A; const char* Bt; int Kb, nM, nN, nwg, G, c, lat, tid;
    DI void init(const void* A_, const void* Bt_, int M, int N, int Kb_, int G_, int c_, int tid_, int lat_ = 0) { tid = tid_; A = (const char*)A_; Bt = (const char*)Bt_; Kb = Kb_; lat = lat_; nM = lat ? 64 : M / BM; nN = N / BM; nwg = nM * nN; G = G_; c = c_; }
    DI bool next(int i, Unit& u) const {
        const long L = (long)i * G + c; if (L >= nwg) return false;
        const int wgid = xcd_remap((int)L, nwg);
        const int nig = WGM * nN, gid = wgid / nig, fm = gid * WGM, gsz = (nM - fm) < WGM ? (nM - fm) : WGM;
        u.pm = fm + ((wgid % nig) % gsz); u.pn = (wgid % nig) / gsz; u.e = 0; u.ord = i;
        if (lat) u.pm = (u.pm >> 3) * 9 + 1 + (u.pm & 7);
        u.A = A + (size_t)u.pm * BM * Kb; u.B = Bt + (size_t)u.pn * BM * Kb; return true;
    }
    DI void aoffs(int, const Unit&, unsigned (&vo)[2][2]) const {
#pragma unroll
        for (int p = 0; p < 2; ++p) { int R, C; stage_rc(tid * 16 + p * 8192, R, C);
#pragma unroll
            for (int h = 0; h < 2; ++h) vo[h][p] = (unsigned)((h * HALF + R) * Kb + C * 2); }
    }
};
template <bool GATHER_, int NPN>
struct MoeSched {
    static constexpr bool GATHER = GATHER_;
    const char* A; const char* Bt; const LAS int* tb; const LAS unsigned* tab; int NT, G, c, Kb, tid; size_t estride;
    DI bool next(int i, Unit& u) const {
        const int nwg = NT * NPN; const long L = (long)i * G + c; if (L >= nwg) return false;
        const int id = xcd_remap((int)L, nwg);
        const int rt = id / NPN, pn = id % NPN; int e = 0;
#pragma unroll
        for (int j = 1; j < 16; ++j) e += (tb[j] <= rt) ? 1 : 0;
        u.pm = rt; u.pn = pn; u.e = e; u.ord = i;
        u.A = GATHER ? A : A + (size_t)rt * BM * Kb; u.B = Bt + (size_t)e * estride + (size_t)pn * BM * Kb; return true;
    }
    DI void aoffs(int i, const Unit&, unsigned (&vo)[2][2]) const {
#pragma unroll
        for (int p = 0; p < 2; ++p) { int R, C; stage_rc(tid * 16 + p * 8192, R, C);
#pragma unroll
            for (int h = 0; h < 2; ++h) vo[h][p] = GATHER ? (tab[i * 256 + h * HALF + R] + (unsigned)C * 2u) : (unsigned)((h * HALF + R) * Kb + C * 2); }
    }
};

struct EpiBf16 {
    static constexpr bool PERM = true;
    bf16_t* O; int ldc; int split_cols; size_t split_stride;
    DI void operator()(const f32x4 (&acc)[2][2][4][2], const Unit& u, int wr, int wc, int fr, int fq) const {
        const int row0 = u.pm * BM + wr * 64 + fr; int colt = u.pn * BM; bf16_t* base = O;
        if (split_cols) { const int t = colt / split_cols; base += (size_t)t * split_stride; colt -= t * split_cols; }
        const int col0 = colt + wc * 32 + 8 * fq;
#pragma unroll
        for (int ai = 0; ai < 2; ++ai)
#pragma unroll
            for (int m = 0; m < 4; ++m) { bf16_t* rowp = base + (size_t)(row0 + ai * HALF + m * 16) * ldc + col0;
#pragma unroll
                for (int bj = 0; bj < 2; ++bj) { const f32x4 v0 = acc[ai][bj][m][0], v1 = acc[ai][bj][m][1];
                    u32x4 w; w.x = cvt_pk_bf16(v0[0], v0[1]); w.y = cvt_pk_bf16(v0[2], v0[3]); w.z = cvt_pk_bf16(v1[0], v1[1]); w.w = cvt_pk_bf16(v1[2], v1[3]);
                    *(u32x4*)(rowp + bj * HALF) = w; } }
    }
};
struct EpiF32 {
    static constexpr bool PERM = false;
    float* C; int ldc;
    DI void operator()(const f32x4 (&acc)[2][2][4][2], const Unit& u, int wr, int wc, int fr, int fq) const {
        const int row0 = u.pm * BM + wr * 64 + fr, col0 = u.pn * BM + wc * 32 + 4 * fq;
#pragma unroll
        for (int ai = 0; ai < 2; ++ai)
#pragma unroll
            for (int m = 0; m < 4; ++m) { float* rowp = C + (size_t)(row0 + ai * HALF + m * 16) * ldc + col0;
#pragma unroll
                for (int bj = 0; bj < 2; ++bj)
#pragma unroll
                    for (int n = 0; n < 2; ++n) *(f32x4*)(rowp + bj * HALF + n * 16) = acc[ai][bj][m][n]; }
    }
};
struct EpiResid {
    static constexpr bool PERM = false;
    float* X; const float* gate;
    DI void operator()(const f32x4 (&acc)[2][2][4][2], const Unit& u, int wr, int wc, int fr, int fq) const {
        const int row0 = u.pm * BM + wr * 64 + fr, col0 = u.pn * BM + wc * 32 + 4 * fq;
        const int r9 = (u.pm % 9 == 0) ? 8 : u.pm / 9; const float* g = gate + (size_t)r9 * 6144 + col0;
        f32x4 gv[2][2];
#pragma unroll
        for (int bj = 0; bj < 2; ++bj)
#pragma unroll
            for (int n = 0; n < 2; ++n) gv[bj][n] = *(const f32x4*)(g + bj * HALF + n * 16);
#pragma unroll
        for (int ai = 0; ai < 2; ++ai)
#pragma unroll
            for (int m = 0; m < 4; ++m) { float* rowp = X + (size_t)(row0 + ai * HALF + m * 16) * D + col0;
#pragma unroll
                for (int bj = 0; bj < 2; ++bj)
#pragma unroll
                    for (int n = 0; n < 2; ++n) { const f32x4 x = *(const f32x4*)(rowp + bj * HALF + n * 16); *(f32x4*)(rowp + bj * HALF + n * 16) = x * DN_ALPHA + gv[bj][n] * acc[ai][bj][m][n]; } }
    }
};
struct EpiGluResid {
    static constexpr bool PERM = false;
    float* X; const float* gate;
    DI void operator()(const f32x4 (&acc)[2][2][4][2], const Unit& u, int wr, int wc, int fr, int fq) const {
        const int row0 = u.pm * BM + wr * 64 + fr, col0 = u.pn * HALF + wc * 32 + 4 * fq;
        const int r9 = (u.pm % 9 == 0) ? 8 : u.pm / 9; const float* g = gate + (size_t)r9 * 6144 + col0;
        f32x4 gv[2];
#pragma unroll
        for (int n = 0; n < 2; ++n) gv[n] = *(const f32x4*)(g + n * 16);
#pragma unroll
        for (int ai = 0; ai < 2; ++ai)
#pragma unroll
            for (int m = 0; m < 4; ++m) { float* rowp = X + (size_t)(row0 + ai * HALF + m * 16) * D + col0;
#pragma unroll
                for (int n = 0; n < 2; ++n) { const f32x4 v = acc[ai][0][m][n], gg = acc[ai][1][m][n]; f32x4 o;
#pragma unroll
                    for (int j = 0; j < 4; ++j) o[j] = v[j] * sigmoidf_(gg[j]);
                    const f32x4 x = *(const f32x4*)(rowp + n * 16); *(f32x4*)(rowp + n * 16) = x * DN_ALPHA + gv[n] * o; } }
    }
};
struct EpiSwiGLU {
    static constexpr bool PERM = true;
    bf16_t* Hid;
    DI void operator()(const f32x4 (&acc)[2][2][4][2], const Unit& u, int wr, int wc, int fr, int fq) const {
        const int row0 = u.pm * BM + wr * 64 + fr, col0 = u.pn * HALF + wc * 32 + 8 * fq;
#pragma unroll
        for (int ai = 0; ai < 2; ++ai)
#pragma unroll
            for (int m = 0; m < 4; ++m) { bf16_t* rowp = Hid + (size_t)(row0 + ai * HALF + m * 16) * DEXP + col0;
                f32x4 h0, h1;
#pragma unroll
                for (int j = 0; j < 4; ++j) { const float g0 = acc[ai][0][m][0][j], g1 = acc[ai][0][m][1][j]; h0[j] = g0 * sigmoidf_(g0) * acc[ai][1][m][0][j]; h1[j] = g1 * sigmoidf_(g1) * acc[ai][1][m][1][j]; }
                u32x4 w; w.x = cvt_pk_bf16(h0[0], h0[1]); w.y = cvt_pk_bf16(h0[2], h0[3]); w.z = cvt_pk_bf16(h1[0], h1[1]); w.w = cvt_pk_bf16(h1[2], h1[3]);
                *(u32x4*)rowp = w; }
    }
};

DI f32x4 i2f4(i32x4 v) { return (f32x4){(float)v[0], (float)v[1], (float)v[2], (float)v[3]}; }
struct EpiBf16S {
    static constexpr bool PERM = true;
    bf16_t* O; int ldc; int split_cols; size_t split_stride; const float* sa; const float* sb; const f32x2* rope;
    DI void operator()(const i32x4 (&acc)[2][2][4][2], const Unit& u, int wr, int wc, int fr, int fq) const {
        const int row0 = u.pm * BM + wr * 64 + fr; int colt = u.pn * BM; bf16_t* base = O;
        const int gcol0 = colt + wc * 32 + 8 * fq;
        const bool do_rope = rope != nullptr && u.pn < 8 && (u.pm % 9) != 0;
        if (split_cols) { const int t = colt / split_cols; base += (size_t)t * split_stride; colt -= t * split_cols; }
        const int col0 = colt + wc * 32 + 8 * fq;
        f32x4 sbv[2][2];
#pragma unroll
        for (int bj = 0; bj < 2; ++bj)
#pragma unroll
            for (int n = 0; n < 2; ++n) sbv[bj][n] = *(const f32x4*)(sb + gcol0 + bj * HALF + 4 * n);
#pragma unroll
        for (int ai = 0; ai < 2; ++ai)
#pragma unroll
            for (int m = 0; m < 4; ++m) { const int row = row0 + ai * HALF + m * 16; const float sar = sa[row]; bf16_t* rowp = base + (size_t)row * ldc + col0;
                f32x4 cs[4];
                if (do_rope) { const int t = row % LSEQ - CN, pos = (wc & 1) ? (t & 63) : (t >> 6); const f32x4* tp = (const f32x4*)(rope + pos * 16 + 8 * (fq & 1));
                    cs[0] = tp[0]; cs[1] = tp[1]; cs[2] = tp[2]; cs[3] = tp[3]; }
#pragma unroll
                for (int bj = 0; bj < 2; ++bj) { f32x4 v0 = i2f4(acc[ai][bj][m][0]) * sbv[bj][0] * sar, v1 = i2f4(acc[ai][bj][m][1]) * sbv[bj][1] * sar;
                    if (do_rope) { const float sg = (fq & 2) ? 1.0f : -1.0f; f32x4 p0, p1;
#pragma unroll
                        for (int j = 0; j < 4; ++j) { p0[j] = __shfl_xor(v0[j], 32); p1[j] = __shfl_xor(v1[j], 32); }
                        v0[0] = v0[0] * cs[0][0] + sg * p0[0] * cs[0][1]; v0[1] = v0[1] * cs[0][2] + sg * p0[1] * cs[0][3]; v0[2] = v0[2] * cs[1][0] + sg * p0[2] * cs[1][1]; v0[3] = v0[3] * cs[1][2] + sg * p0[3] * cs[1][3];
                        v1[0] = v1[0] * cs[2][0] + sg * p1[0] * cs[2][1]; v1[1] = v1[1] * cs[2][2] + sg * p1[1] * cs[2][3]; v1[2] = v1[2] * cs[3][0] + sg * p1[2] * cs[3][1]; v1[3] = v1[3] * cs[3][2] + sg * p1[3] * cs[3][3]; }
                    u32x4 w; w.x = cvt_pk_bf16(v0[0], v0[1]); w.y = cvt_pk_bf16(v0[2], v0[3]); w.z = cvt_pk_bf16(v1[0], v1[1]); w.w = cvt_pk_bf16(v1[2], v1[3]);
                    *(u32x4*)(rowp + bj * HALF) = w; } }
    }
};
struct EpiSwiGLUS {
    static constexpr bool PERM = true;
    bf16_t* Hid; const LAS float* tabs; const float* sb;
    DI void operator()(const i32x4 (&acc)[2][2][4][2], const Unit& u, int wr, int wc, int fr, int fq) const {
        const int row0 = u.pm * BM + wr * 64 + fr, col0 = u.pn * HALF + wc * 32 + 8 * fq;
        const float* sbp = sb + (size_t)u.e * 2048 + u.pn * BM + wc * 32 + 8 * fq;
        f32x4 sg[2], su[2];
#pragma unroll
        for (int n = 0; n < 2; ++n) { sg[n] = *(const f32x4*)(sbp + 4 * n); su[n] = *(const f32x4*)(sbp + HALF + 4 * n); }
#pragma unroll
        for (int ai = 0; ai < 2; ++ai)
#pragma unroll
            for (int m = 0; m < 4; ++m) { const float sar = tabs[u.ord * 256 + ai * HALF + wr * 64 + m * 16 + fr]; bf16_t* rowp = Hid + (size_t)(row0 + ai * HALF + m * 16) * DEXP + col0;
                const f32x4 g0v = i2f4(acc[ai][0][m][0]) * sg[0] * sar, g1v = i2f4(acc[ai][0][m][1]) * sg[1] * sar, u0v = i2f4(acc[ai][1][m][0]) * su[0] * sar, u1v = i2f4(acc[ai][1][m][1]) * su[1] * sar;
                f32x4 h0, h1;
#pragma unroll
                for (int j = 0; j < 4; ++j) { h0[j] = g0v[j] * sigmoidf_(g0v[j]) * u0v[j]; h1[j] = g1v[j] * sigmoidf_(g1v[j]) * u1v[j]; }
                u32x4 w; w.x = cvt_pk_bf16(h0[0], h0[1]); w.y = cvt_pk_bf16(h0[2], h0[3]); w.z = cvt_pk_bf16(h1[0], h1[1]); w.w = cvt_pk_bf16(h1[2], h1[3]);
                *(u32x4*)rowp = w; }
    }
};
template <bool I8> struct AccSel { typedef f32x4 T; };
template <> struct AccSel<true> { typedef i32x4 T; };
DI f32x4 mma16(bf16x8 b, bf16x8 a, f32x4 c) { return __builtin_amdgcn_mfma_f32_16x16x32_bf16(b, a, c, 0, 0, 0); }
DI i32x4 mma16(bf16x8 b, bf16x8 a, i32x4 c) { return __builtin_amdgcn_mfma_i32_16x16x64_i8(__builtin_bit_cast(i32x4, b), __builtin_bit_cast(i32x4, a), c, 0, 0, 0); }
template <class Epi, class Sched, bool I8 = false, bool ALIGN_EPI = true>
DI void gemm_phase(LAS unsigned char* lds, const int Kb  , const Sched& S, const Epi& E, const int tid) {
    const int wid = __builtin_amdgcn_readfirstlane(tid >> 6), lane = tid & 63, wr = wid >> 2, wc = wid & 3, fr = lane & 15, fq = lane >> 4;
    const int nt = Kb / (BK * 2);
    unsigned voffB[2];
#pragma unroll
    for (int i = 0; i < 2; ++i) { int R, C; stage_rc(tid * 16 + i * 8192, R, C); const int Rb = Epi::PERM ? ((R & ~31) + perm32(R & 31)) : R; voffB[i] = (unsigned)(Rb * Kb + C * 2); }
    const size_t kstep = (size_t)(BK * 2);
    const size_t hstep = (size_t)HALF * Kb;
    const unsigned ldsw = (unsigned)wid * 1024u;
    const int aoff = lds_byte(wr * 64 + fr, fq * 8), boff = lds_byte(wc * 32 + fr, fq * 8);
#define PG8_SA(b, h) (((b) * 2 + (h)) * HTB)
#define PG8_SB(b, h) ((4 + (b) * 2 + (h)) * HTB)
#define PG8_STAGE(bufoff, gbase, o0, o1) do { \
        __builtin_amdgcn_global_load_lds((const unsigned*)((const char*)(gbase) + (o0)), (LAS unsigned*)(lds + (bufoff) + ldsw), 16, 0, 0); \
        __builtin_amdgcn_global_load_lds((const unsigned*)((const char*)(gbase) + (o1)), (LAS unsigned*)(lds + (bufoff) + ldsw + 8192), 16, 0, 0); } while (0)
#define PG8_STAGEB(bufoff, gbase) PG8_STAGE(bufoff, gbase, voffB[0], voffB[1])
#define PG8_LDA(dst, b, h) do { _Pragma("unroll") for (int m = 0; m < 4; ++m) _Pragma("unroll") for (int k = 0; k < 2; ++k) dst[m][k] = *(const LAS bf16x8*)(lds + PG8_SA(b, h) + aoff + m * 2048 + k * 1024); } while (0)
#define PG8_LDB(dst, b, h) do { _Pragma("unroll") for (int n = 0; n < 2; ++n) _Pragma("unroll") for (int k = 0; k < 2; ++k) dst[n][k] = *(const LAS bf16x8*)(lds + PG8_SB(b, h) + boff + n * 2048 + k * 1024); } while (0)
#define PG8_MMA(ai, bj, At, Bt) do { __builtin_amdgcn_s_setprio(1); _Pragma("unroll") for (int m = 0; m < 4; ++m) _Pragma("unroll") for (int n = 0; n < 2; ++n) _Pragma("unroll") for (int k = 0; k < 2; ++k) \
        acc[ai][bj][m][n] = mma16(Bt[n][k], At[m][k], acc[ai][bj][m][n]); __builtin_amdgcn_s_setprio(0); } while (0)
#define PG8_WAIT_V(n) asm volatile("s_waitcnt vmcnt(" #n ")" ::: "memory")
#define PG8_WAIT_L(n) asm volatile("s_waitcnt lgkmcnt(" #n ")" ::: "memory")
#define PG8_BAR __builtin_amdgcn_s_barrier()
#define PG8_SCHED __builtin_amdgcn_sched_barrier(0)
    Unit cur, nxt; int ui = 0;
    if (!S.next(0, cur)) return;
    typedef typename AccSel<I8>::T AccT;
    AccT acc[2][2][4][2];
#pragma unroll
    for (int a = 0; a < 2; ++a)
#pragma unroll
        for (int b = 0; b < 2; ++b)
#pragma unroll
            for (int m = 0; m < 4; ++m)
#pragma unroll
                for (int n = 0; n < 2; ++n) acc[a][b][m][n] = AccT{};
    bf16x8 At[4][2], B0[2][2], B1[2][2];
    unsigned voA[2][2], voN[2][2];
    S.aoffs(0, cur, voA);
#pragma unroll
    for (int h = 0; h < 2; ++h)
#pragma unroll
        for (int p = 0; p < 2; ++p) voN[h][p] = voA[h][p];
    const char* cA = cur.A; const char* cB = cur.B;
    PG8_STAGEB(PG8_SB(0, 0), cB); PG8_STAGEB(PG8_SB(0, 1), cB + hstep); PG8_STAGE(PG8_SA(0, 0), cA, voA[0][0], voA[0][1]); PG8_STAGE(PG8_SA(0, 1), cA, voA[1][0], voA[1][1]);
    if (wr == 1) PG8_BAR;
    PG8_WAIT_V(2); PG8_BAR;
    PG8_STAGEB(PG8_SB(1, 0), cB + kstep); PG8_STAGE(PG8_SA(1, 0), cA + kstep, voA[0][0], voA[0][1]); PG8_STAGEB(PG8_SB(1, 1), cB + hstep + kstep);
    PG8_WAIT_V(6); PG8_BAR;
    for (;;) {
        const bool has_next = S.next(ui + 1, nxt);
        const char* nA = has_next ? nxt.A : cA; const char* nB = has_next ? nxt.B : cB;
        for (int t = 0; t < nt; t += 2) {
            const bool last = (t == nt - 2);
            const char* a1 = cA + (size_t)(t + 1) * kstep;
            const char* a2 = last ? nA : cA + (size_t)(t + 2) * kstep; const char* b2 = last ? nB : cB + (size_t)(t + 2) * kstep;
            const char* a3 = a2 + kstep; const char* b3 = b2 + kstep;
            if (Sched::GATHER) { if (last && has_next) S.aoffs(ui + 1, nxt, voN); }
            unsigned s00 = voA[0][0], s01 = voA[0][1], s10 = voA[1][0], s11 = voA[1][1];
            if (Sched::GATHER) { if (last) { s00 = voN[0][0]; s01 = voN[0][1]; s10 = voN[1][0]; s11 = voN[1][1]; } }
            PG8_LDB(B0, 0, 0); PG8_LDB(B1, 0, 1); PG8_SCHED; PG8_LDA(At, 0, 0); PG8_STAGE(PG8_SA(1, 1), a1, voA[1][0], voA[1][1]);
            PG8_WAIT_V(8); PG8_WAIT_L(0); PG8_BAR; PG8_MMA(0, 0, At, B0); PG8_MMA(0, 1, At, B1); PG8_BAR; PG8_SCHED;
            PG8_LDA(At, 0, 1); PG8_STAGEB(PG8_SB(0, 0), b2); PG8_STAGEB(PG8_SB(0, 1), b2 + hstep); PG8_STAGE(PG8_SA(0, 0), a2, s00, s01);
            PG8_WAIT_V(8); PG8_WAIT_L(0); PG8_BAR; PG8_MMA(1, 0, At, B0); PG8_MMA(1, 1, At, B1); PG8_BAR; PG8_SCHED;
            PG8_LDB(B0, 1, 0); PG8_LDB(B1, 1, 1); PG8_SCHED; PG8_LDA(At, 1, 0); PG8_STAGE(PG8_SA(0, 1), a2, s10, s11);
            PG8_WAIT_V(8); PG8_WAIT_L(0); PG8_BAR; PG8_MMA(0, 0, At, B0); PG8_MMA(0, 1, At, B1); PG8_BAR; PG8_SCHED;
            PG8_LDA(At, 1, 1); PG8_STAGEB(PG8_SB(1, 0), b3); PG8_STAGEB(PG8_SB(1, 1), b3 + hstep); PG8_STAGE(PG8_SA(1, 0), a3, s00, s01);
            PG8_WAIT_V(8); PG8_WAIT_L(0); PG8_BAR; PG8_MMA(1, 0, At, B0); PG8_MMA(1, 1, At, B1); PG8_BAR; PG8_SCHED;
        }
        if constexpr (ALIGN_EPI) { if (wr == 0) PG8_BAR; }
        E(acc, cur, wr, wc, fr, fq);
        if (!has_next) break;
#pragma unroll
        for (int a = 0; a < 2; ++a)
#pragma unroll
            for (int b = 0; b < 2; ++b)
#pragma unroll
                for (int m = 0; m < 4; ++m)
#pragma unroll
                    for (int n = 0; n < 2; ++n) acc[a][b][m][n] = AccT{};
        cur = nxt; cA = nA; cB = nB; ++ui;
        if (Sched::GATHER) {
#pragma unroll
            for (int h = 0; h < 2; ++h)
#pragma unroll
                for (int p = 0; p < 2; ++p) voA[h][p] = voN[h][p];
        }
        if constexpr (ALIGN_EPI) { if (wr == 1) PG8_BAR; }
    }
    PG8_WAIT_V(0);
    if constexpr (!ALIGN_EPI) { if (wr == 0) PG8_BAR; }
    PG8_BAR;
#undef PG8_SA
#undef PG8_SB
#undef PG8_STAGE
#undef PG8_STAGEB
#undef PG8_LDA
#undef PG8_LDB
#undef PG8_MMA
#undef PG8_WAIT_V
#undef PG8_WAIT_L
#undef PG8_BAR
#undef PG8_SCHED
}
}

namespace att {
constexpr int KVBLK = 64;
constexpr float SCALE = 0.125f;
constexpr float THR = 8.f;
constexpr int SHM_V = KVBLK * 128 * 2, SHM_K = KVBLK * 128 * 2;
constexpr int ATT_LDS = 2 * SHM_V + 2 * SHM_K + 8 * 64 * 4;
#define KSWZ(row, colB) ((row) * 256 + ((colB) ^ (((row) & 7) << 4)))
#define SBAR() __builtin_amdgcn_sched_barrier(0)
DI int crow(int r, int hi) { return (r & 3) + 8 * (r >> 2) + 4 * hi; }
DI unsigned cvtpk(float lo, float hi) { unsigned r; asm volatile("v_cvt_pk_bf16_f32 %0, %1, %2" : "=v"(r) : "v"(lo), "v"(hi)); return r; }
DI void partialSM(f32x16& p0, f32x16& p1, float& m_reg, float& mn, float& alpha) {
  constexpr float C = SCALE * 1.4426950408889634f;
  float pmax = p0[0];
#pragma unroll
  for (int r = 1; r < 16; ++r) pmax = fmaxf(pmax, p0[r]);
#pragma unroll
  for (int r = 0; r < 16; ++r) pmax = fmaxf(pmax, p1[r]);
  { auto rr = __builtin_amdgcn_permlane32_swap(__float_as_uint(pmax), __float_as_uint(pmax), false, false);
    pmax = fmaxf(__uint_as_float(rr[0]), __uint_as_float(rr[1])); }
  if (__builtin_expect(__all(pmax - m_reg <= THR / SCALE), 1)) { mn = m_reg; alpha = 1.f; }
  else { mn = fmaxf(m_reg, pmax); alpha = __builtin_amdgcn_exp2f((m_reg - mn) * C); m_reg = mn; }
  float mnC = -mn * C;
#pragma unroll
  for (int r = 0; r < 16; ++r) p0[r] = fmaf(p0[r], C, mnC);
#pragma unroll
  for (int r = 0; r < 16; ++r) p1[r] = fmaf(p1[r], C, mnC);
#pragma unroll
  for (int r = 0; r < 16; ++r) p0[r] = __builtin_amdgcn_exp2f(p0[r]);
}
DI void finishSM(f32x16& p0, f32x16& p1, float alpha, float& l_reg, bf16x8& pa0, bf16x8& pa1, bf16x8& pa2, bf16x8& pa3) {
#pragma unroll
  for (int r = 0; r < 16; ++r) p1[r] = __builtin_amdgcn_exp2f(p1[r]);
  float ps = 0;
#pragma unroll
  for (int r = 0; r < 16; ++r) ps += p0[r];
#pragma unroll
  for (int r = 0; r < 16; ++r) ps += p1[r];
  { auto rr = __builtin_amdgcn_permlane32_swap(__float_as_uint(ps), __float_as_uint(ps), false, false);
    ps = __uint_as_float(rr[0]) + __uint_as_float(rr[1]); }
  l_reg = l_reg * alpha + ps;
#define PK4(P, BASE, OUT) do { unsigned a0 = cvtpk(P[BASE + 0], P[BASE + 1]), a1 = cvtpk(P[BASE + 2], P[BASE + 3]);   \
    unsigned b0 = cvtpk(P[BASE + 4], P[BASE + 5]), b1 = cvtpk(P[BASE + 6], P[BASE + 7]);                              \
    auto r0 = __builtin_amdgcn_permlane32_swap(a0, b0, false, false); auto r1 = __builtin_amdgcn_permlane32_swap(a1, b1, false, false); \
    u32x4 w = {r0[0], r1[0], r0[1], r1[1]}; OUT = __builtin_bit_cast(bf16x8, w); } while (0)
  PK4(p0, 0, pa0); PK4(p0, 8, pa1); PK4(p1, 0, pa2); PK4(p1, 8, pa3);
#undef PK4
}
DI void qkt(f32x16& p0, f32x16& p1, const LAS char* Ks, const bf16x8* qr, int r32, int hi, int mo) {
  p0 = f32x16{}; p1 = f32x16{};
#pragma unroll
  for (int d0 = 0; d0 < 4; ++d0) { const int cb = mo + (d0 * 16 + hi * 8) * 2;
    bf16x8 b0 = *(const LAS bf16x8*)(Ks + KSWZ(r32, cb));
    bf16x8 b1 = *(const LAS bf16x8*)(Ks + KSWZ(32 + r32, cb));
    p0 = __builtin_amdgcn_mfma_f32_32x32x16_bf16(b0, qr[d0], p0, 0, 0, 0);
    p1 = __builtin_amdgcn_mfma_f32_32x32x16_bf16(b1, qr[d0], p1, 0, 0, 0); }
}
DI int v_st(int k, int c) { const int kk = (k & ~0xC) | ((k & 4) << 1) | ((k & 8) >> 1); return ((kk >> 3) * 4 + (c >> 5)) * 512 + ((kk & 7) * 32 + (c & 31)) * 2; }
DI int v_rd_base(int lane) { return ((lane & 3) << 3) | (((lane >> 2) & 3) << 6) | (((lane >> 4) & 1) << 5) | (((lane >> 5) & 1) << 8); }
constexpr int v_rd_off(int d0, int ks, int half) { return d0 * 512 + ks * 4096 + half * 2048; }
template <int OFF> DI s16x4 tr_read(int vb) { s16x4 r; asm volatile("ds_read_b64_tr_b16 %0, %1 offset:%2" : "=&v"(r) : "v"(vb), "i"(OFF) : "memory"); return r; }
template <int D0> DI void pv_one(f32x16& od, int vb, bf16x8 pa0, bf16x8 pa1, bf16x8 pa2, bf16x8 pa3) {
  const s16x4 l0 = tr_read<v_rd_off(D0, 0, 0)>(vb), h0 = tr_read<v_rd_off(D0, 0, 1)>(vb), l1 = tr_read<v_rd_off(D0, 1, 0)>(vb), h1 = tr_read<v_rd_off(D0, 1, 1)>(vb);
  const s16x4 l2 = tr_read<v_rd_off(D0, 2, 0)>(vb), h2 = tr_read<v_rd_off(D0, 2, 1)>(vb), l3 = tr_read<v_rd_off(D0, 3, 0)>(vb), h3 = tr_read<v_rd_off(D0, 3, 1)>(vb);
  asm volatile("s_waitcnt lgkmcnt(0)" ::: "memory"); SBAR();
#define PK(L, H) (bf16x8){L[0], L[1], L[2], L[3], H[0], H[1], H[2], H[3]}
  od = __builtin_amdgcn_mfma_f32_32x32x16_bf16(pa0, PK(l0, h0), od, 0, 0, 0);
  od = __builtin_amdgcn_mfma_f32_32x32x16_bf16(pa1, PK(l1, h1), od, 0, 0, 0);
  od = __builtin_amdgcn_mfma_f32_32x32x16_bf16(pa2, PK(l2, h2), od, 0, 0, 0);
  od = __builtin_amdgcn_mfma_f32_32x32x16_bf16(pa3, PK(l3, h3), od, 0, 0, 0);
#undef PK
}
DI void pv_d0(f32x16* o, int vb, bf16x8 pa0, bf16x8 pa1, bf16x8 pa2, bf16x8 pa3) {
  pv_one<0>(o[0], vb, pa0, pa1, pa2, pa3); pv_one<1>(o[1], vb, pa0, pa1, pa2, pa3); pv_one<2>(o[2], vb, pa0, pa1, pa2, pa3); pv_one<3>(o[3], vb, pa0, pa1, pa2, pa3);
}
DI void attn_unit(const bf16_t* Qb, const bf16_t* Kb, const bf16_t* Vb, bf16_t* Ob, int h, int seq, float lam, float osc, const float* subg, LAS char* lds, const int tid) {
  const int wid = __builtin_amdgcn_readfirstlane(tid >> 6), lane = tid & 63, r32 = lane & 31, hi = lane >> 5;
  const int mbr = wid >> 2, wq = wid & 3, mo = mbr * 128;
  LAS char* V_lds = lds; LAS char* K_lds = lds + 2 * SHM_V;
  LAS float* wsl = (LAS float*)(lds + 2 * SHM_V + 2 * SHM_K) + wid * 64; LAS float* li_l = wsl; LAS float* al_l = wsl + 32;
  float m_reg = -1e30f, l_reg = 0; f32x16 o[4] = {}; bf16x8 qr[4];
  const bf16_t* Qw = Qb + (size_t)(wq * 32 + r32) * 1024 + mbr * 512 + h * 64 + hi * 8;
#pragma unroll
  for (int d0 = 0; d0 < 4; ++d0) qr[d0] = *(const bf16x8*)(Qw + d0 * 16);
  const int sr = tid >> 4, sc = (tid & 15) * 8, vst0 = v_st(sr, sc), vst1 = v_st(32 + sr, sc);
  const int kcol = (sc >> 6) * 512 + h * 64 + (sc & 63), vcol = h * 128 + sc;
  const int vb0 = (int)(uintptr_t)V_lds + v_rd_base(lane);
  bf16x8 vsA0, vsA1, ksA0, ksA1, vsB0, vsB1, ksB0, ksB1;
#define SLOADA(k0) do { vsA0 = *(const bf16x8*)(Vb + (size_t)((k0) + sr) * 1024 + vcol); vsA1 = *(const bf16x8*)(Vb + (size_t)((k0) + 32 + sr) * 1024 + vcol); \
    ksA0 = *(const bf16x8*)(Kb + (size_t)((k0) + sr) * 1024 + kcol); ksA1 = *(const bf16x8*)(Kb + (size_t)((k0) + 32 + sr) * 1024 + kcol); } while (0)
#define SLOADB(k0) do { vsB0 = *(const bf16x8*)(Vb + (size_t)((k0) + sr) * 1024 + vcol); vsB1 = *(const bf16x8*)(Vb + (size_t)((k0) + 32 + sr) * 1024 + vcol); \
    ksB0 = *(const bf16x8*)(Kb + (size_t)((k0) + sr) * 1024 + kcol); ksB1 = *(const bf16x8*)(Kb + (size_t)((k0) + 32 + sr) * 1024 + kcol); } while (0)
#define SWRITE(b, v0, v1, k0_, k1_) do { *(LAS bf16x8*)(V_lds + (b) * SHM_V + vst0) = v0; *(LAS bf16x8*)(V_lds + (b) * SHM_V + vst1) = v1; const int kc = sc * 2; \
    *(LAS bf16x8*)(K_lds + (b) * SHM_K + KSWZ(sr, kc)) = k0_; *(LAS bf16x8*)(K_lds + (b) * SHM_K + KSWZ(32 + sr, kc)) = k1_; } while (0)
#define SWAIT() asm volatile("s_waitcnt vmcnt(4)" ::: "memory")
#define RESC(a) do { if (__any((a) < 1.f)) { if (hi == 0) al_l[r32] = (a); asm volatile("s_waitcnt lgkmcnt(0)" ::: "memory"); \
    _Pragma("unroll") for (int d = 0; d < 4; ++d) _Pragma("unroll") for (int r = 0; r < 16; ++r) o[d][r] *= al_l[crow(r, hi)]; } } while (0)
  f32x16 pA0, pA1, pB0, pB1; float mnA, mnB, alA, alB; bf16x8 pa0, pa1, pa2, pa3; const int NT = seq / KVBLK;
  SLOADA(0); asm volatile("s_waitcnt vmcnt(0)" ::: "memory"); SWRITE(0, vsA0, vsA1, ksA0, ksA1); __syncthreads();
  qkt(pA0, pA1, K_lds, qr, r32, hi, mo); partialSM(pA0, pA1, m_reg, mnA, alA);
  SLOADB(KVBLK); if (2 < NT) SLOADA(2 * KVBLK);
  SWAIT(); SWRITE(1, vsB0, vsB1, ksB0, ksB1); __syncthreads();
  for (int j = 1; j + 1 < NT; j += 2) {
    SBAR(); qkt(pB0, pB1, K_lds + SHM_K, qr, r32, hi, mo);
    finishSM(pA0, pA1, alA, l_reg, pa0, pa1, pa2, pa3); SBAR();
    SLOADB((j + 2) * KVBLK); SBAR();
    pv_d0(o, vb0, pa0, pa1, pa2, pa3); partialSM(pB0, pB1, m_reg, mnB, alB);
    __syncthreads(); SWAIT(); SWRITE(0, vsA0, vsA1, ksA0, ksA1);
    RESC(alB); __syncthreads();
    SBAR(); qkt(pA0, pA1, K_lds, qr, r32, hi, mo);
    finishSM(pB0, pB1, alB, l_reg, pa0, pa1, pa2, pa3); SBAR();
    if (j + 3 < NT) SLOADA((j + 3) * KVBLK); SBAR();
    pv_d0(o, vb0 + SHM_V, pa0, pa1, pa2, pa3); partialSM(pA0, pA1, m_reg, mnA, alA);
    __syncthreads(); SWAIT(); SWRITE(1, vsB0, vsB1, ksB0, ksB1);
    RESC(alA); __syncthreads();
  }
  SBAR(); qkt(pB0, pB1, K_lds + SHM_K, qr, r32, hi, mo);
  finishSM(pA0, pA1, alA, l_reg, pa0, pa1, pa2, pa3); SBAR();
  pv_d0(o, vb0, pa0, pa1, pa2, pa3); partialSM(pB0, pB1, m_reg, mnB, alB);
  __syncthreads(); RESC(alB);
  finishSM(pB0, pB1, alB, l_reg, pa0, pa1, pa2, pa3); SBAR();
  pv_d0(o, vb0 + SHM_V, pa0, pa1, pa2, pa3);
  if (hi == 0) li_l[r32] = l_reg; asm volatile("s_waitcnt lgkmcnt(0)" ::: "memory");
  float rli[16];
#pragma unroll
  for (int r = 0; r < 16; ++r) rli[r] = 1.0f / li_l[crow(r, hi)];
  asm volatile("s_waitcnt vmcnt(0)" ::: "memory");
  __syncthreads();
  LAS float* ex = (LAS float*)lds;
  if (mbr == 1) {
#pragma unroll
    for (int r = 0; r < 16; ++r)
#pragma unroll
      for (int d0 = 0; d0 < 4; ++d0) ex[((wq * 16 + r) * 4 + d0) * 64 + lane] = o[d0][r] * rli[r] * lam;
  }
  asm volatile("s_waitcnt lgkmcnt(0)" ::: "memory");
  __syncthreads();
  if (mbr == 0) {
    float g[4];
#pragma unroll
    for (int d0 = 0; d0 < 4; ++d0) g[d0] = subg[d0 * 32 + r32] * osc;
    bf16_t* Ow = Ob + (size_t)(wq * 32) * 1024 + h * 128;
#pragma unroll
    for (int r = 0; r < 16; ++r) {
      float v[4]; float ss = 0.f;
#pragma unroll
      for (int d0 = 0; d0 < 4; ++d0) { v[d0] = o[d0][r] * rli[r] - ex[((wq * 16 + r) * 4 + d0) * 64 + lane]; ss += v[d0] * v[d0]; }
#pragma unroll
      for (int of = 1; of < 32; of <<= 1) ss += __shfl_xor(ss, of);
      const float rs = 1.0f / sqrtf(ss * (1.0f / 128.0f) + LN_EPS);
      const int orow = crow(r, hi);
#pragma unroll
      for (int d0 = 0; d0 < 4; ++d0) Ow[(size_t)orow * 1024 + d0 * 32 + r32] = (bf16_t)f2bf(v[d0] * rs * g[d0]);
    }
  }
  asm volatile("s_waitcnt lgkmcnt(0)" ::: "memory");
  __syncthreads();
#undef SLOADA
#undef SLOADB
#undef SWRITE
#undef SWAIT
#undef RESC
}
}

struct Args { const float* in[37]; float* out; unsigned char* ws; int ph_lo, ph_hi; };
struct Frame { LAS unsigned char* lds; int tid, lane, wave, G, bid, gw, NGW; };
DI Frame refresh(const Frame& F0) { Frame F = F0; int l; asm volatile("v_mbcnt_lo_u32_b32 %0, -1, 0\n\tv_mbcnt_hi_u32_b32 %0, -1, %0" : "=v"(l)); F.lane = l; F.tid = F0.wave * 64 + l; return F; }
enum { I_X = 0, I_C, I_CTX, I_CCTX, I_WADA, I_BADA, I_LNG, I_LNB, I_AWIN, I_AWOUT, I_ALAM, I_ASUB, I_S5WIN, I_S5ARE, I_S5AIM, I_S5BRE, I_S5BIM, I_S5CRE, I_S5CIM, I_S5LDT, I_S5D, I_S5GV, I_S5GG,
       I_LWIN, I_LCW, I_LCB, I_LWA, I_LBA, I_LWX, I_LBX, I_LLAM, I_LWOUT, I_RW, I_RB, I_MG, I_MU, I_MD };

DI unsigned pack4_i8(f32x4 v, float inv) {
    const int a = (int)rintf(v[0] * inv), b = (int)rintf(v[1] * inv), c = (int)rintf(v[2] * inv), d = (int)rintf(v[3] * inv);
    return (unsigned)(a & 255) | ((unsigned)(b & 255) << 8) | ((unsigned)(c & 255) << 16) | ((unsigned)d << 24);
}
DI void store_h8(signed char* hrow, float* sa, int lane, const f32x4 (&v)[4]) {
    float m = 0.f;
#pragma unroll
    for (int j = 0; j < 4; ++j) m = fmaxf(m, fmaxf(fmaxf(fabsf(v[j][0]), fabsf(v[j][1])), fmaxf(fabsf(v[j][2]), fabsf(v[j][3]))));
    m = wave_max(m);
    const float inv = m > 0.f ? 127.0f / m : 0.f;
#pragma unroll
    for (int j = 0; j < 4; ++j) *(unsigned*)(hrow + 4 * lane + 256 * j) = pack4_i8(v[j], inv);
    if (lane == 0) *sa = m * (1.0f / 127.0f);
}
DI void quant_strip(const float* W, int ldw, int n0, signed char* WT8, float* SB, int drow0, LAS float* red, int tid) {
    const int c4 = (tid & 7) * 4, r0 = (tid >> 3) * 16, lane = tid & 63, wave = tid >> 6;
    f32x4 v[16]; const float* wp = W + (size_t)r0 * ldw + n0 + c4;
#pragma unroll
    for (int i = 0; i < 16; ++i) v[i] = *(const f32x4*)(wp + (size_t)i * ldw);
    f32x4 mx = {0.f, 0.f, 0.f, 0.f};
#pragma unroll
    for (int i = 0; i < 16; ++i)
#pragma unroll
        for (int q = 0; q < 4; ++q) mx[q] = fmaxf(mx[q], fabsf(v[i][q]));
#pragma unroll
    for (int q = 0; q < 4; ++q) { mx[q] = fmaxf(mx[q], __shfl_xor(mx[q], 8)); mx[q] = fmaxf(mx[q], __shfl_xor(mx[q], 16)); mx[q] = fmaxf(mx[q], __shfl_xor(mx[q], 32)); }
    if (lane < 8) *(LAS f32x4*)(red + wave * 32 + lane * 4) = mx;
    LDS_WAIT();
    __syncthreads();
    f32x4 m = *(const LAS f32x4*)(red + c4);
#pragma unroll
    for (int w = 1; w < 8; ++w) { const f32x4 t = *(const LAS f32x4*)(red + w * 32 + c4);
#pragma unroll
        for (int q = 0; q < 4; ++q) m[q] = fmaxf(m[q], t[q]); }
#pragma unroll
    for (int q = 0; q < 4; ++q) { const float inv = m[q] > 0.f ? 127.0f / m[q] : 0.f; u32x4 o;
        o.x = pack4_i8((f32x4){v[0][q], v[1][q], v[2][q], v[3][q]}, inv); o.y = pack4_i8((f32x4){v[4][q], v[5][q], v[6][q], v[7][q]}, inv);
        o.z = pack4_i8((f32x4){v[8][q], v[9][q], v[10][q], v[11][q]}, inv); o.w = pack4_i8((f32x4){v[12][q], v[13][q], v[14][q], v[15][q]}, inv);
        *(u32x4*)(WT8 + (size_t)(drow0 + c4 + q) * 1024 + r0) = o; }
    if (tid < 8) *(f32x4*)(SB + drow0 + c4) = m * (1.0f / 127.0f);
    __syncthreads();
}
DI void transpose_tile(const float* W, int ldw, int k0, int n0, bf16_t* WT, int ldt, int drow0, LAS float* scr, int lane) {
    float v[32];
    const float* wp = W + (size_t)(k0 + (lane >> 5)) * ldw + n0 + (lane & 31);
#pragma unroll
    for (int i = 0; i < 32; ++i) v[i] = wp[(size_t)(2 * i) * ldw];
#pragma unroll
    for (int i = 0; i < 32; ++i) scr[(2 * i + (lane >> 5)) * 33 + (lane & 31)] = v[i];
    LDS_WAIT(); asm volatile("" ::: "memory");
    const int c = lane & 7;
#pragma unroll
    for (int j = 0; j < 4; ++j) { const int n = (lane >> 3) + 8 * j; const LAS float* s = scr + (8 * c) * 33 + n;
        u32x4 o; o.x = pk2(s[0 * 33], s[1 * 33]); o.y = pk2(s[2 * 33], s[3 * 33]); o.z = pk2(s[4 * 33], s[5 * 33]); o.w = pk2(s[6 * 33], s[7 * 33]);
        *(u32x4*)(WT + (size_t)(drow0 + n) * ldt + k0 + 8 * c) = o; }
    LDS_WAIT(); asm volatile("" ::: "memory");
}
DI void transpose_item(const float* W, int K, int N, bf16_t* WT, int item, int drow_base, LAS float* scr, int lane) {
    const int nblk = N / 32, kb = item / nblk, nb = item % nblk;
    transpose_tile(W, N, 64 * kb, 32 * nb, WT, K, drow_base + 32 * nb, scr, lane);
}
constexpr int BG_PER_LAYER = 2048, BG_TOTAL = DEPTH * BG_PER_LAYER;
DI void bg_item(const Args& a, const Frame& F, int it) {
    const int li = it >> 11, r = it & 2047;
    unsigned char* wbase = a.ws + WS_MOEW + (size_t)li * 64 * MiB;
    if (r < 1024) {
        const int which = r >> 9, e = (r >> 5) & 15, n0 = (r & 31) * 32;
        quant_strip(a.in[which ? I_MU : I_MG] + ((size_t)(li * 16 + e)) * 1024 * 1024, 1024, n0, (signed char*)wbase, (float*)(a.ws + WS_SCL + SCL_GU + (size_t)li * 131072),
                    e * 2048 + (n0 >> 7) * 256 + which * 128 + (n0 & 127), (LAS float*)F.lds, F.tid);
    } else {
        const int g = r - 1024, e = g >> 6, tile = (g & 63) * 8 + F.wave, kb = tile >> 5, nb = tile & 31;
        LAS float* scr = (LAS float*)(F.lds + 1024 + F.wave * 8704);
        transpose_tile(a.in[I_MD] + ((size_t)(li * 16 + e)) * 1024 * 1024, 1024, 64 * kb, 32 * nb, (bf16_t*)(wbase + 32 * MiB), 1024, e * 1024 + 32 * nb, scr, F.lane);
    }
}
DI int bg_take(const Args& a, const Frame& F) {
    LAS int* slot = (LAS int*)(F.lds + MISC_OFF + 64);
    __syncthreads();
    if (F.tid == 0) *slot = (int)__hip_atomic_fetch_add((unsigned*)(a.ws + WS_CTL) + CW_BG, 1u, RLX_AGENT);
    LDS_WAIT();
    __syncthreads();
    return *slot;
}
DI void bg_tail(const Args& a, const Frame& F, int nwg_units, int seq) {
    unsigned* flag = (unsigned*)(a.ws + WS_CTL) + CW_DONE + seq * 64;
    const int myu = (nwg_units - F.bid + F.G - 1) / F.G, maxu = (nwg_units + F.G - 1) / F.G;
    if (myu >= maxu) { if (F.tid == 0) __hip_atomic_store(flag, 1u, RLX_AGENT); return; }
    LAS int* slot = (LAS int*)(F.lds + MISC_OFF + 64);
    for (;;) {
        __syncthreads();
        if (F.tid == 0) { int it = -1; if (__hip_atomic_load(flag, RLX_AGENT) == 0u) it = (int)__hip_atomic_fetch_add((unsigned*)(a.ws + WS_CTL) + CW_BG, 1u, RLX_AGENT); *slot = it; }
        LDS_WAIT();
        __syncthreads();
        const int it = *slot;
        if (it < 0 || it >= BG_TOTAL) break;
        bg_item(a, F, it);
    }
    __syncthreads();
}
DI void bg_catch_up(const Args& a, const Frame& F, int li) {
    const int end = (li + 1) * BG_PER_LAYER;
    for (;;) { const int it = bg_take(a, F); if (it >= BG_TOTAL) break; bg_item(a, F, it); if (it >= end) break; }
    __syncthreads();
}

DI void p0_prologue(const Args& a, const Frame& F) {
    LAS float* scr = (LAS float*)(F.lds + F.wave * 16384);
    unsigned char* ws = a.ws;
    {
        constexpr int I_AOUT = 16 * 32, I_S5 = 16 * 32, I_LOUT = 22 * 32;
        constexpr int NIT = 2 * I_AOUT + 2 * I_S5 + I_LOUT;
        for (int it = F.gw; it < NIT; it += F.NGW) {
            int r = it;
            if (r < 2 * I_AOUT) { const int sl = r / I_AOUT; transpose_item(a.in[I_AWOUT] + (size_t)sl * 1024 * 1024, 1024, 1024, (bf16_t*)(ws + WS_WATT_OUT) + (size_t)sl * 1024 * 1024, r % I_AOUT, 0, scr, F.lane); continue; } r -= 2 * I_AOUT;
            if (r < 2 * I_S5) { const int which = r / I_S5, item = r % I_S5, kb = item / 32, nb = item % 32, n0 = 32 * nb;
                transpose_tile(a.in[which ? I_S5GG : I_S5GV], 1024, 64 * kb, n0, (bf16_t*)(ws + WS_WS5_GLU), 1024, (n0 >> 7) * 256 + which * 128 + (n0 & 127), scr, F.lane); continue; } r -= 2 * I_S5;
            transpose_item(a.in[I_LWOUT], 1408, 1024, (bf16_t*)(ws + WS_WLRU_OUT), r, 0, scr, F.lane);
        }
        __syncthreads();
        for (int st = F.bid; st < 2 * 96 + 32 + 88; st += F.G) {
            if (st < 192) { const int sl = st / 96, n0 = (st % 96) * 32; quant_strip(a.in[I_AWIN] + (size_t)sl * 1024 * 3072, 3072, n0, (signed char*)(ws + WS_WATT_IN) + (size_t)sl * 3072 * 1024, (float*)(ws + WS_SCL + SCL_ATT) + sl * 3072, n0, (LAS float*)F.lds, F.tid); }
            else if (st < 224) { const int n0 = (st - 192) * 32; quant_strip(a.in[I_S5WIN], 1024, n0, (signed char*)(ws + WS_WS5_IN), (float*)(ws + WS_SCL + SCL_S5), n0, (LAS float*)F.lds, F.tid); }
            else { const int n0 = (st - 224) * 32; quant_strip(a.in[I_LWIN], 2816, n0, (signed char*)(ws + WS_WLRU_IN), (float*)(ws + WS_SCL + SCL_LRU), n0, (LAS float*)F.lds, F.tid); }
        }
    }
    __syncthreads();
    if (F.bid < 192) {
        LAS float* sl = (LAS float*)F.lds;
        for (int i = F.tid; i < 9 * 1024; i += 512) { const int r = i >> 10, k = i & 1023; const float v = (r < 8) ? a.in[I_C][r * 1024 + k] : a.in[I_CCTX][k]; sl[i] = v / (1.0f + __expf(-v)); }
        __syncthreads();
        const int ks = F.gw / 96, cg = F.gw % 96, col4 = cg * 64 + F.lane, layer = col4 / 1536, c4 = (col4 % 1536) * 4;
        f32x4 acc[9];
#pragma unroll
        for (int r = 0; r < 9; ++r) acc[r] = (f32x4){0.f, 0.f, 0.f, 0.f};
        const float* wp = a.in[I_WADA] + (size_t)layer * 1024 * 6144 + (size_t)(ks * 64) * 6144 + c4;
#pragma unroll 4
        for (int k = 0; k < 64; ++k) { const f32x4 w = *(const f32x4*)(wp + (size_t)k * 6144);
#pragma unroll
            for (int r = 0; r < 9; ++r) { const float s = sl[r * 1024 + ks * 64 + k]; acc[r] += w * s; } }
        float* mp = (float*)(ws + WS_MODP) + ((size_t)(ks * 4 + layer) * 9) * 6144 + c4;
#pragma unroll
        for (int r = 0; r < 9; ++r) *(f32x4*)(mp + (size_t)r * 6144) = acc[r];
        __syncthreads();
    }
    const int gt = F.bid * 512 + F.tid, NGT = F.G * 512;
    for (int t = gt; t < 8192; t += NGT) {
        const int p = t & 63;
        const float dt = expf(a.in[I_S5LDT][t >> 6]);
        const float Ar = a.in[I_S5ARE][t], Ai = a.in[I_S5AIM][t];
        const float mag = expf(Ar * dt); float sn, cs; sincos_cw(Ai * dt, sn, cs);
        const float zr = mag * cs, zi = mag * sn, den = Ar * Ar + Ai * Ai;
        const float kr = ((zr - 1.0f) * Ar + zi * Ai) / den, ki = (zi * Ar - (zr - 1.0f) * Ai) / den;
        ((float*)(ws + WS_PAR + PAR_ZR))[t] = zr; ((float*)(ws + WS_PAR + PAR_ZI))[t] = zi;
#pragma unroll
        for (int n = 0; n < 16; ++n) { const float br = a.in[I_S5BRE][(size_t)t * 16 + n], bi = a.in[I_S5BIM][(size_t)t * 16 + n];
            ((float*)(ws + WS_PAR + PAR_BBR))[(size_t)t * 16 + n] = kr * br - ki * bi; ((float*)(ws + WS_PAR + PAR_BBI))[(size_t)t * 16 + n] = kr * bi + ki * br; }
        (void)p;
    }
    for (int t = gt; t < 8192 * 33; t += NGT) {
        const int sidx = t / 33, tau = t % 33; const float dt = expf(a.in[I_S5LDT][sidx >> 6]);
        const float Ar = a.in[I_S5ARE][sidx], Ai = a.in[I_S5AIM][sidx]; const float mag = expf((float)tau * (Ar * dt)); float sn, cs; sincos_cw((float)tau * (Ai * dt), sn, cs);
        ((f32x2*)(ws + WS_S5ZP))[t] = (f32x2){mag * cs, mag * sn};
    }
    for (int t = gt; t < 1024; t += NGT) {
        const int pos = t >> 4, j = t & 15; const float freq = exp2f(-(float)j * (13.287712379549449f / 16.0f)); float sn, cs; sincos_cw((float)pos * freq, sn, cs);
        ((f32x2*)(ws + WS_PAR + PAR_ROPE))[t] = (f32x2){cs, sn};
    }
    for (int t = gt; t < 2 * LRUW; t += NGT) ((float*)(ws + WS_PAR + PAR_SP))[t] = log1pf(expf(-a.in[I_LLAM][t]));
    for (int t = gt; t < 2 * 2 * 16 * 96 * 96; t += NGT) {
        const int d = t % 96, e = (t / 96) % 96, n = (t / 9216) % 16, mat = (t / (9216 * 16)) % 2, dir = t / (9216 * 32);
        float v = 0.f; if (d < 88 && e < 88) v = a.in[mat ? I_LWX : I_LWA][(((size_t)dir * 16 + n) * 88 + d) * 88 + e];
        ((bf16_t*)(ws + WS_BD))[t] = (bf16_t)f2bf(v);
    }
}
DI void p0b_modreduce(const Args& a, const Frame& F) {
    const int gt = F.bid * 512 + F.tid, NGT = F.G * 512;
    for (int t = gt; t < 4 * 9 * 1536; t += NGT) {
        const int c4 = (t % 1536) * 4, lr = t / 1536, layer = lr / 9;
        f32x4 s = *(const f32x4*)(a.in[I_BADA] + (size_t)layer * 6144 + c4);
#pragma unroll
        for (int ks = 0; ks < 16; ++ks) s += *(const f32x4*)((const float*)(a.ws + WS_MODP) + ((size_t)ks * 36 + lr) * 6144 + c4);
        *(f32x4*)((float*)(a.ws + WS_MOD) + (size_t)lr * 6144 + c4) = s;
    }
}
DI void s5_tables_a(const Args& a, const Frame& F) {
    const int gt = F.bid * 512 + F.tid, NGT = F.G * 512;
    const f32x2* ZP = (const f32x2*)(a.ws + WS_S5ZP); const float* BBR = (const float*)(a.ws + WS_PAR + PAR_BBR); const float* BBI = (const float*)(a.ws + WS_PAR + PAR_BBI);
    if (F.bid < 128) {
        const int g = F.bid >> 1, dir = F.bid & 1, gd = dir * 64 + g;
        LAS f32x2* zp = (LAS f32x2*)F.lds; LAS f32x2* cc = zp + 64 * 32; LAS f32x2* bb = cc + 16 * 64;
        for (int i = F.tid; i < 2048; i += 512) zp[i] = ZP[(gd * 64 + (i >> 5)) * 33 + (i & 31)];
        for (int i = F.tid; i < 1024; i += 512) cc[i] = (f32x2){a.in[I_S5CRE][(size_t)gd * 1024 + i], a.in[I_S5CIM][(size_t)gd * 1024 + i]};
        for (int i = F.tid; i < 1024; i += 512) bb[i] = (f32x2){BBR[(size_t)gd * 1024 + i], BBI[(size_t)gd * 1024 + i]};
        LDS_WAIT();
        __syncthreads();
        const int tau = F.tid >> 4, no = F.tid & 15;
        float acc[16];
#pragma unroll
        for (int ni = 0; ni < 16; ++ni) acc[ni] = 0.f;
        for (int p = 0; p < 64; ++p) {
            const f32x2 z = zp[p * 32 + tau], c = cc[no * 64 + p];
            const float wr = c.x * z.x - c.y * z.y, wi = c.x * z.y + c.y * z.x;
#pragma unroll
            for (int ni = 0; ni < 16; ++ni) { const f32x2 bv = bb[p * 16 + ni]; acc[ni] += wr * bv.x - wi * bv.y; }
        }
        float* kt = (float*)(a.ws + WS_S5KT) + ((((size_t)(g * 2 + dir) * 32 + tau) * 16 + no) * 16);
#pragma unroll
        for (int ni = 0; ni < 16; ++ni) kt[ni] = acc[ni];
        __syncthreads();
    }
    for (int t = gt; t < 64 * 8 * 32 * 64; t += NGT) {
        const int lane = t & 63, ks = (t >> 6) & 31, cb = (t >> 11) & 7, g = t >> 14;
        const int col = cb * 32 + (lane & 31), dir = col >> 7, reim = (col >> 6) & 1, p = col & 63, n0 = 8 * (lane >> 5);
        const int sidx = (dir * 64 + g) * 64 + p; const f32x2 z = ZP[sidx * 33 + (dir ? ks : 31 - ks)];
        float v[8];
#pragma unroll
        for (int j = 0; j < 8; ++j) { const float br = BBR[(size_t)sidx * 16 + n0 + j], bi = BBI[(size_t)sidx * 16 + n0 + j]; v[j] = reim ? (z.x * bi + z.y * br) : (z.x * br - z.y * bi); }
        u32x4 o; o.x = pk2(v[0], v[1]); o.y = pk2(v[2], v[3]); o.z = pk2(v[4], v[5]); o.w = pk2(v[6], v[7]);
        *(u32x4*)((bf16_t*)(a.ws + WS_S5W1) + (size_t)t * 8) = o;
    }
    for (int t = gt; t < 64 * 16 * 16 * 64; t += NGT) {
        const int lane = t & 63, ks = 32 + ((t >> 6) & 15), cb = (t >> 10) & 15, g = t >> 14;
        const int col = cb * 32 + (lane & 31), to = col >> 4, no = col & 15, kk0 = (ks - 32) * 16 + 8 * (lane >> 5), dir = kk0 >> 7, reim = (kk0 >> 6) & 1, p0 = kk0 & 63;
        float v[8];
#pragma unroll
        for (int j = 0; j < 8; ++j) { const int p = p0 + j; const int sidx = (dir * 64 + g) * 64 + p; const f32x2 z = ZP[sidx * 33 + (dir ? 32 - to : to + 1)];
            const float cr = a.in[I_S5CRE][((size_t)(dir * 64 + g) * 16 + no) * 64 + p], ci = a.in[I_S5CIM][((size_t)(dir * 64 + g) * 16 + no) * 64 + p];
            v[j] = reim ? -(cr * z.y + ci * z.x) : (cr * z.x - ci * z.y); }
        u32x4 o; o.x = pk2(v[0], v[1]); o.y = pk2(v[2], v[3]); o.z = pk2(v[4], v[5]); o.w = pk2(v[6], v[7]);
        *(u32x4*)((bf16_t*)(a.ws + WS_S5W2) + (((size_t)(g * 16 + cb) * 48 + ks) * 64 + lane) * 8) = o;
    }
}
DI void s5_tables_b(const Args& a, const Frame& F) {
    const int gt = F.bid * 512 + F.tid, NGT = F.G * 512;
    const float* KT = (const float*)(a.ws + WS_S5KT);
    for (int t = gt; t < 64 * 16 * 32 * 64; t += NGT) {
        const int lane = t & 63, ti = (t >> 6) & 31, cb = (t >> 11) & 15, g = t >> 15;
        const int col = cb * 32 + (lane & 31), to = col >> 4, no = col & 15, n0 = 8 * (lane >> 5);
        float v[8];
#pragma unroll
        for (int j = 0; j < 8; ++j) v[j] = 0.f;
        if (ti <= to) { const float* k0 = KT + ((((size_t)(g * 2 + 0) * 32 + (to - ti)) * 16 + no) * 16 + n0);
#pragma unroll
            for (int j = 0; j < 8; ++j) v[j] += k0[j]; }
        if (ti >= to) { const float* k1 = KT + ((((size_t)(g * 2 + 1) * 32 + (ti - to)) * 16 + no) * 16 + n0);
#pragma unroll
            for (int j = 0; j < 8; ++j) v[j] += k1[j]; }
        if (ti == to) {
#pragma unroll
            for (int j = 0; j < 8; ++j) if (n0 + j == no) v[j] += a.in[I_S5D][g * 16 + no]; }
        u32x4 o; o.x = pk2(v[0], v[1]); o.y = pk2(v[2], v[3]); o.z = pk2(v[4], v[5]); o.w = pk2(v[6], v[7]);
        *(u32x4*)((bf16_t*)(a.ws + WS_S5W2) + (((size_t)(g * 16 + cb) * 48 + ti) * 64 + lane) * 8) = o;
    }
}
DI const float* mod_row(const Args& a, int li, int row) { const int p = row % LSEQ, b = row / LSEQ; return (const float*)(a.ws + WS_MOD) + (size_t)(li * 9 + (p < CN ? 8 : b)) * 6144; }
DI void store_h(bf16_t* hrow, int lane, const f32x4 (&v)[4]) {
#pragma unroll
    for (int j = 0; j < 4; ++j) { u32x2 w; w.x = pk2(v[j][0], v[j][1]); w.y = pk2(v[j][2], v[j][3]); *(u32x2*)(hrow + 4 * lane + 256 * j) = w; }
}
DI void p1_init(const Args& a, const Frame& F) {
    float* X = (float*)(a.ws + WS_X); signed char* H = (signed char*)(a.ws + WS_H); float* SA = (float*)(a.ws + WS_SCL + SCL_SA);
    for (int row = F.gw; row < MROWS; row += F.NGW) {
        const int b = row / LSEQ, p = row % LSEQ;
        const float* src = (p < CN) ? a.in[I_CTX] + ((size_t)b * CN + p) * D : a.in[I_X] + ((size_t)b * TL + (p - CN)) * D;
        const float* mr = mod_row(a, 0, row);
        f32x4 v[4], h[4];
#pragma unroll
        for (int j = 0; j < 4; ++j) { const int c = 4 * F.lane + 256 * j; v[j] = *(const f32x4*)(src + c); const f32x4 sh = *(const f32x4*)(mr + c), sc = *(const f32x4*)(mr + 1024 + c);
            h[j] = v[j] * (sc + 1.0f) + sh; *(f32x4*)(X + (size_t)row * D + c) = v[j]; }
        store_h8(H + (size_t)row * D, SA + row, F.lane, h);
    }
}
DI void ln_row(f32x4 (&v)[4], const float* g, const float* bta, int lane) {
    float s = 0.f;
#pragma unroll
    for (int j = 0; j < 4; ++j) s += (v[j][0] + v[j][1]) + (v[j][2] + v[j][3]);
    const float mean = wave_sum(s) * (1.0f / D); float q = 0.f;
#pragma unroll
    for (int j = 0; j < 4; ++j) { v[j] = v[j] - mean; q += (v[j][0] * v[j][0] + v[j][1] * v[j][1]) + (v[j][2] * v[j][2] + v[j][3] * v[j][3]); }
    const float rstd = 1.0f / sqrtf(wave_sum(q) * (1.0f / D) + LN_EPS);
#pragma unroll
    for (int j = 0; j < 4; ++j) { const int c = 4 * lane + 256 * j; v[j] = v[j] * rstd * *(const f32x4*)(g + c) + *(const f32x4*)(bta + c); }
}


constexpr int RG = 3;
DI void wave_sum_n(float (&v)[RG]) {
#pragma unroll
    for (int o = 1; o < 64; o <<= 1) {
#pragma unroll
        for (int k = 0; k < RG; ++k) v[k] += __shfl_xor(v[k], o); }
}
DI void wave_max_n(float (&v)[RG]) {
#pragma unroll
    for (int o = 1; o < 64; o <<= 1) {
#pragma unroll
        for (int k = 0; k < RG; ++k) v[k] = fmaxf(v[k], __shfl_xor(v[k], o)); }
}
DI void ln_rows(f32x4 (&v)[RG][4], const float* g, const float* bta, int lane) {
    float s[RG], q[RG];
#pragma unroll
    for (int k = 0; k < RG; ++k) { s[k] = 0.f;
#pragma unroll
        for (int j = 0; j < 4; ++j) s[k] += (v[k][j][0] + v[k][j][1]) + (v[k][j][2] + v[k][j][3]); }
    wave_sum_n(s);
#pragma unroll
    for (int k = 0; k < RG; ++k) { const float mean = s[k] * (1.0f / D); q[k] = 0.f;
#pragma unroll
        for (int j = 0; j < 4; ++j) { v[k][j] = v[k][j] - mean; q[k] += (v[k][j][0] * v[k][j][0] + v[k][j][1] * v[k][j][1]) + (v[k][j][2] * v[k][j][2] + v[k][j][3] * v[k][j][3]); } }
    wave_sum_n(q);
#pragma unroll
    for (int j = 0; j < 4; ++j) { const int c = 4 * lane + 256 * j; const f32x4 gg = *(const f32x4*)(g + c), bb = *(const f32x4*)(bta + c);
#pragma unroll
        for (int k = 0; k < RG; ++k) { const float rstd = 1.0f / sqrtf(q[k] * (1.0f / D) + LN_EPS); v[k][j] = v[k][j] * rstd * gg + bb; } }
}
DI void store_h8_rows(signed char* H, float* SA, const int (&row)[RG], const bool (&ok)[RG], int lane, const f32x4 (&h)[RG][4]) {
    float m[RG];
#pragma unroll
    for (int k = 0; k < RG; ++k) { m[k] = 0.f;
#pragma unroll
        for (int j = 0; j < 4; ++j) m[k] = fmaxf(m[k], fmaxf(fmaxf(fabsf(h[k][j][0]), fabsf(h[k][j][1])), fmaxf(fabsf(h[k][j][2]), fabsf(h[k][j][3])))); }
    wave_max_n(m);
#pragma unroll
    for (int k = 0; k < RG; ++k) { if (!ok[k]) continue; const float inv = m[k] > 0.f ? 127.0f / m[k] : 0.f;
#pragma unroll
        for (int j = 0; j < 4; ++j) *(unsigned*)(H + (size_t)row[k] * D + 4 * lane + 256 * j) = pack4_i8(h[k][j], inv);
        if (lane == 0) SA[row[k]] = m[k] * (1.0f / 127.0f); }
}
DI void m0_route(const Args& a, const Frame& F, int li) {
    bg_catch_up(a, F, li);
    __syncthreads();
    LAS float* rw = (LAS float*)F.lds;
    LAS int* lcnt = (LAS int*)(F.lds + 65536);
    LAS int* rinfo = (LAS int*)(F.lds + 65536 + 256);
    LAS float* rwt = (LAS float*)(F.lds + 65536 + 256 + 8 * 9 * 16);
    for (int i = F.tid; i < 16 * 1024; i += 512) { const int k = i >> 4, e = i & 15; rw[e * 1024 + k] = a.in[I_RW][i]; }
    if (F.tid < 32) lcnt[F.tid] = 0;
    __syncthreads();
    float* X = (float*)(a.ws + WS_X); signed char* H = (signed char*)(a.ws + WS_H); float* SA = (float*)(a.ws + WS_SCL + SCL_SA);
    const float* lg = a.in[I_LNG] + (size_t)(li * 2 + 0) * D; const float* lb = a.in[I_LNB] + (size_t)(li * 2 + 0) * D;
    const int NR = (li == DEPTH - 1) ? NB * TL : MROWS;
#define ROW_OF(lr) ((li == DEPTH - 1) ? ((lr) / TL) * LSEQ + CN + (lr) % TL : (lr))
    int nrows = 0;
    for (int base = F.gw; base < NR; base += RG * F.NGW) {
        int row[RG]; bool ok[RG]; f32x4 v[RG][4];
#pragma unroll
        for (int k = 0; k < RG; ++k) { const int lr = base + k * F.NGW; ok[k] = lr < NR; row[k] = ROW_OF(ok[k] ? lr : base);
#pragma unroll
            for (int j = 0; j < 4; ++j) v[k][j] = *(const f32x4*)(X + (size_t)row[k] * D + 4 * F.lane + 256 * j); }
        ln_rows(v, lg, lb, F.lane);
#pragma unroll
        for (int k = 0; k < RG; ++k) { const float* mr = mod_row(a, li, row[k]);
#pragma unroll
            for (int j = 0; j < 4; ++j) { const int c = 4 * F.lane + 256 * j; if (ok[k]) *(f32x4*)(X + (size_t)row[k] * D + c) = v[k][j]; const f32x4 sh = *(const f32x4*)(mr + 3072 + c), sc = *(const f32x4*)(mr + 4096 + c); v[k][j] = v[k][j] * (sc + 1.0f) + sh; } }
        store_h8_rows(H, SA, row, ok, F.lane, v);
        float partn[RG][16];
#pragma unroll
        for (int e = 0; e < 16; ++e) {
            float sacc[RG];
#pragma unroll
            for (int k = 0; k < RG; ++k) sacc[k] = 0.f;
#pragma unroll
            for (int j = 0; j < 4; ++j) { const f32x4 w = *(const LAS f32x4*)(rw + e * 1024 + 4 * F.lane + 256 * j);
#pragma unroll
                for (int k = 0; k < RG; ++k) sacc[k] += (v[k][j][0] * w[0] + v[k][j][1] * w[1]) + (v[k][j][2] * w[2] + v[k][j][3] * w[3]); }
#pragma unroll
            for (int k = 0; k < RG; ++k) partn[k][e] = sacc[k];
        }
        float lgn[RG];
        {   const int b5 = F.lane & 32, b4 = F.lane & 16, b3 = F.lane & 8, b2 = F.lane & 4;
#pragma unroll
            for (int k = 0; k < RG; ++k) {
                float v8[8], v4[4], v2[2];
#pragma unroll
                for (int q = 0; q < 8; ++q) { const float send = b5 ? partn[k][q] : partn[k][q + 8], keep = b5 ? partn[k][q + 8] : partn[k][q]; v8[q] = keep + __shfl_xor(send, 32); }
#pragma unroll
                for (int q = 0; q < 4; ++q) { const float send = b4 ? v8[q] : v8[q + 4], keep = b4 ? v8[q + 4] : v8[q]; v4[q] = keep + __shfl_xor(send, 16); }
#pragma unroll
                for (int q = 0; q < 2; ++q) { const float send = b3 ? v4[q] : v4[q + 2], keep = b3 ? v4[q + 2] : v4[q]; v2[q] = keep + __shfl_xor(send, 8); }
                float v1; { const float send = b2 ? v2[0] : v2[1], keep = b2 ? v2[1] : v2[0]; v1 = keep + __shfl_xor(send, 4); }
                v1 += __shfl_xor(v1, 1); v1 += __shfl_xor(v1, 2);
                lgn[k] = v1;
            }
        }
#pragma unroll 1
        for (int k = 0; k < RG; ++k) {
            if (!ok[k]) continue;
            const float v1 = (k == 0) ? lgn[0] : (k == 1) ? lgn[1] : lgn[2];
            float lg16[16];
#pragma unroll
            for (int e = 0; e < 16; ++e) lg16[e] = __shfl(v1, e * 4);
            float mx = lg16[0];
#pragma unroll
            for (int e = 1; e < 16; ++e) mx = fmaxf(mx, lg16[e]);
            float pr[16], sum = 0.f;
#pragma unroll
            for (int e = 0; e < 16; ++e) { pr[e] = __expf(lg16[e] - mx); sum += pr[e]; }
            const float inv = 1.0f / sum;
            float bestg = -3.0e38f; int e1 = 0, e2 = 1; float p1 = 0.f, p2 = 0.f;
#pragma unroll
            for (int g = 0; g < 4; ++g) {
                float b1 = -3.0e38f, b2 = -3.0e38f; int i1 = 0, i2 = 0; float q1 = 0.f, q2 = 0.f;
#pragma unroll
                for (int q = 0; q < 4; ++q) { const float p = pr[4 * g + q] * inv; const float sv = p + a.in[I_RB][4 * g + q];
                    if (sv > b1) { b2 = b1; i2 = i1; q2 = q1; b1 = sv; i1 = 4 * g + q; q1 = p; } else if (sv > b2) { b2 = sv; i2 = 4 * g + q; q2 = p; } }
                const float gs = b1 + b2;
                if (gs > bestg) { bestg = gs; e1 = i1; e2 = i2; p1 = q1; p2 = q2; }
            }
            const float wn = 1.0f / (p1 + p2);
            const int ri_idx = F.wave * 9 + nrows + k;
            if (F.lane == 0) { const int lp1 = atomicAdd((int*)&lcnt[e1], 1), lp2 = atomicAdd((int*)&lcnt[e2], 1);
                LAS int* ri = rinfo + ri_idx * 4; ri[0] = e1; ri[1] = lp1; ri[2] = e2; ri[3] = lp2;
                rwt[ri_idx * 2 + 0] = p1 * wn; rwt[ri_idx * 2 + 1] = p2 * wn; }
        }
        nrows += RG;
    }
    LDS_WAIT();
    __syncthreads();
    if (F.tid < 16) lcnt[16 + F.tid] = (int)__hip_atomic_fetch_add((unsigned*)(a.ws + WS_CTL) + CW_CNT + (li * 16 + F.tid) * 64, (unsigned)lcnt[F.tid], RLX_AGENT);
    LDS_WAIT();
    __syncthreads();
    if (F.lane == 0) {
        unsigned* tok = (unsigned*)(a.ws + WS_TOK); int* lists = (int*)(a.ws + WS_TOK + MiB);
        int k = 0;
        for (int lr = F.gw; lr < NR; lr += F.NGW, ++k) {
            const int row = ROW_OF(lr);
            const LAS int* ri = rinfo + (F.wave * 9 + k) * 4; const int e1 = ri[0], e2 = ri[2]; const int pos1 = lcnt[16 + e1] + ri[1], pos2 = lcnt[16 + e2] + ri[3];
            lists[(size_t)e1 * MROWS + pos1] = row; lists[(size_t)e2 * MROWS + pos2] = row;
            u32x4 w0; w0.x = (unsigned)e1; w0.y = (unsigned)pos1; w0.z = (unsigned)e2; w0.w = (unsigned)pos2;
            *(u32x4*)(tok + (size_t)row * 8) = w0; tok[(size_t)row * 8 + 4] = __float_as_uint(rwt[(F.wave * 9 + k) * 2]); tok[(size_t)row * 8 + 5] = __float_as_uint(rwt[(F.wave * 9 + k) * 2 + 1]);
        }
    }
#undef ROW_OF
}
DI int moe_tile_table(const Args& a, const Frame& F, int li) {
    LAS int* tb = (LAS int*)(F.lds + TB_OFF);
    if (F.tid < 64) {
        int c = 0; if (F.lane < 16) c = (int)__hip_atomic_load((unsigned*)(a.ws + WS_CTL) + CW_CNT + (li * 16 + F.lane) * 64, RLX_AGENT);
        const int nt = (c + 255) >> 8; int inc = nt;
#pragma unroll
        for (int o = 1; o < 16; o <<= 1) { const int t = __shfl_up(inc, o); if (F.lane >= o) inc += t; }
        if (F.lane < 16) { tb[F.lane] = inc - nt; tb[32 + F.lane] = c; }
        if (F.lane == 15) tb[16] = inc;
    }
    LDS_WAIT();
    __syncthreads();
    return tb[16];
}
DI void m1_gateup(const Args& a, const Frame& F, int li) {
    const int NT = moe_tile_table(a, F, li);
    LAS int* tb = (LAS int*)(F.lds + TB_OFF); LAS unsigned* tab = (LAS unsigned*)(F.lds + TAB_OFF);
    pg8::MoeSched<true, 8> S; S.A = (const char*)(a.ws + WS_H); S.Bt = (const char*)(a.ws + WS_MOEW + (size_t)li * 64 * MiB); S.tb = tb; S.tab = tab; S.NT = NT; S.G = F.G; S.c = F.bid; S.tid = F.tid; S.Kb = 1024; S.estride = (size_t)2048 * 1024;
    LAS float* tabs = (LAS float*)(F.lds + TABS_OFF); const float* SA = (const float*)(a.ws + WS_SCL + SCL_SA);
    const int* lists = (const int*)(a.ws + WS_TOK + MiB);
    pg8::Unit u;
    for (int i = 0; i < 8 && S.next(i, u); ++i) {
        if (F.tid < 256) { const int cnt = tb[32 + u.e], idx = (u.pm - tb[u.e]) * 256 + F.tid; const int tokr = lists[(size_t)u.e * MROWS + (idx < cnt ? idx : 0)]; tab[i * 256 + F.tid] = (unsigned)tokr * 1024u; tabs[i * 256 + F.tid] = SA[tokr]; }
    }
    LDS_WAIT();
    __syncthreads();
    pg8::EpiSwiGLUS E{(bf16_t*)(a.ws + WS_HID), tabs, (const float*)(a.ws + WS_SCL + SCL_GU + (size_t)li * 131072)};
    pg8::gemm_phase<pg8::EpiSwiGLUS, pg8::MoeSched<true, 8>, true>(F.lds, 1024, S, E, F.tid);
    bg_tail(a, F, NT * 8, 8 + li);
}
DI void m2_down(const Args& a, const Frame& F, int li) {
    const int NT = moe_tile_table(a, F, li);
    LAS int* tb = (LAS int*)(F.lds + TB_OFF);
    pg8::MoeSched<false, 4> S; S.A = (const char*)(a.ws + WS_HID); S.Bt = (const char*)(a.ws + WS_MOEW + (size_t)li * 64 * MiB + 32 * MiB); S.tb = tb; S.tab = nullptr; S.NT = NT; S.G = F.G; S.c = F.bid; S.tid = F.tid; S.Kb = 2048; S.estride = (size_t)1024 * 1024 * 2;
    pg8::EpiBf16 E{(bf16_t*)(a.ws + WS_YEXP), 1024, 0, 0};
    pg8::gemm_phase<pg8::EpiBf16, pg8::MoeSched<false, 4>>(F.lds, 2048, S, E, F.tid);
    bg_tail(a, F, NT * 4, 12 + li);
}
DI void m3_combine(const Args& a, const Frame& F, int li) {
    (void)moe_tile_table(a, F, li);
    const LAS int* tb = (const LAS int*)(F.lds + TB_OFF);
    float* X = (float*)(a.ws + WS_X); signed char* H = (signed char*)(a.ws + WS_H); float* SA = (float*)(a.ws + WS_SCL + SCL_SA); const bf16_t* Y = (const bf16_t*)(a.ws + WS_YEXP);
    const unsigned* tok = (const unsigned*)(a.ws + WS_TOK);
    const float* lg = a.in[I_LNG] + (size_t)(li * 2 + 1) * D; const float* lb = a.in[I_LNB] + (size_t)(li * 2 + 1) * D;
    const int NR = (li == DEPTH - 1) ? NB * TL : MROWS;
    for (int base = F.gw; base < NR; base += RG * F.NGW) {
        int row[RG]; bool ok[RG]; u32x4 t0[RG]; float w1[RG], w2[RG]; f32x4 v[RG][4];
#pragma unroll
        for (int k = 0; k < RG; ++k) { const int lr = base + k * F.NGW; ok[k] = lr < NR; const int lq = ok[k] ? lr : base; row[k] = (li == DEPTH - 1) ? (lq / TL) * LSEQ + CN + lq % TL : lq;
            t0[k] = *(const u32x4*)(tok + (size_t)row[k] * 8); w1[k] = __uint_as_float(tok[(size_t)row[k] * 8 + 4]); w2[k] = __uint_as_float(tok[(size_t)row[k] * 8 + 5]); }
#pragma unroll
        for (int k = 0; k < RG; ++k)
#pragma unroll
            for (int j = 0; j < 4; ++j) v[k][j] = *(const f32x4*)(X + (size_t)row[k] * D + 4 * F.lane + 256 * j);
        u32x2 y1[RG][4], y2[RG][4]; f32x4 g2[RG][4];
#pragma unroll
        for (int k = 0; k < RG; ++k) { const int e1 = __builtin_amdgcn_readfirstlane((int)t0[k].x), e2 = __builtin_amdgcn_readfirstlane((int)t0[k].z);
            const size_t s1 = (size_t)tb[e1] * 256 + t0[k].y, s2 = (size_t)tb[e2] * 256 + t0[k].w; const float* mr = mod_row(a, li, row[k]);
#pragma unroll
            for (int j = 0; j < 4; ++j) { const int c = 4 * F.lane + 256 * j; y1[k][j] = *(const u32x2*)(Y + s1 * 1024 + c); y2[k][j] = *(const u32x2*)(Y + s2 * 1024 + c); g2[k][j] = *(const f32x4*)(mr + 5120 + c); } }
#pragma unroll
        for (int k = 0; k < RG; ++k)
#pragma unroll
            for (int j = 0; j < 4; ++j) { f32x4 y; y[0] = w1[k] * bflo(y1[k][j].x) + w2[k] * bflo(y2[k][j].x); y[1] = w1[k] * bfhi(y1[k][j].x) + w2[k] * bfhi(y2[k][j].x);
                y[2] = w1[k] * bflo(y1[k][j].y) + w2[k] * bflo(y2[k][j].y); y[3] = w1[k] * bfhi(y1[k][j].y) + w2[k] * bfhi(y2[k][j].y);
                v[k][j] = v[k][j] * DN_ALPHA + g2[k][j] * y; }
        ln_rows(v, lg, lb, F.lane);
        if (li < DEPTH - 1) {
#pragma unroll
            for (int k = 0; k < RG; ++k) { const float* mn = mod_row(a, li + 1, row[k]);
#pragma unroll
                for (int j = 0; j < 4; ++j) { const int c = 4 * F.lane + 256 * j; if (ok[k]) *(f32x4*)(X + (size_t)row[k] * D + c) = v[k][j]; const f32x4 sh = *(const f32x4*)(mn + c), sc = *(const f32x4*)(mn + 1024 + c); v[k][j] = v[k][j] * (sc + 1.0f) + sh; } }
            store_h8_rows(H, SA, row, ok, F.lane, v);
        } else {
#pragma unroll
            for (int k = 0; k < RG; ++k) { const int b = row[k] / LSEQ, p = row[k] % LSEQ;
                if (ok[k] && p >= CN) { float* o = a.out + ((size_t)b * TL + (p - CN)) * D;
#pragma unroll
                    for (int j = 0; j < 4; ++j) *(f32x4*)(o + 4 * F.lane + 256 * j) = v[k][j]; } }
        }
    }
}

DI void a1_qkv(const Args& a, const Frame& F, int slot) {
    pg8::DenseSched S; S.init(a.ws + WS_H, a.ws + WS_WATT_IN + (size_t)slot * 3072 * 1024, MROWS, 3072, 1024, F.G, F.bid, F.tid);
    pg8::EpiBf16S E{(bf16_t*)(a.ws + MX_Q), 1024, 1024, (size_t)MROWS * 1024, (const float*)(a.ws + WS_SCL + SCL_SA), (const float*)(a.ws + WS_SCL + SCL_ATT) + slot * 3072, (const f32x2*)(a.ws + WS_PAR + PAR_ROPE)};
    pg8::gemm_phase<pg8::EpiBf16S, pg8::DenseSched, true>(F.lds, 1024, S, E, F.tid);
    bg_tail(a, F, S.nwg, slot);
}
DI void a1b_rope(const Args& a, const Frame& F) {
    const f32x2* tabl = (const f32x2*)(a.ws + WS_PAR + PAR_ROPE);
    const int quarter = F.lane & 3, colb = (F.lane >> 2) * 64 + quarter * 16;
    for (int it = F.gw; it < 2 * NB * TL; it += F.NGW) {
        const int which = it & 1, lr = it >> 1, b = lr / TL, t = lr % TL;
        bf16_t* p = (bf16_t*)(a.ws + (which ? MX_K : MX_Q)) + ((size_t)b * LSEQ + CN + t) * 1024 + colb;
        const int pos = (quarter < 2) ? (t >> 6) : (t & 63);
        u32x4 w0 = *(const u32x4*)p, w1 = *(const u32x4*)(p + 8);
        unsigned wi[8] = {w0.x, w0.y, w0.z, w0.w, w1.x, w1.y, w1.z, w1.w}; unsigned wo[8];
#pragma unroll
        for (int q = 0; q < 8; ++q) {
            const float m0 = bflo(wi[q]), m1 = bfhi(wi[q]);
            const float o0 = __shfl_xor(m0, 1), o1 = __shfl_xor(m1, 1);
            const f32x2 cs0 = tabl[pos * 16 + 2 * q], cs1 = tabl[pos * 16 + 2 * q + 1];
            const float sg = (quarter & 1) ? 1.0f : -1.0f;
            wo[q] = pk2(m0 * cs0.x + sg * o0 * cs0.y, m1 * cs1.x + sg * o1 * cs1.y);
        }
        *(u32x4*)p = (u32x4){wo[0], wo[1], wo[2], wo[3]}; *(u32x4*)(p + 8) = (u32x4){wo[4], wo[5], wo[6], wo[7]};
    }
}
DI void a2_attention(const Args& a, const Frame& F, int li, int slot) {
    const float lam_init = (li == 0) ? 0.2f : 0.55605820415562f;
    const float* lm = a.in[I_ALAM] + (size_t)slot * 4 * 64;
    const float s0 = wave_sum(lm[F.lane] * lm[64 + F.lane]), s1 = wave_sum(lm[128 + F.lane] * lm[192 + F.lane]);
    const float lamf = expf(s0) - expf(s1) + lam_init;
    const bf16_t* Q = (const bf16_t*)(a.ws + MX_Q); const bf16_t* K = (const bf16_t*)(a.ws + MX_K); const bf16_t* V = (const bf16_t*)(a.ws + MX_V); bf16_t* AO = (bf16_t*)(a.ws + MX_AO);
    const float* subg = a.in[I_ASUB] + (size_t)slot * 128;
    const int v = (F.G % 8 == 0) ? (F.bid % 8) * (F.G / 8) + F.bid / 8 : F.bid;
    for (int u = v; u < (li == DEPTH - 1 ? 1024 : 1024 + 128); u += F.G) {
        int b, h, row0, seq;
        if (u < 1024) { const int bh = u >> 4, qb = u & 15; b = bh >> 3; h = bh & 7; row0 = b * LSEQ + CN + qb * 128; seq = LSEQ; }
        else { const int w = u - 1024, bh = w >> 1, qb = w & 1; b = bh >> 3; h = bh & 7; row0 = b * LSEQ + qb * 128; seq = CN; }
        att::attn_unit(Q + (size_t)row0 * 1024, K + (size_t)b * LSEQ * 1024, V + (size_t)b * LSEQ * 1024, AO + (size_t)row0 * 1024, h, seq, lamf, 1.0f - lam_init, subg, (LAS char*)F.lds, F.tid);
    }
}
DI void a3_wout(const Args& a, const Frame& F, int li, int slot) {
    pg8::DenseSched S; S.init(a.ws + MX_AO, a.ws + WS_WATT_OUT + (size_t)slot * 1024 * 1024 * 2, MROWS, 1024, 2048, F.G, F.bid, F.tid, li == DEPTH - 1);
    pg8::EpiResid E{(float*)(a.ws + WS_X), (const float*)(a.ws + WS_MOD) + (size_t)li * 9 * 6144 + 2048};
    pg8::gemm_phase<pg8::EpiResid, pg8::DenseSched>(F.lds, 2048, S, E, F.tid);
    bg_tail(a, F, S.nwg, 2 + slot);
}

DI void s1_win(const Args& a, const Frame& F) {
    pg8::DenseSched S; S.init(a.ws + WS_H, a.ws + WS_WS5_IN, MROWS, 1024, 1024, F.G, F.bid, F.tid);
    pg8::EpiBf16S E{(bf16_t*)(a.ws + MX_U), 1024, 0, 0, (const float*)(a.ws + WS_SCL + SCL_SA), (const float*)(a.ws + WS_SCL + SCL_S5), nullptr};
    pg8::gemm_phase<pg8::EpiBf16S, pg8::DenseSched, true>(F.lds, 1024, S, E, F.tid);
    bg_tail(a, F, S.nwg, 4);
}
template <int MODE> DI void s5_mm(const Args& a, const Frame& F) {
    constexpr int KS = MODE == 1 ? 32 : 48, NCB = MODE == 1 ? 1 : 2, NCBT = 8 * NCB, LDA = KS * 16 + 8;
    LAS bf16_t* At = (LAS bf16_t*)F.lds;
    const bf16_t* Ub = (const bf16_t*)(a.ws + MX_U); const bf16_t* Hin = (const bf16_t*)(a.ws + MX_HIN);
    const bf16_t* Wf = (const bf16_t*)(a.ws + (MODE == 1 ? WS_S5W1 : WS_S5W2));
    const int r32 = F.lane & 31, hh = F.lane >> 5;
    const int v = (F.G % 8 == 0) ? (F.bid % 8) * (F.G / 8) + F.bid / 8 : F.bid;
    for (int u = v; u < 576; u += F.G) {
        const int g = u / 9, rt = u % 9;
        for (int idx = F.tid; idx < 4096; idx += 512) { const int i = idx >> 6, rem = idx & 63, t = rem >> 1, nh = rem & 1, r = rt * 64 + i, b = r / 72, c = r % 72;
            const u32x4 w = *(const u32x4*)(Ub + ((size_t)(b * LSEQ + c * 32 + t) * 1024 + g * 16 + nh * 8)); *(LAS u32x4*)(At + i * LDA + t * 16 + nh * 8) = w; }
        if (MODE == 2) {
            for (int idx = F.tid; idx < 2048; idx += 512) { const int i = idx >> 5, q = idx & 31, r = rt * 64 + i;
                const u32x4 w = *(const u32x4*)(Hin + ((size_t)r * 64 + g) * 256 + q * 8); *(LAS u32x4*)(At + i * LDA + 512 + q * 8) = w; }
        }
        LDS_WAIT();
        __syncthreads();
        f32x16 acc[2][NCB];
#pragma unroll
        for (int rb = 0; rb < 2; ++rb)
#pragma unroll
            for (int cb = 0; cb < NCB; ++cb) acc[rb][cb] = f32x16{};
        const bf16_t* wb = Wf + ((size_t)(g * NCBT + F.wave * NCB) * KS) * 512 + F.lane * 8;
        bf16x8 bq[4][NCB], bn[4][NCB];
#pragma unroll
        for (int q = 0; q < 4; ++q)
#pragma unroll
            for (int cb = 0; cb < NCB; ++cb) bq[q][cb] = *(const bf16x8*)(wb + ((size_t)cb * KS + q) * 512);
        for (int k0 = 0; k0 < KS; k0 += 4) {
            if (k0 + 4 < KS) {
#pragma unroll
                for (int q = 0; q < 4; ++q)
#pragma unroll
                    for (int cb = 0; cb < NCB; ++cb) bn[q][cb] = *(const bf16x8*)(wb + ((size_t)cb * KS + k0 + 4 + q) * 512);
            }
#pragma unroll
            for (int q = 0; q < 4; ++q) {
                const bf16x8 a0 = *(const LAS bf16x8*)(At + r32 * LDA + (k0 + q) * 16 + 8 * hh), a1 = *(const LAS bf16x8*)(At + (32 + r32) * LDA + (k0 + q) * 16 + 8 * hh);
#pragma unroll
                for (int cb = 0; cb < NCB; ++cb) { acc[0][cb] = __builtin_amdgcn_mfma_f32_32x32x16_bf16(a0, bq[q][cb], acc[0][cb], 0, 0, 0); acc[1][cb] = __builtin_amdgcn_mfma_f32_32x32x16_bf16(a1, bq[q][cb], acc[1][cb], 0, 0, 0); }
            }
#pragma unroll
            for (int q = 0; q < 4; ++q)
#pragma unroll
                for (int cb = 0; cb < NCB; ++cb) bq[q][cb] = bn[q][cb];
        }
#pragma unroll
        for (int rb = 0; rb < 2; ++rb)
#pragma unroll
            for (int reg = 0; reg < 16; ++reg) {
                const int r = rt * 64 + rb * 32 + att::crow(reg, hh);
                if (MODE == 1) { float* E = (float*)(a.ws + MX_E); E[((size_t)r * 64 + g) * 256 + F.wave * 32 + r32] = acc[rb][0][reg]; }
                else { const int b = r / 72, c = r % 72; bf16_t* Gb = (bf16_t*)(a.ws + MX_G);
#pragma unroll
                    for (int cb = 0; cb < NCB; ++cb) { const int col = (F.wave * NCB + cb) * 32 + r32, to = col >> 4, no = col & 15;
                        Gb[(size_t)(b * LSEQ + c * 32 + to) * 1024 + g * 16 + no] = (bf16_t)f2bf(gelu_tanh(acc[rb][cb][reg])); } }
            }
        __syncthreads();
    }
}
DI void s5_carry(const Args& a, const Frame& F) {
    const int gt = F.bid * 512 + F.tid; if (gt >= 65536) return;
    const int p = gt & 63, dir = (gt >> 6) & 1, g = (gt >> 7) & 63, b = gt >> 13;
    const f32x2 z32 = ((const f32x2*)(a.ws + WS_S5ZP))[((dir * 64 + g) * 64 + p) * 33 + 32];
    const float* E = (const float*)(a.ws + MX_E); bf16_t* Hin = (bf16_t*)(a.ws + MX_HIN);
    float hr = 0.f, hi = 0.f;
#define S5_CH(s) (dir ? ((s) < 8 ? 7 - (s) : 79 - (s)) : (s))
    for (int s0 = 0; s0 < 72; s0 += 8) {
        float er[8], ei[8];
#pragma unroll
        for (int q = 0; q < 8; ++q) { const size_t idx = ((size_t)(b * 72 + S5_CH(s0 + q)) * 64 + g) * 256 + dir * 128 + p; er[q] = E[idx]; ei[q] = E[idx + 64]; }
#pragma unroll
        for (int q = 0; q < 8; ++q) { const size_t idx = ((size_t)(b * 72 + S5_CH(s0 + q)) * 64 + g) * 256 + dir * 128 + p;
            Hin[idx] = (bf16_t)f2bf(hr); Hin[idx + 64] = (bf16_t)f2bf(hi);
            const float nr = z32.x * hr - z32.y * hi + er[q], ni = z32.x * hi + z32.y * hr + ei[q]; hr = nr; hi = ni; }
    }
#undef S5_CH
}
DI void s3_glu(const Args& a, const Frame& F, int li) {
    pg8::DenseSched S; S.init(a.ws + MX_G, a.ws + WS_WS5_GLU, MROWS, 2048, 2048, F.G, F.bid, F.tid);
    pg8::EpiGluResid E{(float*)(a.ws + WS_X), (const float*)(a.ws + WS_MOD) + (size_t)li * 9 * 6144 + 2048};
    pg8::gemm_phase<pg8::EpiGluResid, pg8::DenseSched>(F.lds, 2048, S, E, F.tid);
    bg_tail(a, F, S.nwg, 5);
}

DI void l1_win(const Args& a, const Frame& F) {
    pg8::DenseSched S; S.init(a.ws + WS_H, a.ws + WS_WLRU_IN, MROWS, 2816, 1024, F.G, F.bid, F.tid);
    pg8::EpiBf16S E{(bf16_t*)(a.ws + MX_UG), 2816, 0, 0, (const float*)(a.ws + WS_SCL + SCL_SA), (const float*)(a.ws + WS_SCL + SCL_LRU), nullptr};
    pg8::gemm_phase<pg8::EpiBf16S, pg8::DenseSched, true>(F.lds, 1024, S, E, F.tid);
    bg_tail(a, F, S.nwg, 6);
}
template <int PASS> DI void lru_tiles(const Args& a, const Frame& F) {
    constexpr int UNR = (PASS == 1) ? 2 : 1;
    const int half = F.wave >> 2, wq = F.wave & 3, dir = wq >> 1, nbh = wq & 1, ht = F.tid & 255;
    LAS unsigned char* ub = F.lds + half * 58368;
    LAS bf16_t* XB = (LAS bf16_t*)ub;
    LAS float* HS = (LAS float*)(ub + 13312);
    LAS bf16_t* RAW = (LAS bf16_t*)(ub + 13312);
    const bf16_t* Ug = (const bf16_t*)(a.ws + MX_UG); const bf16_t* BD = (const bf16_t*)(a.ws + WS_BD);
    const float* SP = (const float*)(a.ws + WS_PAR + PAR_SP);
    f32x2* SUMM = (f32x2*)(a.ws + MX_SUMM); const float* CARRY = (const float*)(a.ws + MX_CARRY); bf16_t* A2 = (bf16_t*)(a.ws + MX_A2);
    const int fr = F.lane & 15, fq = F.lane >> 4;
    const int src1 = dir ? F.lane + 16 : F.lane - 16, src2 = dir ? F.lane + 32 : F.lane - 32, lastl = dir ? fr : fr + 48;
    const bool val1 = dir ? (fq <= 2) : (fq >= 1), val2 = dir ? (fq <= 1) : (fq >= 2);
    const int slot = F.bid * 2 + half, n = slot & 15, rc0 = slot >> 4, nslots16 = (F.G * 2) >> 4;
#define LRU_LOADW(dst, nbi_) do { _Pragma("unroll") for (int mat = 0; mat < 2; ++mat) _Pragma("unroll") for (int ks = 0; ks < 3; ++ks) \
        dst[mat][ks] = *(const bf16x8*)(BD + ((size_t)((dir * 2 + mat) * 16 + n) * 96 + (nbh * 3 + (nbi_)) * 16 + fr) * 96 + ks * 32 + fq * 8); } while (0)
    u32x4 rawv[3], gwv[3];
#define LRU_LOAD_RAW(rc_) do { const int b_ = (rc_) / 36, c_ = (rc_) % 36, p0_ = c_ * 64, lo_ = (c_ < 4) ? 0 : CN, hi_ = (c_ < 4) ? CN : LSEQ; \
        _Pragma("unroll") for (int it = 0; it < 3; ++it) { const int pi = ht + 256 * it; rawv[it] = (u32x4){0u, 0u, 0u, 0u}; \
            if (pi < 737) { const int j = pi / 11, cg = pi % 11, q = p0_ - 1 + j; if (q >= lo_ && q < hi_) rawv[it] = *(const u32x4*)(Ug + ((size_t)b_ * LSEQ + q) * 2816 + LRUW + n * 88 + cg * 8); } } } while (0)
#define LRU_LOAD_GATE(rc_) do { const int b_ = (rc_) / 36, c_ = (rc_) % 36, p0_ = c_ * 64; \
        _Pragma("unroll") for (int it = 0; it < 3; ++it) { const int gi = ht + 256 * it; gwv[it] = (u32x4){0u, 0u, 0u, 0u}; \
            if (gi < 704) { const int row = gi / 11, cg = gi % 11; gwv[it] = *(const u32x4*)(Ug + ((size_t)b_ * LSEQ + p0_ + row) * 2816 + n * 88 + cg * 8); } } } while (0)
    if (rc0 < 288) LRU_LOAD_RAW(rc0);
    for (int rc = rc0; rc < 288; rc += nslots16) {
        const int b = rc / 36, c = rc % 36, p0 = c * 64;
        const size_t rowbase = (size_t)b * LSEQ + p0;
        bf16x8 wcur[2][3], wnxt[2][3];
        LRU_LOADW(wcur, 0);
        float bav[3], bxv[3], spv[3], hcv[3];
#pragma unroll
        for (int nbi = 0; nbi < 3; ++nbi) { const int e = (nbh * 3 + nbi) * 16 + fr, ecl = e < 88 ? e : 87, cch = n * 88 + ecl;
            bav[nbi] = a.in[I_LBA][dir * LRUW + cch]; bxv[nbi] = a.in[I_LBX][dir * LRUW + cch]; spv[nbi] = SP[dir * LRUW + cch];
            hcv[nbi] = (PASS == 2) ? CARRY[((size_t)(dir * 8 + b) * 36 + c) * LRUW + cch] : 0.f; }
#pragma unroll
        for (int it = 0; it < 3; ++it) { const int pi = ht + 256 * it; if (pi < 737) { const int j = pi / 11, cg = pi % 11; *(LAS u32x4*)(RAW + j * 88 + cg * 8) = rawv[it]; } }
        LDS_WAIT();
        __syncthreads();
#pragma unroll
        for (int it = 0; it < 3; ++it) { const int gi = ht + 256 * it;
            if (gi < 704) { const int row = gi / 11, cg = gi % 11, c0 = n * 88 + cg * 8;
                float acc[8]; { const f32x4 b0 = *(const f32x4*)(a.in[I_LCB] + c0), b1 = *(const f32x4*)(a.in[I_LCB] + c0 + 4); acc[0] = b0[0]; acc[1] = b0[1]; acc[2] = b0[2]; acc[3] = b0[3]; acc[4] = b1[0]; acc[5] = b1[1]; acc[6] = b1[2]; acc[7] = b1[3]; }
#pragma unroll
                for (int k = 0; k < 4; ++k) { const u32x4 rw = *(const LAS u32x4*)(RAW + (row + k) * 88 + cg * 8); const f32x4 w0 = *(const f32x4*)(a.in[I_LCW] + k * LRUW + c0), w1 = *(const f32x4*)(a.in[I_LCW] + k * LRUW + c0 + 4);
                    acc[0] += w0[0] * bflo(rw.x); acc[1] += w0[1] * bfhi(rw.x); acc[2] += w0[2] * bflo(rw.y); acc[3] += w0[3] * bfhi(rw.y);
                    acc[4] += w1[0] * bflo(rw.z); acc[5] += w1[1] * bfhi(rw.z); acc[6] += w1[2] * bflo(rw.w); acc[7] += w1[3] * bfhi(rw.w); }
                u32x4 o; o.x = pk2(acc[0], acc[1]); o.y = pk2(acc[2], acc[3]); o.z = pk2(acc[4], acc[5]); o.w = pk2(acc[6], acc[7]);
                *(LAS u32x4*)(XB + row * 104 + cg * 8) = o; } }
        if (ht < 64) *(LAS u32x4*)(XB + ht * 104 + 88) = (u32x4){0u, 0u, 0u, 0u};
        LDS_WAIT();
        __syncthreads();
        if (PASS == 2) LRU_LOAD_GATE(rc);
#pragma unroll
        for (int nbi = 0; nbi < 3; ++nbi) {
            if (nbi < 2) LRU_LOADW(wnxt, nbi + 1);
            const int e = (nbh * 3 + nbi) * 16 + fr, ecl = e < 88 ? e : 87, cch = n * 88 + ecl;
            const float ba = bav[nbi], bx = bxv[nbi], sp = spv[nbi];
            float Hc = hcv[nbi], Pt = 1.f; (void)cch;
#pragma unroll UNR
            for (int mi = 0; mi < 4; ++mi) {
                const int mb = dir ? 3 - mi : mi;
                f32x4 acc0 = {0.f, 0.f, 0.f, 0.f}, acc1 = {0.f, 0.f, 0.f, 0.f};
#pragma unroll
                for (int ks = 0; ks < 3; ++ks) { const bf16x8 af = *(const LAS bf16x8*)(XB + (mb * 16 + fr) * 104 + ks * 32 + fq * 8);
                    acc0 = __builtin_amdgcn_mfma_f32_16x16x32_bf16(af, wcur[0][ks], acc0, 0, 0, 0); acc1 = __builtin_amdgcn_mfma_f32_16x16x32_bf16(af, wcur[1][ks], acc1, 0, 0, 0); }
                float av[4], bt[4];
#pragma unroll
                for (int j = 0; j < 4; ++j) { const float xs = bf2f(XB[(mb * 16 + fq * 4 + j) * 104 + ecl]);
                    const float r = __builtin_amdgcn_rcpf(1.0f + __expf(-(acc0[j] + ba))), ig = __builtin_amdgcn_rcpf(1.0f + __expf(-(acc1[j] + bx)));
                    const float la = -8.0f * r * sp; av[j] = __expf(la); bt[j] = __builtin_amdgcn_sqrtf(fmaxf(1.0f - av[j] * av[j], 0.f)) * ig * xs; }
                float Pl = 1.f, hl = 0.f;
#pragma unroll
                for (int jj = 0; jj < 4; ++jj) { const int j = dir ? 3 - jj : jj; hl = fmaf(av[j], hl, bt[j]); Pl *= av[j]; }
                float Pn = __shfl(Pl, src1), hn = __shfl(hl, src1);
                float Pi = val1 ? Pn * Pl : Pl, hi = val1 ? fmaf(Pl, hn, hl) : hl;
                Pn = __shfl(Pi, src2); hn = __shfl(hi, src2);
                const float Pi2 = val2 ? Pn * Pi : Pi, hi2 = val2 ? fmaf(Pi, hn, hi) : hi;
                const float Pex = __shfl(Pi2, src1), hex = __shfl(hi2, src1);
                const float Pe = val1 ? Pex : 1.f, he = val1 ? hex : 0.f;
                const float Ptot = __shfl(Pi2, lastl), htot = __shfl(hi2, lastl);
                if (PASS == 2) {
                    float h = fmaf(Pe, Hc, he);
#pragma unroll
                    for (int jj = 0; jj < 4; ++jj) { const int j = dir ? 3 - jj : jj; h = fmaf(av[j], h, bt[j]); if (e < 88) HS[(dir * 64 + mb * 16 + fq * 4 + j) * 88 + e] = h; }
                }
                Hc = fmaf(Ptot, Hc, htot); Pt *= Ptot;
            }
            if (PASS == 1) { if (fq == 0 && e < 88) SUMM[((size_t)(dir * 8 + b) * 36 + c) * LRUW + n * 88 + e] = (f32x2){Pt, Hc}; }
            if (nbi < 2) {
#pragma unroll
                for (int mat = 0; mat < 2; ++mat)
#pragma unroll
                    for (int ks = 0; ks < 3; ++ks) wcur[mat][ks] = wnxt[mat][ks];
            }
        }
        if (rc + nslots16 < 288) LRU_LOAD_RAW(rc + nslots16);
        if (PASS == 2) {
            LDS_WAIT();
            __syncthreads();
#pragma unroll
            for (int it = 0; it < 3; ++it) { const int gi = ht + 256 * it;
                if (gi < 704) { const int row = gi / 11, cg = gi % 11;
                    const f32x4 f0 = *(const LAS f32x4*)(HS + row * 88 + cg * 8), f1 = *(const LAS f32x4*)(HS + row * 88 + cg * 8 + 4), g0 = *(const LAS f32x4*)(HS + (64 + row) * 88 + cg * 8), g1 = *(const LAS f32x4*)(HS + (64 + row) * 88 + cg * 8 + 4);
                    const u32x4 gw = gwv[it]; u32x4 o;
                    o.x = pk2((f0[0] + g0[0]) * gelu_tanh(bflo(gw.x)), (f0[1] + g0[1]) * gelu_tanh(bfhi(gw.x))); o.y = pk2((f0[2] + g0[2]) * gelu_tanh(bflo(gw.y)), (f0[3] + g0[3]) * gelu_tanh(bfhi(gw.y)));
                    o.z = pk2((f1[0] + g1[0]) * gelu_tanh(bflo(gw.z)), (f1[1] + g1[1]) * gelu_tanh(bfhi(gw.z))); o.w = pk2((f1[2] + g1[2]) * gelu_tanh(bflo(gw.w)), (f1[3] + g1[3]) * gelu_tanh(bfhi(gw.w)));
                    *(u32x4*)(A2 + (rowbase + row) * LRUW + n * 88 + cg * 8) = o; } }
        }
        LDS_WAIT();
        __syncthreads();
    }
#undef LRU_LOAD_RAW
#undef LRU_LOAD_GATE
#undef LRU_LOADW
}
DI void l3_carry(const Args& a, const Frame& F) {
    const f32x2* SUMM = (const f32x2*)(a.ws + MX_SUMM); float* CARRY = (float*)(a.ws + MX_CARRY);
    const int gt = F.bid * 512 + F.tid;
    if (gt < 2 * NB * LRUW) {
        const int dir = gt / (NB * LRUW), b = (gt / LRUW) % NB, ch = gt % LRUW; float h = 0.f;
        for (int s = 0; s < 36; ++s) { const int c = dir ? (s < 4 ? 3 - s : 39 - s) : s; const size_t idx = ((size_t)(dir * 8 + b) * 36 + c) * LRUW + ch;
            CARRY[idx] = h; const f32x2 ph = SUMM[idx]; h = fmaf(ph.x, h, ph.y); }
    }
}
DI void l5_wout(const Args& a, const Frame& F, int li) {
    pg8::DenseSched S; S.init(a.ws + MX_A2, a.ws + WS_WLRU_OUT, MROWS, 1024, LRUW * 2, F.G, F.bid, F.tid);
    pg8::EpiResid E{(float*)(a.ws + WS_X), (const float*)(a.ws + WS_MOD) + (size_t)li * 9 * 6144 + 2048};
    pg8::gemm_phase<pg8::EpiResid, pg8::DenseSched>(F.lds, LRUW * 2, S, E, F.tid);
    bg_tail(a, F, S.nwg, 7);
}

constexpr int NPHASE = 37;
__global__ void __launch_bounds__(NWAVES * 64, 2) fwd_kernel(Args args) {
    extern __shared__ __attribute__((aligned(16))) unsigned char lds_raw[];
    Frame F;
    F.lds = (LAS unsigned char*)lds_raw;
    F.wave = __builtin_amdgcn_readfirstlane((int)threadIdx.x >> 6); F.tid = 0; F.lane = 0;
    F.G = gridDim.x; F.bid = blockIdx.x; F.gw = F.bid * NWAVES + F.wave; F.NGW = F.G * NWAVES;
    volatile LAS unsigned* MISC = (volatile LAS unsigned*)(F.lds + MISC_OFF);
    for (int u = threadIdx.x; u < (LDS_BYTES - MISC_OFF) / 4; u += NWAVES * 64) ((LAS unsigned*)(F.lds + MISC_OFF))[u] = 0u;
    __syncthreads();
    XcdBarrier bar = xcd_barrier_post((unsigned*)(args.ws + WS_CTL) + CW_BAR, MISC + 8);
    const int lo = args.ph_lo, hi = args.ph_hi;
#define IN(k) (lo <= (k) && (k) < hi)
#define NREP(k) ((((PROBE_MASK) >> (k)) & 1ull) ? (args.ph_hi >= NPHASE ? 2 : 1) : 1)
#define SEAM(k) do { if (IN(k) && IN((k) + 1)) xcd_barrier(bar, refresh(F).tid == 0); } while (0)
    if (IN(0)) { for (int rep = 0; rep < NREP(0); ++rep) p0_prologue(args, refresh(F)); }   SEAM(0);
    if (IN(1)) { for (int rep = 0; rep < NREP(1); ++rep) { p0b_modreduce(args, refresh(F)); s5_tables_a(args, refresh(F)); } } SEAM(1);
    if (IN(2)) { for (int rep = 0; rep < NREP(2); ++rep) { p1_init(args, refresh(F)); s5_tables_b(args, refresh(F)); } }       SEAM(2);
    if (IN(3)) { for (int rep = 0; rep < NREP(3); ++rep) a1_qkv(args, refresh(F), 0); }          SEAM(3);
    if (IN(4)) { for (int rep = 0; rep < NREP(4); ++rep) (void)0; }
    if (IN(5)) { for (int rep = 0; rep < NREP(5); ++rep) a2_attention(args, refresh(F), 0, 0); } SEAM(5);
    if (IN(6)) { for (int rep = 0; rep < NREP(6); ++rep) a3_wout(args, refresh(F), 0, 0); }      SEAM(6);
    if (IN(7)) { for (int rep = 0; rep < NREP(7); ++rep) m0_route(args, refresh(F), 0); }        SEAM(7);
    if (IN(8)) { for (int rep = 0; rep < NREP(8); ++rep) m1_gateup(args, refresh(F), 0); }       SEAM(8);
    if (IN(9)) { for (int rep = 0; rep < NREP(9); ++rep) m2_down(args, refresh(F), 0); }         SEAM(9);
    if (IN(10)) { for (int rep = 0; rep < NREP(10); ++rep) m3_combine(args, refresh(F), 0); }     SEAM(10);
    if (IN(11)) { for (int rep = 0; rep < NREP(11); ++rep) s1_win(args, refresh(F)); }            SEAM(11);
    if (IN(12)) { for (int rep = 0; rep < NREP(12); ++rep) s5_mm<1>(args, refresh(F)); }           SEAM(12);
    if (IN(13)) { for (int rep = 0; rep < NREP(13); ++rep) s5_carry(args, refresh(F)); }          SEAM(13);
    if (IN(14)) { for (int rep = 0; rep < NREP(14); ++rep) s5_mm<2>(args, refresh(F)); }         SEAM(14);
    if (IN(15)) { for (int rep = 0; rep < NREP(15); ++rep) s3_glu(args, refresh(F), 1); }         SEAM(15);
    if (IN(16)) { for (int rep = 0; rep < NREP(16); ++rep) m0_route(args, refresh(F), 1); }       SEAM(16);
    if (IN(17)) { for (int rep = 0; rep < NREP(17); ++rep) m1_gateup(args, refresh(F), 1); }      SEAM(17);
    if (IN(18)) { for (int rep = 0; rep < NREP(18); ++rep) m2_down(args, refresh(F), 1); }        SEAM(18);
    if (IN(19)) { for (int rep = 0; rep < NREP(19); ++rep) m3_combine(args, refresh(F), 1); }     SEAM(19);
    if (IN(20)) { for (int rep = 0; rep < NREP(20); ++rep) l1_win(args, refresh(F)); }            SEAM(20);
    if (IN(21)) { for (int rep = 0; rep < NREP(21); ++rep) lru_tiles<1>(args, refresh(F)); }      SEAM(21);
    if (IN(22)) { for (int rep = 0; rep < NREP(22); ++rep) l3_carry(args, refresh(F)); }          SEAM(22);
    if (IN(23)) { for (int rep = 0; rep < NREP(23); ++rep) lru_tiles<2>(args, refresh(F)); }      SEAM(23);
    if (IN(24)) { for (int rep = 0; rep < NREP(24); ++rep) l5_wout(args, refresh(F), 2); }        SEAM(24);
    if (IN(25)) { for (int rep = 0; rep < NREP(25); ++rep) m0_route(args, refresh(F), 2); }       SEAM(25);
    if (IN(26)) { for (int rep = 0; rep < NREP(26); ++rep) m1_gateup(args, refresh(F), 2); }      SEAM(26);
    if (IN(27)) { for (int rep = 0; rep < NREP(27); ++rep) m2_down(args, refresh(F), 2); }        SEAM(27);
    if (IN(28)) { for (int rep = 0; rep < NREP(28); ++rep) m3_combine(args, refresh(F), 2); }     SEAM(28);
    if (IN(29)) { for (int rep = 0; rep < NREP(29); ++rep) a1_qkv(args, refresh(F), 1); }         SEAM(29);
    if (IN(30)) { for (int rep = 0; rep < NREP(30); ++rep) (void)0; }
    if (IN(31)) { for (int rep = 0; rep < NREP(31); ++rep) a2_attention(args, refresh(F), 3, 1); } SEAM(31);
    if (IN(32)) { for (int rep = 0; rep < NREP(32); ++rep) a3_wout(args, refresh(F), 3, 1); }     SEAM(32);
    if (IN(33)) { for (int rep = 0; rep < NREP(33); ++rep) m0_route(args, refresh(F), 3); }       SEAM(33);
    if (IN(34)) { for (int rep = 0; rep < NREP(34); ++rep) m1_gateup(args, refresh(F), 3); }      SEAM(34);
    if (IN(35)) { for (int rep = 0; rep < NREP(35); ++rep) m2_down(args, refresh(F), 3); }        SEAM(35);
    if (IN(36)) { for (int rep = 0; rep < NREP(36); ++rep) m3_combine(args, refresh(F), 3); }
#undef IN
#undef SEAM
}

extern "C" void kernel_launch(void* const* d_in, const int* in_sizes, int n_in, void* d_out, int out_size, void* d_ws, size_t ws_size, hipStream_t stream) {
    static int grid = 0;
    if (grid == 0) {
        if (n_in != 37 || ws_size < WS_END) { fprintf(stderr, "kernel_launch: unexpected n_in %d or ws_size %zu\n", n_in, ws_size); grid = -1; return; }
        if (hipFuncSetAttribute((const void*)fwd_kernel, hipFuncAttributeMaxDynamicSharedMemorySize, LDS_BYTES) != hipSuccess) { fprintf(stderr, "kernel_launch: hipFuncSetAttribute failed\n"); grid = -1; return; }
        int per_cu = 0;
        if (hipOccupancyMaxActiveBlocksPerMultiprocessor(&per_cu, (const void*)fwd_kernel, NWAVES * 64, LDS_BYTES) != hipSuccess || per_cu < 1) fprintf(stderr, "kernel_launch: occupancy query says %d\n", per_cu);
        (void)hipGetLastError();
        grid = 256;
    }
    if (grid < 0) return;
    (void)hipMemsetAsync((char*)d_ws + WS_CTL, 0, CTL_ZERO_BYTES, stream);
    Args a{};
    for (int i = 0; i < 37; ++i) a.in[i] = (const float*)d_in[i];
    a.out = (float*)d_out; a.ws = (unsigned char*)d_ws;
#if MK_N_LAUNCHES == 1
    a.ph_lo = 0; a.ph_hi = NPHASE;
    hipLaunchKernelGGL(fwd_kernel, dim3(grid), dim3(NWAVES * 64), LDS_BYTES, stream, a);
#else
    for (int p = 0; p < NPHASE; ++p) { a.ph_lo = p; a.ph_hi = p + 1; hipLaunchKernelGGL(fwd_kernel, dim3(grid), dim3(NWAVES * 64), LDS_BYTES, stream, a); }
#endif
    (void)in_sizes; (void)out_size;
}
```

```cpp
#include <hip/hip_runtime.h>
#include <cstdio>
#include <cstdint>

#ifndef PROBE_MASK
#define PROBE_MASK 0ull
#endif
#ifndef MK_N_LAUNCHES
#define MK_N_LAUNCHES 1
#endif

#define LAS __attribute__((address_space(3)))
#define GAS __attribute__((address_space(1)))
typedef unsigned short bf16_t;
typedef short bf16x8 __attribute__((ext_vector_type(8)));
typedef short s16x4 __attribute__((ext_vector_type(4)));
typedef float f32x4 __attribute__((ext_vector_type(4)));
typedef float f32x2 __attribute__((ext_vector_type(2)));
typedef float f32x16 __attribute__((ext_vector_type(16)));
typedef unsigned u32x4 __attribute__((ext_vector_type(4)));
typedef unsigned u32x2 __attribute__((ext_vector_type(2)));
typedef int i32x4 __attribute__((ext_vector_type(4)));
typedef GAS unsigned gu32;
#define RLX_AGENT __ATOMIC_RELAXED, __HIP_MEMORY_SCOPE_AGENT
#define LDS_WAIT() asm volatile("s_waitcnt lgkmcnt(0)" ::: "memory")
#define VM_WAIT() asm volatile("s_waitcnt vmcnt(0)" ::: "memory")
#define DI __device__ __forceinline__

constexpr int D = 1024, NB = 8, TL = 2048, CN = 256, LSEQ = TL + CN  , MROWS = NB * LSEQ  , DEPTH = 4;
constexpr int NE = 16, DEXP = 1024, LRUW = 1408, LRUB = 88;
constexpr int S5G = 64, S5P = 64, S5N = 16;
constexpr float LN_EPS = 1e-5f;
constexpr float DN_ALPHA = 1.6817928305074292f;
constexpr int NWAVES = 8;

constexpr size_t MiB = 1u << 20;
constexpr size_t WS_CTL = 0, CTL_ZERO_BYTES = 1 * MiB;
constexpr size_t WS_MODP = 1 * MiB;
constexpr size_t WS_MOD = 16 * MiB;
constexpr size_t WS_PAR = 17 * MiB;
constexpr size_t WS_BD = 19 * MiB;
constexpr size_t WS_WATT_IN = 21 * MiB;
constexpr size_t WS_WATT_OUT = 33 * MiB;
constexpr size_t WS_WS5_IN = 37 * MiB;
constexpr size_t WS_WS5_GLU = 39 * MiB;
constexpr size_t WS_WLRU_IN = 43 * MiB;
constexpr size_t WS_WLRU_OUT = 49 * MiB;
constexpr size_t WS_WGU = 52 * MiB;
constexpr size_t WS_WD = 116 * MiB;
constexpr size_t WS_X = 148 * MiB;
constexpr size_t WS_H = 220 * MiB;
constexpr size_t WS_TOK = 256 * MiB;
constexpr size_t WS_HID = 258 * MiB;
constexpr size_t WS_YEXP = 338 * MiB;
constexpr size_t WS_MIX = 418 * MiB;
constexpr size_t WS_S5W1 = 670 * MiB;
constexpr size_t WS_S5W2 = 686 * MiB;
constexpr size_t WS_S5KT = 734 * MiB;
constexpr size_t WS_S5ZP = 738 * MiB;
constexpr size_t WS_SCL = 742 * MiB;
constexpr size_t SCL_SA = 0, SCL_ATT = 131072, SCL_S5 = 163840, SCL_LRU = 180224, SCL_GU = 262144  ;
constexpr size_t WS_MOEW = 744 * MiB;
constexpr size_t WS_END = 1000 * MiB;
constexpr size_t MX_Q = WS_MIX, MX_K = WS_MIX + 36 * MiB, MX_V = WS_MIX + 72 * MiB, MX_AO = WS_MIX + 108 * MiB;
constexpr size_t MX_U = WS_MIX  , MX_E = WS_MIX + 72 * MiB  , MX_HIN = WS_MIX + 144 * MiB  , MX_G = WS_MIX + 216 * MiB;
constexpr size_t MX_UG = WS_MIX, MX_A2 = WS_MIX + 100 * MiB, MX_SUMM = WS_MIX + 150 * MiB, MX_CARRY = WS_MIX + 158 * MiB;
constexpr size_t PAR_ZR = 0, PAR_ZI = 32768, PAR_BBR = 65536, PAR_BBI = 65536 + 524288, PAR_ROPE = 65536 + 2 * 524288, PAR_SP = PAR_ROPE + 8192;
constexpr int CW_BAR = 4096;
constexpr int CW_CNT = 16384;
constexpr int CW_BG = 32768;
constexpr int CW_DONE = 36864;

constexpr int RING_BYTES = 131072;
constexpr int MISC_OFF = RING_BYTES;
constexpr int TB_OFF = MISC_OFF + 512;
constexpr int TAB_OFF = TB_OFF + 512;
constexpr int TABS_OFF = TAB_OFF + 8192;
constexpr int LDS_BYTES = 155648;
static_assert(TABS_OFF + 8 * 1024 <= LDS_BYTES, "LDS map");

DI unsigned f2bf(float f) { unsigned u = __builtin_bit_cast(unsigned, f); return (u + 0x7fffu + ((u >> 16) & 1u)) >> 16; }
DI unsigned pk2(float lo, float hi) { return f2bf(lo) | (f2bf(hi) << 16); }
DI float bf2f(unsigned short b) { return __builtin_bit_cast(float, ((unsigned)b) << 16); }
DI float bflo(unsigned w) { return __builtin_bit_cast(float, w << 16); }
DI float bfhi(unsigned w) { return __builtin_bit_cast(float, w & 0xffff0000u); }
template <int CTRL> DI float dppf(float v) { return __builtin_bit_cast(float, __builtin_amdgcn_update_dpp(0, __builtin_bit_cast(int, v), CTRL, 0xf, 0xf, true)); }
constexpr int DPP_XOR1 = 0xB1, DPP_XOR2 = 0x4E, DPP_HMIRROR = 0x141, DPP_MIRROR = 0x140;
DI void swap16(float a, float b, float& ra, float& rb) { auto r = __builtin_amdgcn_permlane16_swap(__float_as_uint(a), __float_as_uint(b), false, false); const unsigned u0 = r[0], u1 = r[1]; ra = __uint_as_float(u0); rb = __uint_as_float(u1); }
DI void swap32(float a, float b, float& ra, float& rb) { auto r = __builtin_amdgcn_permlane32_swap(__float_as_uint(a), __float_as_uint(b), false, false); const unsigned u0 = r[0], u1 = r[1]; ra = __uint_as_float(u0); rb = __uint_as_float(u1); }
DI float launder(float v) { asm volatile("" : "+v"(v)); return v; }
DI float wave_sum(float v) {
    v += dppf<DPP_XOR1>(v); v += dppf<DPP_XOR2>(v); v += dppf<DPP_HMIRROR>(v); v += dppf<DPP_MIRROR>(v);
    float a, b; swap16(v, launder(v), a, b); v = a + b; swap32(v, launder(v), a, b); return a + b;
}
DI float wave_max(float v) {
    v = fmaxf(v, dppf<DPP_XOR1>(v)); v = fmaxf(v, dppf<DPP_XOR2>(v)); v = fmaxf(v, dppf<DPP_HMIRROR>(v)); v = fmaxf(v, dppf<DPP_MIRROR>(v));
    float a, b; swap16(v, launder(v), a, b); v = fmaxf(a, b); swap32(v, launder(v), a, b); return fmaxf(a, b);
}
DI float sigmoidf_(float x) { return __builtin_amdgcn_rcpf(1.0f + __expf(-x)); }
DI float gelu_tanh(float x) { const float u = 0.7978845608028654f * (x + 0.044715f * x * x * x); const float e = __expf(2.0f * u); return x - x * __builtin_amdgcn_rcpf(e + 1.0f); }
DI void sincos_cw(float x, float& s, float& c) {
    const float k = rintf(x * 0.6366197723675814f);
    float r = fmaf(k, -1.5707962512969971f, x); r = fmaf(k, -7.5497894158615964e-08f, r); r = fmaf(k, -5.3903029534742384e-15f, r);
    const float r2 = r * r;
    float sp = fmaf(r2, 2.7557313707070068e-6f, -1.9841270114006046e-4f); sp = fmaf(sp, r2, 8.3333337680e-3f); sp = fmaf(sp, r2, -1.6666667163e-1f); sp = fmaf(sp * r2, r, r);
    float cp = fmaf(r2, 2.4801587e-5f, -1.3888889225e-3f); cp = fmaf(cp, r2, 4.1666667908e-2f); cp = fmaf(cp, r2, -0.5f); cp = fmaf(cp, r2, 1.0f);
    const int q = ((int)k) & 3;
    const float ss = (q & 1) ? cp : sp, cc = (q & 1) ? sp : cp;
    s = (q & 2) ? -ss : ss; c = ((q + 1) & 2) ? -cc : cc;
}

#define XB_TMO      128
#define XB_XCNT(j)  (256  + 64 * (j))
#define XB_XSUB(j)  (1280 + 64 * (j))
#define XB_XGEN(j)  (2304 + 64 * (j))
#define XB_TOP      3328
#define XB_TOPGEN   3392
#define XCD_BAR_WORDS 3456
#define XB_SPIN_CAP (1u << 20)
DI unsigned xb_ld(unsigned* p)              { return __hip_atomic_load(p, __ATOMIC_RELAXED, __HIP_MEMORY_SCOPE_AGENT); }
DI unsigned xb_add(unsigned* p, unsigned v) { return __hip_atomic_fetch_add(p, v, __ATOMIC_RELAXED, __HIP_MEMORY_SCOPE_AGENT); }
DI unsigned xb_xcc_id() { return (unsigned)__builtin_amdgcn_s_getreg((3 << 11) | 20) & 0xFu; }
#define XB_SPIN(cond, bar) do { unsigned _sp = 0; while (cond) { __builtin_amdgcn_s_sleep(1); \
    if ((++_sp & 255u) == 0u) { if (xb_ld(&(bar)[XB_TMO])) break; if (_sp > XB_SPIN_CAP) { atomicAdd(&(bar)[XB_TMO], 1u); break; } } } } while (0)
struct XcdBarrier { unsigned* bar; unsigned x; volatile LAS unsigned* st; };
DI XcdBarrier xcd_barrier_post(unsigned* bar, volatile LAS unsigned* st) {
    XcdBarrier b; b.bar = bar; b.x = xb_xcc_id(); b.st = st;
    if (threadIdx.x == 0) (void)xb_add(&bar[XB_XCNT(b.x)], 1u);
    return b;
}
DI void xcd_barrier_complete(unsigned* bar, unsigned x, unsigned& nloc, unsigned& nx) {
    const unsigned G = gridDim.x * gridDim.y * gridDim.z;
    unsigned sum, cnt, mine, sp = 0u;
    for (;;) {
        sum = 0u; cnt = 0u; mine = 0u;
#pragma unroll
        for (unsigned j = 0; j < 16; ++j) { const unsigned c = xb_ld(&bar[XB_XCNT(j)]); sum += c; cnt += (c > 0u) ? 1u : 0u; mine = (j == x) ? c : mine; }
        if (sum == G) break;
        __builtin_amdgcn_s_sleep(1);
        if ((++sp & 255u) == 0u) { if (xb_ld(&bar[XB_TMO])) break; if (sp > XB_SPIN_CAP) { atomicAdd(&bar[XB_TMO], 1u); break; } }
    }
    nloc = mine > 0u ? mine : 1u; nx = cnt > 0u ? cnt : 1u;
}
DI void xcd_barrier(const XcdBarrier& b, const bool leader) {
    asm volatile("s_waitcnt vmcnt(0)" ::: "memory");
    __syncthreads();
    if (leader) {
        unsigned* bar = b.bar;
        __builtin_amdgcn_s_waitcnt(0);
        unsigned nloc = b.st[0], nx = b.st[1];
        if (nloc == 0u) { xcd_barrier_complete(bar, b.x, nloc, nx); b.st[0] = nloc; b.st[1] = nx; }
        const unsigned old = xb_add(&bar[XB_XSUB(b.x)], 1u);
        const unsigned gen = old / nloc;
        if (old + 1u == (gen + 1u) * nloc) {
            __builtin_amdgcn_fence(__ATOMIC_RELEASE, "agent");
            asm volatile("s_waitcnt vmcnt(0)" ::: "memory");
            const unsigned og = xb_add(&bar[XB_TOP], 1u);
            const unsigned tg = og / nx;
            if (og + 1u == (tg + 1u) * nx) xb_add(&bar[XB_TOPGEN], 1u);
            else XB_SPIN(xb_ld(&bar[XB_TOPGEN]) == tg, bar);
            __builtin_amdgcn_fence(__ATOMIC_ACQUIRE, "agent");
            xb_add(&bar[XB_XGEN(b.x)], 1u);
            asm volatile("s_waitcnt vmcnt(0)" ::: "memory");
        } else {
            XB_SPIN(xb_ld(&bar[XB_XGEN(b.x)]) == gen, bar);
            __builtin_amdgcn_fence(__ATOMIC_ACQUIRE, "agent");
            asm volatile("s_waitcnt vmcnt(0)" ::: "memory");
        }
    }
    __syncthreads();
}

namespace pg8 {
constexpr int BM = 256, BK = 64, HALF = 128, HTB = HALF * BK * 2, STAGE_BYTES = 8 * HTB, NXCD = 8, WGM = 8;
__host__ __device__ __forceinline__ int lds_byte(int r, int c) { const int st = (r >> 4) * 2 + (c >> 5), rr = r & 15, cc = c & 31, ob = rr * 64 + cc * 2; return st * 1024 + (ob ^ (((ob >> 9) & 1) << 5)); }
__host__ __device__ __forceinline__ void stage_rc(int b, int& R, int& C) { const int st = b / 1024, sb = b % 1024, swz = sb ^ (((sb >> 9) & 1) << 5); R = (st >> 1) * 16 + swz / 64; C = (st & 1) * 32 + (swz % 64) / 2; }
__host__ __device__ __forceinline__ int perm32(int rho) { const int n = rho >> 4, i = rho & 15; return 8 * (i >> 2) + 4 * n + (i & 3); }

struct Unit { int pm, pn, e, ord; const char* A; const char* B; };
DI unsigned cvt_pk_bf16(float lo, float hi) { unsigned r; asm volatile("v_cvt_pk_bf16_f32 %0, %1, %2" : "=v"(r) : "v"(lo), "v"(hi)); return r; }

DI int xcd_remap(int wgid, int nwg) { const int q = nwg / NXCD, r = nwg % NXCD, xcd = wgid % NXCD, off = wgid / NXCD; return (xcd < r ? xcd * (q + 1) : r * (q + 1) + (xcd - r) * q) + off; }

struct DenseSched {
    static constexpr bool GATHER = false;
    const char* A; const char* Bt; int Kb, nM, nN, nwg, G, c, lat, tid;
    DI void init(const void* A_, const void* Bt_, int M, int N, int Kb_, int G_, int c_, int tid_, int lat_ = 0) { tid = tid_; A = (const char*)A_; Bt = (const char*)Bt_; Kb = Kb_; lat = lat_; nM = lat ? 64 : M / BM; nN = N / BM; nwg = nM * nN; G = G_; c = c_; }
    DI bool next(int i, Unit& u) const {
        const long L = (long)i * G + c; if (L >= nwg) return false;
        const int wgid = xcd_remap((int)L, nwg);
        const int nig = WGM * nN, gid = wgid / nig, fm = gid * WGM, gsz = (nM - fm) < WGM ? (nM - fm) : WGM;
        u.pm = fm + ((wgid % nig) % gsz); u.pn = (wgid % nig) / gsz; u.e = 0; u.ord = i;
        if (lat) u.pm = (u.pm >> 3) * 9 + 1 + (u.pm & 7);
        u.A = A + (size_t)u.pm * BM * Kb; u.B = Bt + (size_t)u.pn * BM * Kb; return true;
    }
    DI void aoffs(int, const Unit&, unsigned (&vo)[2][2]) const {
#pragma unroll
        for (int p = 0; p < 2; ++p) { int R, C; stage_rc(tid * 16 + p * 8192, R, C);
#pragma unroll
            for (int h = 0; h < 2; ++h) vo[h][p] = (unsigned)((h * HALF + R) * Kb + C * 2); }
    }
};
template <bool GATHER_, int NPN>
struct MoeSched {
    static constexpr bool GATHER = GATHER_;
    const char* A; const char* Bt; const LAS int* tb; const LAS unsigned* tab; int NT, G, c, Kb, tid; size_t estride;
    DI bool next(int i, Unit& u) const {
        const int nwg = NT * NPN; const long L = (long)i * G + c; if (L >= nwg) return false;
        const int id = xcd_remap((int)L, nwg);
        const int rt = id / NPN, pn = id % NPN; int e = 0;
#pragma unroll
        for (int j = 1; j < 16; ++j) e += (tb[j] <= rt) ? 1 : 0;
        u.pm = rt; u.pn = pn; u.e = e; u.ord = i;
        u.A = GATHER ? A : A + (size_t)rt * BM * Kb; u.B = Bt + (size_t)e * estride + (size_t)pn * BM * Kb; return true;
    }
    DI void aoffs(int i, const Unit&, unsigned (&vo)[2][2]) const {
#pragma unroll
        for (int p = 0; p < 2; ++p) { int R, C; stage_rc(tid * 16 + p * 8192, R, C);
#pragma unroll
            for (int h = 0; h < 2; ++h) vo[h][p] = GATHER ? (tab[i * 256 + h * HALF + R] + (unsigned)C * 2u) : (unsigned)((h * HALF + R) * Kb + C * 2); }
    }
};

struct EpiBf16 {
    static constexpr bool PERM = true;
    bf16_t* O; int ldc; int split_cols; size_t split_stride;
    DI void operator()(const f32x4 (&acc)[2][2][4][2], const Unit& u, int wr, int wc, int fr, int fq) const {
        const int row0 = u.pm * BM + wr * 64 + fr; int colt = u.pn * BM; bf16_t* base = O;
        if (split_cols) { const int t = colt / split_cols; base += (size_t)t * split_stride; colt -= t * split_cols; }
        const int col0 = colt + wc * 32 + 8 * fq;
#pragma unroll
        for (int ai = 0; ai < 2; ++ai)
#pragma unroll
            for (int m = 0; m < 4; ++m) { bf16_t* rowp = base + (size_t)(row0 + ai * HALF + m * 16) * ldc + col0;
#pragma unroll
                for (int bj = 0; bj < 2; ++bj) { const f32x4 v0 = acc[ai][bj][m][0], v1 = acc[ai][bj][m][1];
                    u32x4 w; w.x = cvt_pk_bf16(v0[0], v0[1]); w.y = cvt_pk_bf16(v0[2], v0[3]); w.z = cvt_pk_bf16(v1[0], v1[1]); w.w = cvt_pk_bf16(v1[2], v1[3]);
                    *(u32x4*)(rowp + bj * HALF) = w; } }
    }
};
struct EpiF32 {
    static constexpr bool PERM = false;
    float* C; int ldc;
    DI void operator()(const f32x4 (&acc)[2][2][4][2], const Unit& u, int wr, int wc, int fr, int fq) const {
        const int row0 = u.pm * BM + wr * 64 + fr, col0 = u.pn * BM + wc * 32 + 4 * fq;
#pragma unroll
        for (int ai = 0; ai < 2; ++ai)
#pragma unroll
            for (int m = 0; m < 4; ++m) { float* rowp = C + (size_t)(row0 + ai * HALF + m * 16) * ldc + col0;
#pragma unroll
                for (int bj = 0; bj < 2; ++bj)
#pragma unroll
                    for (int n = 0; n < 2; ++n) *(f32x4*)(rowp + bj * HALF + n * 16) = acc[ai][bj][m][n]; }
    }
};
struct EpiResid {
    static constexpr bool PERM = false;
    float* X; const float* gate;
    DI void operator()(const f32x4 (&acc)[2][2][4][2], const Unit& u, int wr, int wc, int fr, int fq) const {
        const int row0 = u.pm * BM + wr * 64 + fr, col0 = u.pn * BM + wc * 32 + 4 * fq;
        const int r9 = (u.pm % 9 == 0) ? 8 : u.pm / 9; const float* g = gate + (size_t)r9 * 6144 + col0;
        f32x4 gv[2][2];
#pragma unroll
        for (int bj = 0; bj < 2; ++bj)
#pragma unroll
            for (int n = 0; n < 2; ++n) gv[bj][n] = *(const f32x4*)(g + bj * HALF + n * 16);
#pragma unroll
        for (int ai = 0; ai < 2; ++ai)
#pragma unroll
            for (int m = 0; m < 4; ++m) { float* rowp = X + (size_t)(row0 + ai * HALF + m * 16) * D + col0;
#pragma unroll
                for (int bj = 0; bj < 2; ++bj)
#pragma unroll
                    for (int n = 0; n < 2; ++n) { const f32x4 x = *(const f32x4*)(rowp + bj * HALF + n * 16); *(f32x4*)(rowp + bj * HALF + n * 16) = x * DN_ALPHA + gv[bj][n] * acc[ai][bj][m][n]; } }
    }
};
struct EpiGluResid {
    static constexpr bool PERM = false;
    float* X; const float* gate;
    DI void operator()(const f32x4 (&acc)[2][2][4][2], const Unit& u, int wr, int wc, int fr, int fq) const {
        const int row0 = u.pm * BM + wr * 64 + fr, col0 = u.pn * HALF + wc * 32 + 4 * fq;
        const int r9 = (u.pm % 9 == 0) ? 8 : u.pm / 9; const float* g = gate + (size_t)r9 * 6144 + col0;
        f32x4 gv[2];
#pragma unroll
        for (int n = 0; n < 2; ++n) gv[n] = *(const f32x4*)(g + n * 16);
#pragma unroll
        for (int ai = 0; ai < 2; ++ai)
#pragma unroll
            for (int m = 0; m < 4; ++m) { float* rowp = X + (size_t)(row0 + ai * HALF + m * 16) * D + col0;
#pragma unroll
                for (int n = 0; n < 2; ++n) { const f32x4 v = acc[ai][0][m][n], gg = acc[ai][1][m][n]; f32x4 o;
#pragma unroll
                    for (int j = 0; j < 4; ++j) o[j] = v[j] * sigmoidf_(gg[j]);
                    const f32x4 x = *(const f32x4*)(rowp + n * 16); *(f32x4*)(rowp + n * 16) = x * DN_ALPHA + gv[n] * o; } }
    }
};
struct EpiSwiGLU {
    static constexpr bool PERM = true;
    bf16_t* Hid;
    DI void operator()(const f32x4 (&acc)[2][2][4][2], const Unit& u, int wr, int wc, int fr, int fq) const {
        const int row0 = u.pm * BM + wr * 64 + fr, col0 = u.pn * HALF + wc * 32 + 8 * fq;
#pragma unroll
        for (int ai = 0; ai < 2; ++ai)
#pragma unroll
            for (int m = 0; m < 4; ++m) { bf16_t* rowp = Hid + (size_t)(row0 + ai * HALF + m * 16) * DEXP + col0;
                f32x4 h0, h1;
#pragma unroll
                for (int j = 0; j < 4; ++j) { const float g0 = acc[ai][0][m][0][j], g1 = acc[ai][0][m][1][j]; h0[j] = g0 * sigmoidf_(g0) * acc[ai][1][m][0][j]; h1[j] = g1 * sigmoidf_(g1) * acc[ai][1][m][1][j]; }
                u32x4 w; w.x = cvt_pk_bf16(h0[0], h0[1]); w.y = cvt_pk_bf16(h0[2], h0[3]); w.z = cvt_pk_bf16(h1[0], h1[1]); w.w = cvt_pk_bf16(h1[2], h1[3]);
                *(u32x4*)rowp = w; }
    }
};

DI f32x4 i2f4(i32x4 v) { return (f32x4){(float)v[0], (float)v[1], (float)v[2], (float)v[3]}; }
struct EpiBf16S {
    static constexpr bool PERM = true;
    bf16_t* O; int ldc; int split_cols; size_t split_stride; const float* sa; const float* sb; const f32x2* rope;
    DI void operator()(const i32x4 (&acc)[2][2][4][2], const Unit& u, int wr, int wc, int fr, int fq) const {
        const int row0 = u.pm * BM + wr * 64 + fr; int colt = u.pn * BM; bf16_t* base = O;
        const int gcol0 = colt + wc * 32 + 8 * fq;
        const bool do_rope = rope != nullptr && u.pn < 8 && (u.pm % 9) != 0;
        if (split_cols) { const int t = colt / split_cols; base += (size_t)t * split_stride; colt -= t * split_cols; }
        const int col0 = colt + wc * 32 + 8 * fq;
        f32x4 sbv[2][2];
#pragma unroll
        for (int bj = 0; bj < 2; ++bj)
#pragma unroll
            for (int n = 0; n < 2; ++n) sbv[bj][n] = *(const f32x4*)(sb + gcol0 + bj * HALF + 4 * n);
#pragma unroll
        for (int ai = 0; ai < 2; ++ai)
#pragma unroll
            for (int m = 0; m < 4; ++m) { const int row = row0 + ai * HALF + m * 16; const float sar = sa[row]; bf16_t* rowp = base + (size_t)row * ldc + col0;
                f32x4 cs[4];
                if (do_rope) { const int t = row % LSEQ - CN, pos = (wc & 1) ? (t & 63) : (t >> 6); const f32x4* tp = (const f32x4*)(rope + pos * 16 + 8 * (fq & 1));
                    cs[0] = tp[0]; cs[1] = tp[1]; cs[2] = tp[2]; cs[3] = tp[3]; }
#pragma unroll
                for (int bj = 0; bj < 2; ++bj) { f32x4 v0 = i2f4(acc[ai][bj][m][0]) * sbv[bj][0] * sar, v1 = i2f4(acc[ai][bj][m][1]) * sbv[bj][1] * sar;
                    if (do_rope) { const float sg = (fq & 2) ? 1.0f : -1.0f; f32x4 p0, p1;
#pragma unroll
                        for (int j = 0; j < 4; ++j) { float xa, xb; swap32(v0[j], v0[j], xa, xb); p0[j] = (fq & 2) ? xa : xb; swap32(v1[j], v1[j], xa, xb); p1[j] = (fq & 2) ? xa : xb; }
                        v0[0] = v0[0] * cs[0][0] + sg * p0[0] * cs[0][1]; v0[1] = v0[1] * cs[0][2] + sg * p0[1] * cs[0][3]; v0[2] = v0[2] * cs[1][0] + sg * p0[2] * cs[1][1]; v0[3] = v0[3] * cs[1][2] + sg * p0[3] * cs[1][3];
                        v1[0] = v1[0] * cs[2][0] + sg * p1[0] * cs[2][1]; v1[1] = v1[1] * cs[2][2] + sg * p1[1] * cs[2][3]; v1[2] = v1[2] * cs[3][0] + sg * p1[2] * cs[3][1]; v1[3] = v1[3] * cs[3][2] + sg * p1[3] * cs[3][3]; }
                    u32x4 w; w.x = cvt_pk_bf16(v0[0], v0[1]); w.y = cvt_pk_bf16(v0[2], v0[3]); w.z = cvt_pk_bf16(v1[0], v1[1]); w.w = cvt_pk_bf16(v1[2], v1[3]);
                    *(u32x4*)(rowp + bj * HALF) = w; } }
    }
};
struct EpiSwiGLUS {
    static constexpr bool PERM = true;
    bf16_t* Hid; const LAS float* tabs; const float* sb;
    DI void operator()(const i32x4 (&acc)[2][2][4][2], const Unit& u, int wr, int wc, int fr, int fq) const {
        const int row0 = u.pm * BM + wr * 64 + fr, col0 = u.pn * HALF + wc * 32 + 8 * fq;
        const float* sbp = sb + (size_t)u.e * 2048 + u.pn * BM + wc * 32 + 8 * fq;
        f32x4 sg[2], su[2];
#pragma unroll
        for (int n = 0; n < 2; ++n) { sg[n] = *(const f32x4*)(sbp + 4 * n); su[n] = *(const f32x4*)(sbp + HALF + 4 * n); }
#pragma unroll
        for (int ai = 0; ai < 2; ++ai)
#pragma unroll
            for (int m = 0; m < 4; ++m) { const float sar = tabs[u.ord * 256 + ai * HALF + wr * 64 + m * 16 + fr]; bf16_t* rowp = Hid + (size_t)(row0 + ai * HALF + m * 16) * DEXP + col0;
                const f32x4 g0v = i2f4(acc[ai][0][m][0]) * sg[0] * sar, g1v = i2f4(acc[ai][0][m][1]) * sg[1] * sar, u0v = i2f4(acc[ai][1][m][0]) * su[0] * sar, u1v = i2f4(acc[ai][1][m][1]) * su[1] * sar;
                f32x4 h0, h1;
#pragma unroll
                for (int j = 0; j < 4; ++j) { h0[j] = g0v[j] * sigmoidf_(g0v[j]) * u0v[j]; h1[j] = g1v[j] * sigmoidf_(g1v[j]) * u1v[j]; }
                u32x4 w; w.x = cvt_pk_bf16(h0[0], h0[1]); w.y = cvt_pk_bf16(h0[2], h0[3]); w.z = cvt_pk_bf16(h1[0], h1[1]); w.w = cvt_pk_bf16(h1[2], h1[3]);
                *(u32x4*)rowp = w; }
    }
};
template <bool I8> struct AccSel { typedef f32x4 T; };
template <> struct AccSel<true> { typedef i32x4 T; };
DI f32x4 mma16(bf16x8 b, bf16x8 a, f32x4 c) { return __builtin_amdgcn_mfma_f32_16x16x32_bf16(b, a, c, 0, 0, 0); }
DI i32x4 mma16(bf16x8 b, bf16x8 a, i32x4 c) { return __builtin_amdgcn_mfma_i32_16x16x64_i8(__builtin_bit_cast(i32x4, b), __builtin_bit_cast(i32x4, a), c, 0, 0, 0); }
template <class Epi, class Sched, bool I8 = false, bool ALIGN_EPI = true>
DI void gemm_phase(LAS unsigned char* lds, const int Kb  , const Sched& S, const Epi& E, const int tid) {
    const int wid = __builtin_amdgcn_readfirstlane(tid >> 6), lane = tid & 63, wr = wid >> 2, wc = wid & 3, fr = lane & 15, fq = lane >> 4;
    const int nt = Kb / (BK * 2);
    unsigned voffB[2];
#pragma unroll
    for (int i = 0; i < 2; ++i) { int R, C; stage_rc(tid * 16 + i * 8192, R, C); const int Rb = Epi::PERM ? ((R & ~31) + perm32(R & 31)) : R; voffB[i] = (unsigned)(Rb * Kb + C * 2); }
    const size_t kstep = (size_t)(BK * 2);
    const size_t hstep = (size_t)HALF * Kb;
    const unsigned ldsw = (unsigned)wid * 1024u;
    const int aoff = lds_byte(wr * 64 + fr, fq * 8), boff = lds_byte(wc * 32 + fr, fq * 8);
#define PG8_SA(b, h) (((b) * 2 + (h)) * HTB)
#define PG8_SB(b, h) ((4 + (b) * 2 + (h)) * HTB)
#define PG8_STAGE(bufoff, gbase, o0, o1) do { \
        __builtin_amdgcn_global_load_lds((const unsigned*)((const char*)(gbase) + (o0)), (LAS unsigned*)(lds + (bufoff) + ldsw), 16, 0, 0); \
        __builtin_amdgcn_global_load_lds((const unsigned*)((const char*)(gbase) + (o1)), (LAS unsigned*)(lds + (bufoff) + ldsw + 8192), 16, 0, 0); } while (0)
#define PG8_STAGEB(bufoff, gbase) PG8_STAGE(bufoff, gbase, voffB[0], voffB[1])
#define PG8_LDA(dst, b, h) do { _Pragma("unroll") for (int m = 0; m < 4; ++m) _Pragma("unroll") for (int k = 0; k < 2; ++k) dst[m][k] = *(const LAS bf16x8*)(lds + PG8_SA(b, h) + aoff + m * 2048 + k * 1024); } while (0)
#define PG8_LDB(dst, b, h) do { _Pragma("unroll") for (int n = 0; n < 2; ++n) _Pragma("unroll") for (int k = 0; k < 2; ++k) dst[n][k] = *(const LAS bf16x8*)(lds + PG8_SB(b, h) + boff + n * 2048 + k * 1024); } while (0)
#define PG8_MMA(ai, bj, At, Bt) do { __builtin_amdgcn_s_setprio(1); _Pragma("unroll") for (int m = 0; m < 4; ++m) _Pragma("unroll") for (int n = 0; n < 2; ++n) _Pragma("unroll") for (int k = 0; k < 2; ++k) \
        acc[ai][bj][m][n] = mma16(Bt[n][k], At[m][k], acc[ai][bj][m][n]); __builtin_amdgcn_s_setprio(0); } while (0)
#define PG8_WAIT_V(n) asm volatile("s_waitcnt vmcnt(" #n ")" ::: "memory")
#define PG8_WAIT_L(n) asm volatile("s_waitcnt lgkmcnt(" #n ")" ::: "memory")
#define PG8_BAR __builtin_amdgcn_s_barrier()
#define PG8_SCHED __builtin_amdgcn_sched_barrier(0)
    Unit cur, nxt; int ui = 0;
    if (!S.next(0, cur)) return;
    typedef typename AccSel<I8>::T AccT;
    AccT acc[2][2][4][2];
#pragma unroll
    for (int a = 0; a < 2; ++a)
#pragma unroll
        for (int b = 0; b < 2; ++b)
#pragma unroll
            for (int m = 0; m < 4; ++m)
#pragma unroll
                for (int n = 0; n < 2; ++n) acc[a][b][m][n] = AccT{};
    bf16x8 At[4][2], B0[2][2], B1[2][2];
    unsigned voA[2][2], voN[2][2];
    S.aoffs(0, cur, voA);
#pragma unroll
    for (int h = 0; h < 2; ++h)
#pragma unroll
        for (int p = 0; p < 2; ++p) voN[h][p] = voA[h][p];
    const char* cA = cur.A; const char* cB = cur.B;
    PG8_STAGEB(PG8_SB(0, 0), cB); PG8_STAGEB(PG8_SB(0, 1), cB + hstep); PG8_STAGE(PG8_SA(0, 0), cA, voA[0][0], voA[0][1]); PG8_STAGE(PG8_SA(0, 1), cA, voA[1][0], voA[1][1]);
    if (wr == 1) PG8_BAR;
    PG8_WAIT_V(2); PG8_BAR;
    PG8_STAGEB(PG8_SB(1, 0), cB + kstep); PG8_STAGE(PG8_SA(1, 0), cA + kstep, voA[0][0], voA[0][1]); PG8_STAGEB(PG8_SB(1, 1), cB + hstep + kstep);
    PG8_WAIT_V(6); PG8_BAR;
    for (;;) {
        const bool has_next = S.next(ui + 1, nxt);
        const char* nA = has_next ? nxt.A : cA; const char* nB = has_next ? nxt.B : cB;
        for (int t = 0; t < nt; t += 2) {
            const bool last = (t == nt - 2);
            const char* a1 = cA + (size_t)(t + 1) * kstep;
            const char* a2 = last ? nA : cA + (size_t)(t + 2) * kstep; const char* b2 = last ? nB : cB + (size_t)(t + 2) * kstep;
            const char* a3 = a2 + kstep; const char* b3 = b2 + kstep;
            if (Sched::GATHER) { if (last && has_next) S.aoffs(ui + 1, nxt, voN); }
            unsigned s00 = voA[0][0], s01 = voA[0][1], s10 = voA[1][0], s11 = voA[1][1];
            if (Sched::GATHER) { if (last) { s00 = voN[0][0]; s01 = voN[0][1]; s10 = voN[1][0]; s11 = voN[1][1]; } }
            PG8_LDB(B0, 0, 0); PG8_LDB(B1, 0, 1); PG8_SCHED; PG8_LDA(At, 0, 0); PG8_STAGE(PG8_SA(1, 1), a1, voA[1][0], voA[1][1]);
            PG8_WAIT_V(8); PG8_WAIT_L(0); PG8_BAR; PG8_MMA(0, 0, At, B0); PG8_MMA(0, 1, At, B1); PG8_BAR; PG8_SCHED;
            PG8_LDA(At, 0, 1); PG8_STAGEB(PG8_SB(0, 0), b2); PG8_STAGEB(PG8_SB(0, 1), b2 + hstep); PG8_STAGE(PG8_SA(0, 0), a2, s00, s01);
            PG8_WAIT_V(8); PG8_WAIT_L(0); PG8_BAR; PG8_MMA(1, 0, At, B0); PG8_MMA(1, 1, At, B1); PG8_BAR; PG8_SCHED;
            PG8_LDB(B0, 1, 0); PG8_LDB(B1, 1, 1); PG8_SCHED; PG8_LDA(At, 1, 0); PG8_STAGE(PG8_SA(0, 1), a2, s10, s11);
            PG8_WAIT_V(8); PG8_WAIT_L(0); PG8_BAR; PG8_MMA(0, 0, At, B0); PG8_MMA(0, 1, At, B1); PG8_BAR; PG8_SCHED;
            PG8_LDA(At, 1, 1); PG8_STAGEB(PG8_SB(1, 0), b3); PG8_STAGEB(PG8_SB(1, 1), b3 + hstep); PG8_STAGE(PG8_SA(1, 0), a3, s00, s01);
            PG8_WAIT_V(8); PG8_WAIT_L(0); PG8_BAR; PG8_MMA(1, 0, At, B0); PG8_MMA(1, 1, At, B1); PG8_BAR; PG8_SCHED;
        }
        if constexpr (ALIGN_EPI) { if (wr == 0) PG8_BAR; }
        E(acc, cur, wr, wc, fr, fq);
        if (!has_next) break;
#pragma unroll
        for (int a = 0; a < 2; ++a)
#pragma unroll
            for (int b = 0; b < 2; ++b)
#pragma unroll
                for (int m = 0; m < 4; ++m)
#pragma unroll
                    for (int n = 0; n < 2; ++n) acc[a][b][m][n] = AccT{};
        cur = nxt; cA = nA; cB = nB; ++ui;
        if (Sched::GATHER) {
#pragma unroll
            for (int h = 0; h < 2; ++h)
#pragma unroll
                for (int p = 0; p < 2; ++p) voA[h][p] = voN[h][p];
        }
        if constexpr (ALIGN_EPI) { if (wr == 1) PG8_BAR; }
    }
    PG8_WAIT_V(0);
    if constexpr (!ALIGN_EPI) { if (wr == 0) PG8_BAR; }
    PG8_BAR;
#undef PG8_SA
#undef PG8_SB
#undef PG8_STAGE
#undef PG8_STAGEB
#undef PG8_LDA
#undef PG8_LDB
#undef PG8_MMA
#undef PG8_WAIT_V
#undef PG8_WAIT_L
#undef PG8_BAR
#undef PG8_SCHED
}
}

namespace att {
constexpr int KVBLK = 64;
constexpr float SCALE = 0.125f;
constexpr float THR = 8.f;
constexpr int SHM_V = KVBLK * 128 * 2, SHM_K = KVBLK * 128 * 2;
constexpr int ATT_LDS = 2 * SHM_V + 2 * SHM_K + 8 * 64 * 4;
#define KSWZ(row, colB) ((row) * 256 + ((colB) ^ (((row) & 7) << 4)))
#define SBAR() __builtin_amdgcn_sched_barrier(0)
DI int crow(int r, int hi) { return (r & 3) + 8 * (r >> 2) + 4 * hi; }
DI unsigned cvtpk(float lo, float hi) { unsigned r; asm volatile("v_cvt_pk_bf16_f32 %0, %1, %2" : "=v"(r) : "v"(lo), "v"(hi)); return r; }
DI void partialSM(f32x16& p0, f32x16& p1, float& m_reg, float& mn, float& alpha) {
  constexpr float C = SCALE * 1.4426950408889634f;
  float pmax = p0[0];
#pragma unroll
  for (int r = 1; r < 16; ++r) pmax = fmaxf(pmax, p0[r]);
#pragma unroll
  for (int r = 0; r < 16; ++r) pmax = fmaxf(pmax, p1[r]);
  { auto rr = __builtin_amdgcn_permlane32_swap(__float_as_uint(pmax), __float_as_uint(pmax), false, false);
    pmax = fmaxf(__uint_as_float(rr[0]), __uint_as_float(rr[1])); }
  if (__builtin_expect(__all(pmax - m_reg <= THR / SCALE), 1)) { mn = m_reg; alpha = 1.f; }
  else { mn = fmaxf(m_reg, pmax); alpha = __builtin_amdgcn_exp2f((m_reg - mn) * C); m_reg = mn; }
  float mnC = -mn * C;
#pragma unroll
  for (int r = 0; r < 16; ++r) p0[r] = fmaf(p0[r], C, mnC);
#pragma unroll
  for (int r = 0; r < 16; ++r) p1[r] = fmaf(p1[r], C, mnC);
#pragma unroll
  for (int r = 0; r < 16; ++r) p0[r] = __builtin_amdgcn_exp2f(p0[r]);
}
DI void finishSM(f32x16& p0, f32x16& p1, float alpha, float& l_reg, bf16x8& pa0, bf16x8& pa1, bf16x8& pa2, bf16x8& pa3) {
#pragma unroll
  for (int r = 0; r < 16; ++r) p1[r] = __builtin_amdgcn_exp2f(p1[r]);
  float ps = 0;
#pragma unroll
  for (int r = 0; r < 16; ++r) ps += p0[r];
#pragma unroll
  for (int r = 0; r < 16; ++r) ps += p1[r];
  { auto rr = __builtin_amdgcn_permlane32_swap(__float_as_uint(ps), __float_as_uint(ps), false, false);
    ps = __uint_as_float(rr[0]) + __uint_as_float(rr[1]); }
  l_reg = l_reg * alpha + ps;
#define PK4(P, BASE, OUT) do { unsigned a0 = cvtpk(P[BASE + 0], P[BASE + 1]), a1 = cvtpk(P[BASE + 2], P[BASE + 3]);   \
    unsigned b0 = cvtpk(P[BASE + 4], P[BASE + 5]), b1 = cvtpk(P[BASE + 6], P[BASE + 7]);                              \
    auto r0 = __builtin_amdgcn_permlane32_swap(a0, b0, false, false); auto r1 = __builtin_amdgcn_permlane32_swap(a1, b1, false, false); \
    u32x4 w = {r0[0], r1[0], r0[1], r1[1]}; OUT = __builtin_bit_cast(bf16x8, w); } while (0)
  PK4(p0, 0, pa0); PK4(p0, 8, pa1); PK4(p1, 0, pa2); PK4(p1, 8, pa3);
#undef PK4
}
DI void qkt(f32x16& p0, f32x16& p1, const LAS char* Ks, const bf16x8* qr, int r32, int hi, int mo) {
  p0 = f32x16{}; p1 = f32x16{};
#pragma unroll
  for (int d0 = 0; d0 < 4; ++d0) { const int cb = mo + (d0 * 16 + hi * 8) * 2;
    bf16x8 b0 = *(const LAS bf16x8*)(Ks + KSWZ(r32, cb));
    bf16x8 b1 = *(const LAS bf16x8*)(Ks + KSWZ(32 + r32, cb));
    p0 = __builtin_amdgcn_mfma_f32_32x32x16_bf16(b0, qr[d0], p0, 0, 0, 0);
    p1 = __builtin_amdgcn_mfma_f32_32x32x16_bf16(b1, qr[d0], p1, 0, 0, 0); }
}
DI int v_st(int k, int c) { const int kk = (k & ~0xC) | ((k & 4) << 1) | ((k & 8) >> 1); return ((kk >> 3) * 4 + (c >> 5)) * 512 + ((kk & 7) * 32 + (c & 31)) * 2; }
DI int v_rd_base(int lane) { return ((lane & 3) << 3) | (((lane >> 2) & 3) << 6) | (((lane >> 4) & 1) << 5) | (((lane >> 5) & 1) << 8); }
constexpr int v_rd_off(int d0, int ks, int half) { return d0 * 512 + ks * 4096 + half * 2048; }
template <int OFF> DI s16x4 tr_read(int vb) { s16x4 r; asm volatile("ds_read_b64_tr_b16 %0, %1 offset:%2" : "=&v"(r) : "v"(vb), "i"(OFF) : "memory"); return r; }
template <int D0> DI void pv_one(f32x16& od, int vb, bf16x8 pa0, bf16x8 pa1, bf16x8 pa2, bf16x8 pa3) {
  const s16x4 l0 = tr_read<v_rd_off(D0, 0, 0)>(vb), h0 = tr_read<v_rd_off(D0, 0, 1)>(vb), l1 = tr_read<v_rd_off(D0, 1, 0)>(vb), h1 = tr_read<v_rd_off(D0, 1, 1)>(vb);
  const s16x4 l2 = tr_read<v_rd_off(D0, 2, 0)>(vb), h2 = tr_read<v_rd_off(D0, 2, 1)>(vb), l3 = tr_read<v_rd_off(D0, 3, 0)>(vb), h3 = tr_read<v_rd_off(D0, 3, 1)>(vb);
  asm volatile("s_waitcnt lgkmcnt(0)" ::: "memory"); SBAR();
#define PK(L, H) (bf16x8){L[0], L[1], L[2], L[3], H[0], H[1], H[2], H[3]}
  od = __builtin_amdgcn_mfma_f32_32x32x16_bf16(pa0, PK(l0, h0), od, 0, 0, 0);
  od = __builtin_amdgcn_mfma_f32_32x32x16_bf16(pa1, PK(l1, h1), od, 0, 0, 0);
  od = __builtin_amdgcn_mfma_f32_32x32x16_bf16(pa2, PK(l2, h2), od, 0, 0, 0);
  od = __builtin_amdgcn_mfma_f32_32x32x16_bf16(pa3, PK(l3, h3), od, 0, 0, 0);
#undef PK
}
DI void pv_d0(f32x16* o, int vb, bf16x8 pa0, bf16x8 pa1, bf16x8 pa2, bf16x8 pa3) {
  pv_one<0>(o[0], vb, pa0, pa1, pa2, pa3); pv_one<1>(o[1], vb, pa0, pa1, pa2, pa3); pv_one<2>(o[2], vb, pa0, pa1, pa2, pa3); pv_one<3>(o[3], vb, pa0, pa1, pa2, pa3);
}
DI void attn_unit(const bf16_t* Qb, const bf16_t* Kb, const bf16_t* Vb, bf16_t* Ob, int h, int seq, float lam, float osc, const float* subg, LAS char* lds, const int tid) {
  const int wid = __builtin_amdgcn_readfirstlane(tid >> 6), lane = tid & 63, r32 = lane & 31, hi = lane >> 5;
  const int mbr = wid >> 2, wq = wid & 3, mo = mbr * 128;
  LAS char* V_lds = lds; LAS char* K_lds = lds + 2 * SHM_V;
  LAS float* wsl = (LAS float*)(lds + 2 * SHM_V + 2 * SHM_K) + wid * 64; LAS float* li_l = wsl; LAS float* al_l = wsl + 32;
  float m_reg = -1e30f, l_reg = 0; f32x16 o[4] = {}; bf16x8 qr[4];
  const bf16_t* Qw = Qb + (size_t)(wq * 32 + r32) * 1024 + mbr * 512 + h * 64 + hi * 8;
#pragma unroll
  for (int d0 = 0; d0 < 4; ++d0) qr[d0] = *(const bf16x8*)(Qw + d0 * 16);
  const int sr = tid >> 4, sc = (tid & 15) * 8, vst0 = v_st(sr, sc), vst1 = v_st(32 + sr, sc);
  const int kcol = (sc >> 6) * 512 + h * 64 + (sc & 63), vcol = h * 128 + sc;
  const int vb0 = (int)(uintptr_t)V_lds + v_rd_base(lane);
  bf16x8 vsA0, vsA1, ksA0, ksA1, vsB0, vsB1, ksB0, ksB1;
#define SLOADA(k0) do { vsA0 = *(const bf16x8*)(Vb + (size_t)((k0) + sr) * 1024 + vcol); vsA1 = *(const bf16x8*)(Vb + (size_t)((k0) + 32 + sr) * 1024 + vcol); \
    ksA0 = *(const bf16x8*)(Kb + (size_t)((k0) + sr) * 1024 + kcol); ksA1 = *(const bf16x8*)(Kb + (size_t)((k0) + 32 + sr) * 1024 + kcol); } while (0)
#define SLOADB(k0) do { vsB0 = *(const bf16x8*)(Vb + (size_t)((k0) + sr) * 1024 + vcol); vsB1 = *(const bf16x8*)(Vb + (size_t)((k0) + 32 + sr) * 1024 + vcol); \
    ksB0 = *(const bf16x8*)(Kb + (size_t)((k0) + sr) * 1024 + kcol); ksB1 = *(const bf16x8*)(Kb + (size_t)((k0) + 32 + sr) * 1024 + kcol); } while (0)
#define SWRITE(b, v0, v1, k0_, k1_) do { *(LAS bf16x8*)(V_lds + (b) * SHM_V + vst0) = v0; *(LAS bf16x8*)(V_lds + (b) * SHM_V + vst1) = v1; const int kc = sc * 2; \
    *(LAS bf16x8*)(K_lds + (b) * SHM_K + KSWZ(sr, kc)) = k0_; *(LAS bf16x8*)(K_lds + (b) * SHM_K + KSWZ(32 + sr, kc)) = k1_; } while (0)
#define SWAIT() asm volatile("s_waitcnt vmcnt(4)" ::: "memory")
#define RESC(a) do { if (__any((a) < 1.f)) { if (hi == 0) al_l[r32] = (a); asm volatile("s_waitcnt lgkmcnt(0)" ::: "memory"); \
    _Pragma("unroll") for (int d = 0; d < 4; ++d) _Pragma("unroll") for (int r = 0; r < 16; ++r) o[d][r] *= al_l[crow(r, hi)]; } } while (0)
  f32x16 pA0, pA1, pB0, pB1; float mnA, mnB, alA, alB; bf16x8 pa0, pa1, pa2, pa3; const int NT = seq / KVBLK;
  SLOADA(0); asm volatile("s_waitcnt vmcnt(0)" ::: "memory"); SWRITE(0, vsA0, vsA1, ksA0, ksA1); __syncthreads();
  qkt(pA0, pA1, K_lds, qr, r32, hi, mo); partialSM(pA0, pA1, m_reg, mnA, alA);
  SLOADB(KVBLK); if (2 < NT) SLOADA(2 * KVBLK);
  SWAIT(); SWRITE(1, vsB0, vsB1, ksB0, ksB1); __syncthreads();
  for (int j = 1; j + 1 < NT; j += 2) {
    SBAR(); qkt(pB0, pB1, K_lds + SHM_K, qr, r32, hi, mo);
    finishSM(pA0, pA1, alA, l_reg, pa0, pa1, pa2, pa3); SBAR();
    SLOADB((j + 2) * KVBLK); SBAR();
    pv_d0(o, vb0, pa0, pa1, pa2, pa3); partialSM(pB0, pB1, m_reg, mnB, alB);
    __syncthreads(); SWAIT(); SWRITE(0, vsA0, vsA1, ksA0, ksA1);
    RESC(alB); __syncthreads();
    SBAR(); qkt(pA0, pA1, K_lds, qr, r32, hi, mo);
    finishSM(pB0, pB1, alB, l_reg, pa0, pa1, pa2, pa3); SBAR();
    if (j + 3 < NT) SLOADA((j + 3) * KVBLK); SBAR();
    pv_d0(o, vb0 + SHM_V, pa0, pa1, pa2, pa3); partialSM(pA0, pA1, m_reg, mnA, alA);
    __syncthreads(); SWAIT(); SWRITE(1, vsB0, vsB1, ksB0, ksB1);
    RESC(alA); __syncthreads();
  }
  SBAR(); qkt(pB0, pB1, K_lds + SHM_K, qr, r32, hi, mo);
  finishSM(pA0, pA1, alA, l_reg, pa0, pa1, pa2, pa3); SBAR();
  pv_d0(o, vb0, pa0, pa1, pa2, pa3); partialSM(pB0, pB1, m_reg, mnB, alB);
  __syncthreads(); RESC(alB);
  finishSM(pB0, pB1, alB, l_reg, pa0, pa1, pa2, pa3); SBAR();
  pv_d0(o, vb0 + SHM_V, pa0, pa1, pa2, pa3);
  if (hi == 0) li_l[r32] = l_reg; asm volatile("s_waitcnt lgkmcnt(0)" ::: "memory");
  float rli[16];
#pragma unroll
  for (int r = 0; r < 16; ++r) rli[r] = 1.0f / li_l[crow(r, hi)];
  asm volatile("s_waitcnt vmcnt(0)" ::: "memory");
  __syncthreads();
  LAS float* ex = (LAS float*)lds;
  if (mbr == 1) {
#pragma unroll
    for (int r = 0; r < 16; ++r)
#pragma unroll
      for (int d0 = 0; d0 < 4; ++d0) ex[((wq * 16 + r) * 4 + d0) * 64 + lane] = o[d0][r] * rli[r] * lam;
  }
  asm volatile("s_waitcnt lgkmcnt(0)" ::: "memory");
  __syncthreads();
  if (mbr == 0) {
    float g[4];
#pragma unroll
    for (int d0 = 0; d0 < 4; ++d0) g[d0] = subg[d0 * 32 + r32] * osc;
    bf16_t* Ow = Ob + (size_t)(wq * 32) * 1024 + h * 128;
#pragma unroll
    for (int r = 0; r < 16; ++r) {
      float v[4]; float ss = 0.f;
#pragma unroll
      for (int d0 = 0; d0 < 4; ++d0) { v[d0] = o[d0][r] * rli[r] - ex[((wq * 16 + r) * 4 + d0) * 64 + lane]; ss += v[d0] * v[d0]; }
      ss += dppf<DPP_XOR1>(ss); ss += dppf<DPP_XOR2>(ss); ss += dppf<DPP_HMIRROR>(ss); ss += dppf<DPP_MIRROR>(ss); { float sa_, sb_; swap16(ss, ss, sa_, sb_); ss = sa_ + sb_; }
      const float rs = 1.0f / sqrtf(ss * (1.0f / 128.0f) + LN_EPS);
      const int orow = crow(r, hi);
#pragma unroll
      for (int d0 = 0; d0 < 4; ++d0) Ow[(size_t)orow * 1024 + d0 * 32 + r32] = (bf16_t)f2bf(v[d0] * rs * g[d0]);
    }
  }
  asm volatile("s_waitcnt lgkmcnt(0)" ::: "memory");
  __syncthreads();
#undef SLOADA
#undef SLOADB
#undef SWRITE
#undef SWAIT
#undef RESC
}
}

struct Args { const float* in[37]; float* out; unsigned char* ws; int ph_lo, ph_hi; };
struct Frame { LAS unsigned char* lds; int tid, lane, wave, G, bid, gw, NGW; };
DI Frame refresh(const Frame& F0) { Frame F = F0; int l; asm volatile("v_mbcnt_lo_u32_b32 %0, -1, 0\n\tv_mbcnt_hi_u32_b32 %0, -1, %0" : "=v"(l)); F.lane = l; F.tid = F0.wave * 64 + l; return F; }
enum { I_X = 0, I_C, I_CTX, I_CCTX, I_WADA, I_BADA, I_LNG, I_LNB, I_AWIN, I_AWOUT, I_ALAM, I_ASUB, I_S5WIN, I_S5ARE, I_S5AIM, I_S5BRE, I_S5BIM, I_S5CRE, I_S5CIM, I_S5LDT, I_S5D, I_S5GV, I_S5GG,
       I_LWIN, I_LCW, I_LCB, I_LWA, I_LBA, I_LWX, I_LBX, I_LLAM, I_LWOUT, I_RW, I_RB, I_MG, I_MU, I_MD };

DI unsigned pack4_i8(f32x4 v, float inv) {
    const int a = (int)rintf(v[0] * inv), b = (int)rintf(v[1] * inv), c = (int)rintf(v[2] * inv), d = (int)rintf(v[3] * inv);
    return (unsigned)(a & 255) | ((unsigned)(b & 255) << 8) | ((unsigned)(c & 255) << 16) | ((unsigned)d << 24);
}
DI void store_h8(signed char* hrow, float* sa, int lane, const f32x4 (&v)[4]) {
    float m = 0.f;
#pragma unroll
    for (int j = 0; j < 4; ++j) m = fmaxf(m, fmaxf(fmaxf(fabsf(v[j][0]), fabsf(v[j][1])), fmaxf(fabsf(v[j][2]), fabsf(v[j][3]))));
    m = wave_max(m);
    const float inv = m > 0.f ? 127.0f / m : 0.f;
#pragma unroll
    for (int j = 0; j < 4; ++j) *(unsigned*)(hrow + 4 * lane + 256 * j) = pack4_i8(v[j], inv);
    if (lane == 0) *sa = m * (1.0f / 127.0f);
}
DI void quant_strip(const float* W, int ldw, int n0, signed char* WT8, float* SB, int drow0, LAS float* red, int tid) {
    const int c4 = (tid & 7) * 4, r0 = (tid >> 3) * 16, lane = tid & 63, wave = tid >> 6;
    f32x4 v[16]; const float* wp = W + (size_t)r0 * ldw + n0 + c4;
#pragma unroll
    for (int i = 0; i < 16; ++i) v[i] = *(const f32x4*)(wp + (size_t)i * ldw);
    f32x4 mx = {0.f, 0.f, 0.f, 0.f};
#pragma unroll
    for (int i = 0; i < 16; ++i)
#pragma unroll
        for (int q = 0; q < 4; ++q) mx[q] = fmaxf(mx[q], fabsf(v[i][q]));
#pragma unroll
    for (int q = 0; q < 4; ++q) { mx[q] = fmaxf(mx[q], __shfl_xor(mx[q], 8)); mx[q] = fmaxf(mx[q], __shfl_xor(mx[q], 16)); mx[q] = fmaxf(mx[q], __shfl_xor(mx[q], 32)); }
    if (lane < 8) *(LAS f32x4*)(red + wave * 32 + lane * 4) = mx;
    LDS_WAIT();
    __syncthreads();
    f32x4 m = *(const LAS f32x4*)(red + c4);
#pragma unroll
    for (int w = 1; w < 8; ++w) { const f32x4 t = *(const LAS f32x4*)(red + w * 32 + c4);
#pragma unroll
        for (int q = 0; q < 4; ++q) m[q] = fmaxf(m[q], t[q]); }
#pragma unroll
    for (int q = 0; q < 4; ++q) { const float inv = m[q] > 0.f ? 127.0f / m[q] : 0.f; u32x4 o;
        o.x = pack4_i8((f32x4){v[0][q], v[1][q], v[2][q], v[3][q]}, inv); o.y = pack4_i8((f32x4){v[4][q], v[5][q], v[6][q], v[7][q]}, inv);
        o.z = pack4_i8((f32x4){v[8][q], v[9][q], v[10][q], v[11][q]}, inv); o.w = pack4_i8((f32x4){v[12][q], v[13][q], v[14][q], v[15][q]}, inv);
        *(u32x4*)(WT8 + (size_t)(drow0 + c4 + q) * 1024 + r0) = o; }
    if (tid < 8) *(f32x4*)(SB + drow0 + c4) = m * (1.0f / 127.0f);
    __syncthreads();
}
DI void transpose_tile(const float* W, int ldw, int k0, int n0, bf16_t* WT, int ldt, int drow0, LAS float* scr, int lane) {
    float v[32];
    const float* wp = W + (size_t)(k0 + (lane >> 5)) * ldw + n0 + (lane & 31);
#pragma unroll
    for (int i = 0; i < 32; ++i) v[i] = wp[(size_t)(2 * i) * ldw];
#pragma unroll
    for (int i = 0; i < 32; ++i) scr[(2 * i + (lane >> 5)) * 33 + (lane & 31)] = v[i];
    LDS_WAIT(); asm volatile("" ::: "memory");
    const int c = lane & 7;
#pragma unroll
    for (int j = 0; j < 4; ++j) { const int n = (lane >> 3) + 8 * j; const LAS float* s = scr + (8 * c) * 33 + n;
        u32x4 o; o.x = pk2(s[0 * 33], s[1 * 33]); o.y = pk2(s[2 * 33], s[3 * 33]); o.z = pk2(s[4 * 33], s[5 * 33]); o.w = pk2(s[6 * 33], s[7 * 33]);
        *(u32x4*)(WT + (size_t)(drow0 + n) * ldt + k0 + 8 * c) = o; }
    LDS_WAIT(); asm volatile("" ::: "memory");
}
DI void transpose_item(const float* W, int K, int N, bf16_t* WT, int item, int drow_base, LAS float* scr, int lane) {
    const int nblk = N / 32, kb = item / nblk, nb = item % nblk;
    transpose_tile(W, N, 64 * kb, 32 * nb, WT, K, drow_base + 32 * nb, scr, lane);
}
constexpr int BG_PER_LAYER = 2048, BG_TOTAL = DEPTH * BG_PER_LAYER;
DI void bg_item(const Args& a, const Frame& F, int it) {
    const int li = it >> 11, r = it & 2047;
    unsigned char* wbase = a.ws + WS_MOEW + (size_t)li * 64 * MiB;
    if (r < 1024) {
        const int which = r >> 9, e = (r >> 5) & 15, n0 = (r & 31) * 32;
        quant_strip(a.in[which ? I_MU : I_MG] + ((size_t)(li * 16 + e)) * 1024 * 1024, 1024, n0, (signed char*)wbase, (float*)(a.ws + WS_SCL + SCL_GU + (size_t)li * 131072),
                    e * 2048 + (n0 >> 7) * 256 + which * 128 + (n0 & 127), (LAS float*)F.lds, F.tid);
    } else {
        const int g = r - 1024, e = g >> 6, tile = (g & 63) * 8 + F.wave, kb = tile >> 5, nb = tile & 31;
        LAS float* scr = (LAS float*)(F.lds + 1024 + F.wave * 8704);
        transpose_tile(a.in[I_MD] + ((size_t)(li * 16 + e)) * 1024 * 1024, 1024, 64 * kb, 32 * nb, (bf16_t*)(wbase + 32 * MiB), 1024, e * 1024 + 32 * nb, scr, F.lane);
    }
}
DI int bg_take(const Args& a, const Frame& F) {
    LAS int* slot = (LAS int*)(F.lds + MISC_OFF + 64);
    __syncthreads();
    if (F.tid == 0) *slot = (int)__hip_atomic_fetch_add((unsigned*)(a.ws + WS_CTL) + CW_BG, 1u, RLX_AGENT);
    LDS_WAIT();
    __syncthreads();
    return *slot;
}
DI void bg_tail(const Args& a, const Frame& F, int nwg_units, int seq) {
    unsigned* flag = (unsigned*)(a.ws + WS_CTL) + CW_DONE + seq * 64;
    const int myu = (nwg_units - F.bid + F.G - 1) / F.G, maxu = (nwg_units + F.G - 1) / F.G;
    if (myu >= maxu) { if (F.tid == 0) __hip_atomic_store(flag, 1u, RLX_AGENT); return; }
    LAS int* slot = (LAS int*)(F.lds + MISC_OFF + 64);
    for (;;) {
        __syncthreads();
        if (F.tid == 0) { int it = -1; if (__hip_atomic_load(flag, RLX_AGENT) == 0u) it = (int)__hip_atomic_fetch_add((unsigned*)(a.ws + WS_CTL) + CW_BG, 1u, RLX_AGENT); *slot = it; }
        LDS_WAIT();
        __syncthreads();
        const int it = *slot;
        if (it < 0 || it >= BG_TOTAL) break;
        bg_item(a, F, it);
    }
    __syncthreads();
}
DI void bg_catch_up(const Args& a, const Frame& F, int li) {
    const int end = (li + 1) * BG_PER_LAYER;
    for (;;) { const int it = bg_take(a, F); if (it >= BG_TOTAL) break; bg_item(a, F, it); if (it >= end) break; }
    __syncthreads();
}

DI void p0_prologue(const Args& a, const Frame& F) {
    LAS float* scr = (LAS float*)(F.lds + F.wave * 16384);
    unsigned char* ws = a.ws;
    {
        constexpr int I_AOUT = 16 * 32, I_S5 = 16 * 32, I_LOUT = 22 * 32;
        constexpr int NIT = 2 * I_AOUT + 2 * I_S5 + I_LOUT;
        for (int it = F.gw; it < NIT; it += F.NGW) {
            int r = it;
            if (r < 2 * I_AOUT) { const int sl = r / I_AOUT; transpose_item(a.in[I_AWOUT] + (size_t)sl * 1024 * 1024, 1024, 1024, (bf16_t*)(ws + WS_WATT_OUT) + (size_t)sl * 1024 * 1024, r % I_AOUT, 0, scr, F.lane); continue; } r -= 2 * I_AOUT;
            if (r < 2 * I_S5) { const int which = r / I_S5, item = r % I_S5, kb = item / 32, nb = item % 32, n0 = 32 * nb;
                transpose_tile(a.in[which ? I_S5GG : I_S5GV], 1024, 64 * kb, n0, (bf16_t*)(ws + WS_WS5_GLU), 1024, (n0 >> 7) * 256 + which * 128 + (n0 & 127), scr, F.lane); continue; } r -= 2 * I_S5;
            transpose_item(a.in[I_LWOUT], 1408, 1024, (bf16_t*)(ws + WS_WLRU_OUT), r, 0, scr, F.lane);
        }
        __syncthreads();
        for (int st = F.bid; st < 2 * 96 + 32 + 88; st += F.G) {
            if (st < 192) { const int sl = st / 96, n0 = (st % 96) * 32; quant_strip(a.in[I_AWIN] + (size_t)sl * 1024 * 3072, 3072, n0, (signed char*)(ws + WS_WATT_IN) + (size_t)sl * 3072 * 1024, (float*)(ws + WS_SCL + SCL_ATT) + sl * 3072, n0, (LAS float*)F.lds, F.tid); }
            else if (st < 224) { const int n0 = (st - 192) * 32; quant_strip(a.in[I_S5WIN], 1024, n0, (signed char*)(ws + WS_WS5_IN), (float*)(ws + WS_SCL + SCL_S5), n0, (LAS float*)F.lds, F.tid); }
            else { const int n0 = (st - 224) * 32; quant_strip(a.in[I_LWIN], 2816, n0, (signed char*)(ws + WS_WLRU_IN), (float*)(ws + WS_SCL + SCL_LRU), n0, (LAS float*)F.lds, F.tid); }
        }
    }
    __syncthreads();
    if (F.bid < 192) {
        LAS float* sl = (LAS float*)F.lds;
        {   float cv[18];
#pragma unroll
            for (int q = 0; q < 18; ++q) { const int i = F.tid + 512 * q, r = i >> 10, k = i & 1023; cv[q] = (r < 8) ? a.in[I_C][r * 1024 + k] : a.in[I_CCTX][k]; }
#pragma unroll
            for (int q = 0; q < 18; ++q) sl[F.tid + 512 * q] = cv[q] / (1.0f + __expf(-cv[q])); }
        __syncthreads();
        const int ks = F.gw / 96, cg = F.gw % 96, col4 = cg * 64 + F.lane, layer = col4 / 1536, c4 = (col4 % 1536) * 4;
        f32x4 acc[9];
#pragma unroll
        for (int r = 0; r < 9; ++r) acc[r] = (f32x4){0.f, 0.f, 0.f, 0.f};
        const float* wp = a.in[I_WADA] + (size_t)layer * 1024 * 6144 + (size_t)(ks * 64) * 6144 + c4;
#pragma unroll 4
        for (int k = 0; k < 64; ++k) { const f32x4 w = *(const f32x4*)(wp + (size_t)k * 6144);
#pragma unroll
            for (int r = 0; r < 9; ++r) { const float s = sl[r * 1024 + ks * 64 + k]; acc[r] += w * s; } }
        float* mp = (float*)(ws + WS_MODP) + ((size_t)(ks * 4 + layer) * 9) * 6144 + c4;
#pragma unroll
        for (int r = 0; r < 9; ++r) *(f32x4*)(mp + (size_t)r * 6144) = acc[r];
        __syncthreads();
    }
    const int gt = F.bid * 512 + F.tid, NGT = F.G * 512;
    for (int t = gt; t < 8192; t += NGT) {
        const int p = t & 63;
        const float dt = expf(a.in[I_S5LDT][t >> 6]);
        const float Ar = a.in[I_S5ARE][t], Ai = a.in[I_S5AIM][t];
        const float mag = expf(Ar * dt); float sn, cs; sincos_cw(Ai * dt, sn, cs);
        const float zr = mag * cs, zi = mag * sn, den = Ar * Ar + Ai * Ai;
        const float kr = ((zr - 1.0f) * Ar + zi * Ai) / den, ki = (zi * Ar - (zr - 1.0f) * Ai) / den;
        ((float*)(ws + WS_PAR + PAR_ZR))[t] = zr; ((float*)(ws + WS_PAR + PAR_ZI))[t] = zi;
#pragma unroll
        for (int n = 0; n < 16; ++n) { const float br = a.in[I_S5BRE][(size_t)t * 16 + n], bi = a.in[I_S5BIM][(size_t)t * 16 + n];
            ((float*)(ws + WS_PAR + PAR_BBR))[(size_t)t * 16 + n] = kr * br - ki * bi; ((float*)(ws + WS_PAR + PAR_BBI))[(size_t)t * 16 + n] = kr * bi + ki * br; }
        (void)p;
    }
    for (int t = gt; t < 8192 * 33; t += NGT) {
        const int sidx = t / 33, tau = t % 33; const float dt = expf(a.in[I_S5LDT][sidx >> 6]);
        const float Ar = a.in[I_S5ARE][sidx], Ai = a.in[I_S5AIM][sidx]; const float mag = expf((float)tau * (Ar * dt)); float sn, cs; sincos_cw((float)tau * (Ai * dt), sn, cs);
        ((f32x2*)(ws + WS_S5ZP))[t] = (f32x2){mag * cs, mag * sn};
    }
    for (int t = gt; t < 1024; t += NGT) {
        const int pos = t >> 4, j = t & 15; const float freq = exp2f(-(float)j * (13.287712379549449f / 16.0f)); float sn, cs; sincos_cw((float)pos * freq, sn, cs);
        ((f32x2*)(ws + WS_PAR + PAR_ROPE))[t] = (f32x2){cs, sn};
    }
    for (int t = gt; t < 2 * LRUW; t += NGT) ((float*)(ws + WS_PAR + PAR_SP))[t] = log1pf(expf(-a.in[I_LLAM][t]));
    for (int t = gt; t < 2 * 2 * 16 * 96 * 96; t += NGT) {
        const int d = t % 96, e = (t / 96) % 96, n = (t / 9216) % 16, mat = (t / (9216 * 16)) % 2, dir = t / (9216 * 32);
        float v = 0.f; if (d < 88 && e < 88) v = a.in[mat ? I_LWX : I_LWA][(((size_t)dir * 16 + n) * 88 + d) * 88 + e];
        ((bf16_t*)(ws + WS_BD))[t] = (bf16_t)f2bf(v);
    }
}
DI void p0b_modreduce(const Args& a, const Frame& F) {
    const int gt = F.bid * 512 + F.tid, NGT = F.G * 512;
    for (int t = gt; t < 4 * 9 * 1536; t += NGT) {
        const int c4 = (t % 1536) * 4, lr = t / 1536, layer = lr / 9;
        f32x4 s = *(const f32x4*)(a.in[I_BADA] + (size_t)layer * 6144 + c4);
#pragma unroll
        for (int ks = 0; ks < 16; ++ks) s += *(const f32x4*)((const float*)(a.ws + WS_MODP) + ((size_t)ks * 36 + lr) * 6144 + c4);
        *(f32x4*)((float*)(a.ws + WS_MOD) + (size_t)lr * 6144 + c4) = s;
    }
}
DI void s5_tables_a(const Args& a, const Frame& F) {
    const int gt = F.bid * 512 + F.tid, NGT = F.G * 512;
    const f32x2* ZP = (const f32x2*)(a.ws + WS_S5ZP); const float* BBR = (const float*)(a.ws + WS_PAR + PAR_BBR); const float* BBI = (const float*)(a.ws + WS_PAR + PAR_BBI);
    if (F.bid < 128) {
        const int g = F.bid >> 1, dir = F.bid & 1, gd = dir * 64 + g;
        LAS f32x2* zp = (LAS f32x2*)F.lds; LAS f32x2* cc = zp + 64 * 32; LAS f32x2* bb = cc + 16 * 64;
        for (int i = F.tid; i < 2048; i += 512) zp[i] = ZP[(gd * 64 + (i >> 5)) * 33 + (i & 31)];
        for (int i = F.tid; i < 1024; i += 512) cc[i] = (f32x2){a.in[I_S5CRE][(size_t)gd * 1024 + i], a.in[I_S5CIM][(size_t)gd * 1024 + i]};
        for (int i = F.tid; i < 1024; i += 512) bb[i] = (f32x2){BBR[(size_t)gd * 1024 + i], BBI[(size_t)gd * 1024 + i]};
        LDS_WAIT();
        __syncthreads();
        const int tau = F.tid >> 4, no = F.tid & 15;
        float acc[16];
#pragma unroll
        for (int ni = 0; ni < 16; ++ni) acc[ni] = 0.f;
        for (int p = 0; p < 64; ++p) {
            const f32x2 z = zp[p * 32 + tau], c = cc[no * 64 + p];
            const float wr = c.x * z.x - c.y * z.y, wi = c.x * z.y + c.y * z.x;
#pragma unroll
            for (int ni = 0; ni < 16; ++ni) { const f32x2 bv = bb[p * 16 + ni]; acc[ni] += wr * bv.x - wi * bv.y; }
        }
        float* kt = (float*)(a.ws + WS_S5KT) + ((((size_t)(g * 2 + dir) * 32 + tau) * 16 + no) * 16);
#pragma unroll
        for (int ni = 0; ni < 16; ++ni) kt[ni] = acc[ni];
        __syncthreads();
    }
    for (int t = gt; t < 64 * 8 * 32 * 64; t += NGT) {
        const int lane = t & 63, ks = (t >> 6) & 31, cb = (t >> 11) & 7, g = t >> 14;
        const int col = cb * 32 + (lane & 31), dir = col >> 7, reim = (col >> 6) & 1, p = col & 63, n0 = 8 * (lane >> 5);
        const int sidx = (dir * 64 + g) * 64 + p; const f32x2 z = ZP[sidx * 33 + (dir ? ks : 31 - ks)];
        float v[8];
#pragma unroll
        for (int j = 0; j < 8; ++j) { const float br = BBR[(size_t)sidx * 16 + n0 + j], bi = BBI[(size_t)sidx * 16 + n0 + j]; v[j] = reim ? (z.x * bi + z.y * br) : (z.x * br - z.y * bi); }
        u32x4 o; o.x = pk2(v[0], v[1]); o.y = pk2(v[2], v[3]); o.z = pk2(v[4], v[5]); o.w = pk2(v[6], v[7]);
        *(u32x4*)((bf16_t*)(a.ws + WS_S5W1) + (size_t)t * 8) = o;
    }
    for (int t = gt; t < 64 * 16 * 16 * 64; t += NGT) {
        const int lane = t & 63, ks = 32 + ((t >> 6) & 15), cb = (t >> 10) & 15, g = t >> 14;
        const int col = cb * 32 + (lane & 31), to = col >> 4, no = col & 15, kk0 = (ks - 32) * 16 + 8 * (lane >> 5), dir = kk0 >> 7, reim = (kk0 >> 6) & 1, p0 = kk0 & 63;
        float v[8];
#pragma unroll
        for (int j = 0; j < 8; ++j) { const int p = p0 + j; const int sidx = (dir * 64 + g) * 64 + p; const f32x2 z = ZP[sidx * 33 + (dir ? 32 - to : to + 1)];
            const float cr = a.in[I_S5CRE][((size_t)(dir * 64 + g) * 16 + no) * 64 + p], ci = a.in[I_S5CIM][((size_t)(dir * 64 + g) * 16 + no) * 64 + p];
            v[j] = reim ? -(cr * z.y + ci * z.x) : (cr * z.x - ci * z.y); }
        u32x4 o; o.x = pk2(v[0], v[1]); o.y = pk2(v[2], v[3]); o.z = pk2(v[4], v[5]); o.w = pk2(v[6], v[7]);
        *(u32x4*)((bf16_t*)(a.ws + WS_S5W2) + (((size_t)(g * 16 + cb) * 48 + ks) * 64 + lane) * 8) = o;
    }
}
DI void s5_tables_b(const Args& a, const Frame& F) {
    const int gt = F.bid * 512 + F.tid, NGT = F.G * 512;
    const float* KT = (const float*)(a.ws + WS_S5KT);
    for (int t = gt; t < 64 * 16 * 32 * 64; t += NGT) {
        const int lane = t & 63, ti = (t >> 6) & 31, cb = (t >> 11) & 15, g = t >> 15;
        const int col = cb * 32 + (lane & 31), to = col >> 4, no = col & 15, n0 = 8 * (lane >> 5);
        float v[8];
#pragma unroll
        for (int j = 0; j < 8; ++j) v[j] = 0.f;
        if (ti <= to) { const float* k0 = KT + ((((size_t)(g * 2 + 0) * 32 + (to - ti)) * 16 + no) * 16 + n0);
#pragma unroll
            for (int j = 0; j < 8; ++j) v[j] += k0[j]; }
        if (ti >= to) { const float* k1 = KT + ((((size_t)(g * 2 + 1) * 32 + (ti - to)) * 16 + no) * 16 + n0);
#pragma unroll
            for (int j = 0; j < 8; ++j) v[j] += k1[j]; }
        if (ti == to) {
#pragma unroll
            for (int j = 0; j < 8; ++j) if (n0 + j == no) v[j] += a.in[I_S5D][g * 16 + no]; }
        u32x4 o; o.x = pk2(v[0], v[1]); o.y = pk2(v[2], v[3]); o.z = pk2(v[4], v[5]); o.w = pk2(v[6], v[7]);
        *(u32x4*)((bf16_t*)(a.ws + WS_S5W2) + (((size_t)(g * 16 + cb) * 48 + ti) * 64 + lane) * 8) = o;
    }
}
DI const float* mod_row(const Args& a, int li, int row) { const int p = row % LSEQ, b = row / LSEQ; return (const float*)(a.ws + WS_MOD) + (size_t)(li * 9 + (p < CN ? 8 : b)) * 6144; }
DI void store_h(bf16_t* hrow, int lane, const f32x4 (&v)[4]) {
#pragma unroll
    for (int j = 0; j < 4; ++j) { u32x2 w; w.x = pk2(v[j][0], v[j][1]); w.y = pk2(v[j][2], v[j][3]); *(u32x2*)(hrow + 4 * lane + 256 * j) = w; }
}
DI void p1_init(const Args& a, const Frame& F) {
    float* X = (float*)(a.ws + WS_X); signed char* H = (signed char*)(a.ws + WS_H); float* SA = (float*)(a.ws + WS_SCL + SCL_SA);
    for (int row = F.gw; row < MROWS; row += F.NGW) {
        const int b = row / LSEQ, p = row % LSEQ;
        const float* src = (p < CN) ? a.in[I_CTX] + ((size_t)b * CN + p) * D : a.in[I_X] + ((size_t)b * TL + (p - CN)) * D;
        const float* mr = mod_row(a, 0, row);
        f32x4 v[4], h[4];
#pragma unroll
        for (int j = 0; j < 4; ++j) { const int c = 4 * F.lane + 256 * j; v[j] = *(const f32x4*)(src + c); const f32x4 sh = *(const f32x4*)(mr + c), sc = *(const f32x4*)(mr + 1024 + c);
            h[j] = v[j] * (sc + 1.0f) + sh; *(f32x4*)(X + (size_t)row * D + c) = v[j]; }
        store_h8(H + (size_t)row * D, SA + row, F.lane, h);
    }
}
DI void ln_row(f32x4 (&v)[4], const float* g, const float* bta, int lane) {
    float s = 0.f;
#pragma unroll
    for (int j = 0; j < 4; ++j) s += (v[j][0] + v[j][1]) + (v[j][2] + v[j][3]);
    const float mean = wave_sum(s) * (1.0f / D); float q = 0.f;
#pragma unroll
    for (int j = 0; j < 4; ++j) { v[j] = v[j] - mean; q += (v[j][0] * v[j][0] + v[j][1] * v[j][1]) + (v[j][2] * v[j][2] + v[j][3] * v[j][3]); }
    const float rstd = 1.0f / sqrtf(wave_sum(q) * (1.0f / D) + LN_EPS);
#pragma unroll
    for (int j = 0; j < 4; ++j) { const int c = 4 * lane + 256 * j; v[j] = v[j] * rstd * *(const f32x4*)(g + c) + *(const f32x4*)(bta + c); }
}


constexpr int RG = 3;
DI void wave_sum_n(float (&v)[RG]) {
#pragma unroll
    for (int k = 0; k < RG; ++k) v[k] = wave_sum(v[k]);
}
DI void wave_max_n(float (&v)[RG]) {
#pragma unroll
    for (int k = 0; k < RG; ++k) v[k] = wave_max(v[k]);
}
DI void ln_rows(f32x4 (&v)[RG][4], const float* g, const float* bta, int lane) {
    float s[RG], q[RG];
#pragma unroll
    for (int k = 0; k < RG; ++k) { s[k] = 0.f;
#pragma unroll
        for (int j = 0; j < 4; ++j) s[k] += (v[k][j][0] + v[k][j][1]) + (v[k][j][2] + v[k][j][3]); }
    wave_sum_n(s);
#pragma unroll
    for (int k = 0; k < RG; ++k) { const float mean = s[k] * (1.0f / D); q[k] = 0.f;
#pragma unroll
        for (int j = 0; j < 4; ++j) { v[k][j] = v[k][j] - mean; q[k] += (v[k][j][0] * v[k][j][0] + v[k][j][1] * v[k][j][1]) + (v[k][j][2] * v[k][j][2] + v[k][j][3] * v[k][j][3]); } }
    wave_sum_n(q);
#pragma unroll
    for (int j = 0; j < 4; ++j) { const int c = 4 * lane + 256 * j; const f32x4 gg = *(const f32x4*)(g + c), bb = *(const f32x4*)(bta + c);
#pragma unroll
        for (int k = 0; k < RG; ++k) { const float rstd = 1.0f / sqrtf(q[k] * (1.0f / D) + LN_EPS); v[k][j] = v[k][j] * rstd * gg + bb; } }
}
DI void store_h8_rows(signed char* H, float* SA, const int (&row)[RG], const bool (&ok)[RG], int lane, const f32x4 (&h)[RG][4]) {
    float m[RG];
#pragma unroll
    for (int k = 0; k < RG; ++k) { m[k] = 0.f;
#pragma unroll
        for (int j = 0; j < 4; ++j) m[k] = fmaxf(m[k], fmaxf(fmaxf(fabsf(h[k][j][0]), fabsf(h[k][j][1])), fmaxf(fabsf(h[k][j][2]), fabsf(h[k][j][3])))); }
    wave_max_n(m);
#pragma unroll
    for (int k = 0; k < RG; ++k) { if (!ok[k]) continue; const float inv = m[k] > 0.f ? 127.0f / m[k] : 0.f;
#pragma unroll
        for (int j = 0; j < 4; ++j) *(unsigned*)(H + (size_t)row[k] * D + 4 * lane + 256 * j) = pack4_i8(h[k][j], inv);
        if (lane == 0) SA[row[k]] = m[k] * (1.0f / 127.0f); }
}
DI void m0_route(const Args& a, const Frame& F, int li) {
    bg_catch_up(a, F, li);
    __syncthreads();
    LAS float* rw = (LAS float*)F.lds;
    LAS int* lcnt = (LAS int*)(F.lds + 65536);
    LAS int* rinfo = (LAS int*)(F.lds + 65536 + 256);
    LAS float* rwt = (LAS float*)(F.lds + 65536 + 256 + 8 * 9 * 16);
    {   float rv[32];
#pragma unroll
        for (int q = 0; q < 32; ++q) rv[q] = a.in[I_RW][F.tid + 512 * q];
#pragma unroll
        for (int q = 0; q < 32; ++q) { const int i = F.tid + 512 * q; rw[(i & 15) * 1024 + (i >> 4)] = rv[q]; } }
    if (F.tid < 32) lcnt[F.tid] = 0;
    __syncthreads();
    float* X = (float*)(a.ws + WS_X); signed char* H = (signed char*)(a.ws + WS_H); float* SA = (float*)(a.ws + WS_SCL + SCL_SA);
    const float* lg = a.in[I_LNG] + (size_t)(li * 2 + 0) * D; const float* lb = a.in[I_LNB] + (size_t)(li * 2 + 0) * D;
    const int NR = (li == DEPTH - 1) ? NB * TL : MROWS;
#define ROW_OF(lr) ((li == DEPTH - 1) ? ((lr) / TL) * LSEQ + CN + (lr) % TL : (lr))
    int nrows = 0;
    f32x4 vn[RG][4];
#define M0_LOADROWS(dst, base_) do { _Pragma("unroll") for (int k = 0; k < RG; ++k) { const int lr_ = (base_) + k * F.NGW; const int rw_ = ROW_OF((lr_ < NR) ? lr_ : (base_)); \
        _Pragma("unroll") for (int j = 0; j < 4; ++j) dst[k][j] = *(const f32x4*)(X + (size_t)rw_ * D + 4 * F.lane + 256 * j); } } while (0)
    if (F.gw < NR) M0_LOADROWS(vn, F.gw);
    for (int base = F.gw; base < NR; base += RG * F.NGW) {
        int row[RG]; bool ok[RG]; f32x4 v[RG][4];
#pragma unroll
        for (int k = 0; k < RG; ++k) { const int lr = base + k * F.NGW; ok[k] = lr < NR; row[k] = ROW_OF(ok[k] ? lr : base);
#pragma unroll
            for (int j = 0; j < 4; ++j) v[k][j] = vn[k][j]; }
        if (base + RG * F.NGW < NR) M0_LOADROWS(vn, base + RG * F.NGW);
        ln_rows(v, lg, lb, F.lane);
#pragma unroll
        for (int k = 0; k < RG; ++k) { const float* mr = mod_row(a, li, row[k]);
#pragma unroll
            for (int j = 0; j < 4; ++j) { const int c = 4 * F.lane + 256 * j; if (ok[k]) *(f32x4*)(X + (size_t)row[k] * D + c) = v[k][j]; const f32x4 sh = *(const f32x4*)(mr + 3072 + c), sc = *(const f32x4*)(mr + 4096 + c); v[k][j] = v[k][j] * (sc + 1.0f) + sh; } }
        store_h8_rows(H, SA, row, ok, F.lane, v);
        float partn[RG][16];
#pragma unroll
        for (int e = 0; e < 16; ++e) {
            float sacc[RG];
#pragma unroll
            for (int k = 0; k < RG; ++k) sacc[k] = 0.f;
            f32x4 w4[4];
#pragma unroll
            for (int j = 0; j < 4; ++j) w4[j] = *(const LAS f32x4*)(rw + e * 1024 + 4 * F.lane + 256 * j);
#pragma unroll
            for (int j = 0; j < 4; ++j) { const f32x4 w = w4[j];
#pragma unroll
                for (int k = 0; k < RG; ++k) sacc[k] += (v[k][j][0] * w[0] + v[k][j][1] * w[1]) + (v[k][j][2] * w[2] + v[k][j][3] * w[3]); }
#pragma unroll
            for (int k = 0; k < RG; ++k) partn[k][e] = sacc[k];
        }
        float lgn[RG];
        {   const int b3 = F.lane & 8, b2 = F.lane & 4;
#pragma unroll
            for (int k = 0; k < RG; ++k) {
                float v8[8], v4[4], v2[2];
#pragma unroll
                for (int q = 0; q < 8; ++q) { float ra, rb; swap32(partn[k][q], partn[k][q + 8], ra, rb); v8[q] = ra + rb; }
#pragma unroll
                for (int q = 0; q < 4; ++q) { float ra, rb; swap16(v8[q], v8[q + 4], ra, rb); v4[q] = ra + rb; }
#pragma unroll
                for (int q = 0; q < 2; ++q) { const float send = b3 ? v4[q] : v4[q + 2], keep = b3 ? v4[q + 2] : v4[q]; v2[q] = keep + dppf<DPP_MIRROR>(send); }
                float v1; { const float send = b2 ? v2[0] : v2[1], keep = b2 ? v2[1] : v2[0]; v1 = keep + dppf<DPP_HMIRROR>(send); }
                v1 += dppf<DPP_XOR1>(v1); v1 += dppf<DPP_XOR2>(v1);
                lgn[k] = v1;
            }
        }
#pragma unroll 1
        for (int k = 0; k < RG; ++k) {
            if (!ok[k]) continue;
            const float v1 = (k == 0) ? lgn[0] : (k == 1) ? lgn[1] : lgn[2];
            float lg16[16];
#pragma unroll
            for (int e = 0; e < 16; ++e) lg16[e] = __uint_as_float((unsigned)__builtin_amdgcn_readlane((int)__float_as_uint(v1), e * 4));
            float mx = lg16[0];
#pragma unroll
            for (int e = 1; e < 16; ++e) mx = fmaxf(mx, lg16[e]);
            float pr[16], sum = 0.f;
#pragma unroll
            for (int e = 0; e < 16; ++e) { pr[e] = __expf(lg16[e] - mx); sum += pr[e]; }
            const float inv = 1.0f / sum;
            float pp[16], sv[16];
#pragma unroll
            for (int e = 0; e < 16; ++e) { pp[e] = pr[e] * inv; sv[e] = pp[e] + a.in[I_RB][e]; }
            float gs[4];
#pragma unroll
            for (int g = 0; g < 4; ++g) { const float m01 = fmaxf(sv[4 * g], sv[4 * g + 1]), n01 = fminf(sv[4 * g], sv[4 * g + 1]), m23 = fmaxf(sv[4 * g + 2], sv[4 * g + 3]), n23 = fminf(sv[4 * g + 2], sv[4 * g + 3]);
                gs[g] = fmaxf(m01, m23) + fmaxf(fminf(m01, m23), fmaxf(n01, n23)); }
            int gsel = 0; float gbest = gs[0];
#pragma unroll
            for (int g = 1; g < 4; ++g) { const bool c = gs[g] > gbest; gbest = c ? gs[g] : gbest; gsel = c ? g : gsel; }
            float s4[4], q4[4];
#pragma unroll
            for (int q = 0; q < 4; ++q) { s4[q] = (gsel == 0) ? sv[q] : (gsel == 1) ? sv[4 + q] : (gsel == 2) ? sv[8 + q] : sv[12 + q]; q4[q] = (gsel == 0) ? pp[q] : (gsel == 1) ? pp[4 + q] : (gsel == 2) ? pp[8 + q] : pp[12 + q]; }
            int i1 = 0; float b1 = s4[0], p1 = q4[0];
#pragma unroll
            for (int q = 1; q < 4; ++q) { const bool c = s4[q] > b1; b1 = c ? s4[q] : b1; p1 = c ? q4[q] : p1; i1 = c ? q : i1; }
            int i2 = -1; float b2 = -3.0e38f, p2 = 0.f;
#pragma unroll
            for (int q = 0; q < 4; ++q) { const bool c = (q != i1) && (s4[q] > b2); b2 = c ? s4[q] : b2; p2 = c ? q4[q] : p2; i2 = c ? q : i2; }
            const int e1 = 4 * gsel + i1, e2 = 4 * gsel + i2;
            const float wn = 1.0f / (p1 + p2);
            const int ri_idx = F.wave * 9 + nrows + k;
            if (F.lane == 0) { const int lp1 = atomicAdd((int*)&lcnt[e1], 1), lp2 = atomicAdd((int*)&lcnt[e2], 1);
                LAS int* ri = rinfo + ri_idx * 4; ri[0] = e1; ri[1] = lp1; ri[2] = e2; ri[3] = lp2;
                rwt[ri_idx * 2 + 0] = p1 * wn; rwt[ri_idx * 2 + 1] = p2 * wn; }
        }
        nrows += RG;
    }
    LDS_WAIT();
    __syncthreads();
    if (F.tid < 16) lcnt[16 + F.tid] = (int)__hip_atomic_fetch_add((unsigned*)(a.ws + WS_CTL) + CW_CNT + (li * 16 + F.tid) * 64, (unsigned)lcnt[F.tid], RLX_AGENT);
    LDS_WAIT();
    __syncthreads();
    if (F.lane == 0) {
        unsigned* tok = (unsigned*)(a.ws + WS_TOK); int* lists = (int*)(a.ws + WS_TOK + MiB);
        int k = 0;
        for (int lr = F.gw; lr < NR; lr += F.NGW, ++k) {
            const int row = ROW_OF(lr);
            const LAS int* ri = rinfo + (F.wave * 9 + k) * 4; const int e1 = ri[0], e2 = ri[2]; const int pos1 = lcnt[16 + e1] + ri[1], pos2 = lcnt[16 + e2] + ri[3];
            lists[(size_t)e1 * MROWS + pos1] = row; lists[(size_t)e2 * MROWS + pos2] = row;
            u32x4 w0; w0.x = (unsigned)e1; w0.y = (unsigned)pos1; w0.z = (unsigned)e2; w0.w = (unsigned)pos2;
            *(u32x4*)(tok + (size_t)row * 8) = w0; tok[(size_t)row * 8 + 4] = __float_as_uint(rwt[(F.wave * 9 + k) * 2]); tok[(size_t)row * 8 + 5] = __float_as_uint(rwt[(F.wave * 9 + k) * 2 + 1]);
        }
    }
#undef ROW_OF
#undef M0_LOADROWS
}
DI int moe_tile_table(const Args& a, const Frame& F, int li) {
    LAS int* tb = (LAS int*)(F.lds + TB_OFF);
    if (F.tid < 64) {
        int c = 0; if (F.lane < 16) c = (int)__hip_atomic_load((unsigned*)(a.ws + WS_CTL) + CW_CNT + (li * 16 + F.lane) * 64, RLX_AGENT);
        const int nt = (c + 255) >> 8; int inc = nt;
#pragma unroll
        for (int o = 1; o < 16; o <<= 1) { const int t = __shfl_up(inc, o); if (F.lane >= o) inc += t; }
        if (F.lane < 16) { tb[F.lane] = inc - nt; tb[32 + F.lane] = c; }
        if (F.lane == 15) tb[16] = inc;
    }
    LDS_WAIT();
    __syncthreads();
    return tb[16];
}
DI void m1_gateup(const Args& a, const Frame& F, int li) {
    const int NT = moe_tile_table(a, F, li);
    LAS int* tb = (LAS int*)(F.lds + TB_OFF); LAS unsigned* tab = (LAS unsigned*)(F.lds + TAB_OFF);
    pg8::MoeSched<true, 8> S; S.A = (const char*)(a.ws + WS_H); S.Bt = (const char*)(a.ws + WS_MOEW + (size_t)li * 64 * MiB); S.tb = tb; S.tab = tab; S.NT = NT; S.G = F.G; S.c = F.bid; S.tid = F.tid; S.Kb = 1024; S.estride = (size_t)2048 * 1024;
    LAS float* tabs = (LAS float*)(F.lds + TABS_OFF); const float* SA = (const float*)(a.ws + WS_SCL + SCL_SA);
    const int* lists = (const int*)(a.ws + WS_TOK + MiB);
    {   int tokr[8]; int nun = 0;
#pragma unroll
        for (int i = 0; i < 8; ++i) { pg8::Unit u; tokr[i] = 0; if (S.next(i, u)) { nun = i + 1; if (F.tid < 256) { const int cnt = tb[32 + u.e], idx = (u.pm - tb[u.e]) * 256 + F.tid; tokr[i] = lists[(size_t)u.e * MROWS + (idx < cnt ? idx : 0)]; } } }
        float sav[8];
#pragma unroll
        for (int i = 0; i < 8; ++i) sav[i] = (i < nun && F.tid < 256) ? SA[tokr[i]] : 0.f;
#pragma unroll
        for (int i = 0; i < 8; ++i) if (i < nun && F.tid < 256) { tab[i * 256 + F.tid] = (unsigned)tokr[i] * 1024u; tabs[i * 256 + F.tid] = sav[i]; }
    }
    LDS_WAIT();
    __syncthreads();
    pg8::EpiSwiGLUS E{(bf16_t*)(a.ws + WS_HID), tabs, (const float*)(a.ws + WS_SCL + SCL_GU + (size_t)li * 131072)};
    pg8::gemm_phase<pg8::EpiSwiGLUS, pg8::MoeSched<true, 8>, true>(F.lds, 1024, S, E, F.tid);
    bg_tail(a, F, NT * 8, 8 + li);
}
DI void m2_down(const Args& a, const Frame& F, int li) {
    const int NT = moe_tile_table(a, F, li);
    LAS int* tb = (LAS int*)(F.lds + TB_OFF);
    pg8::MoeSched<false, 4> S; S.A = (const char*)(a.ws + WS_HID); S.Bt = (const char*)(a.ws + WS_MOEW + (size_t)li * 64 * MiB + 32 * MiB); S.tb = tb; S.tab = nullptr; S.NT = NT; S.G = F.G; S.c = F.bid; S.tid = F.tid; S.Kb = 2048; S.estride = (size_t)1024 * 1024 * 2;
    pg8::EpiBf16 E{(bf16_t*)(a.ws + WS_YEXP), 1024, 0, 0};
    pg8::gemm_phase<pg8::EpiBf16, pg8::MoeSched<false, 4>>(F.lds, 2048, S, E, F.tid);
    bg_tail(a, F, NT * 4, 12 + li);
}
DI void m3_combine(const Args& a, const Frame& F, int li) {
    (void)moe_tile_table(a, F, li);
    const LAS int* tb = (const LAS int*)(F.lds + TB_OFF);
    float* X = (float*)(a.ws + WS_X); signed char* H = (signed char*)(a.ws + WS_H); float* SA = (float*)(a.ws + WS_SCL + SCL_SA); const bf16_t* Y = (const bf16_t*)(a.ws + WS_YEXP);
    const unsigned* tok = (const unsigned*)(a.ws + WS_TOK);
    const float* lg = a.in[I_LNG] + (size_t)(li * 2 + 1) * D; const float* lb = a.in[I_LNB] + (size_t)(li * 2 + 1) * D;
    const int NR = (li == DEPTH - 1) ? NB * TL : MROWS;
    for (int base = F.gw; base < NR; base += RG * F.NGW) {
        int row[RG]; bool ok[RG]; u32x4 t0[RG]; float w1[RG], w2[RG]; f32x4 v[RG][4];
#pragma unroll
        for (int k = 0; k < RG; ++k) { const int lr = base + k * F.NGW; ok[k] = lr < NR; const int lq = ok[k] ? lr : base; row[k] = (li == DEPTH - 1) ? (lq / TL) * LSEQ + CN + lq % TL : lq;
            t0[k] = *(const u32x4*)(tok + (size_t)row[k] * 8); w1[k] = __uint_as_float(tok[(size_t)row[k] * 8 + 4]); w2[k] = __uint_as_float(tok[(size_t)row[k] * 8 + 5]); }
#pragma unroll
        for (int k = 0; k < RG; ++k)
#pragma unroll
            for (int j = 0; j < 4; ++j) v[k][j] = *(const f32x4*)(X + (size_t)row[k] * D + 4 * F.lane + 256 * j);
        u32x2 y1[RG][4], y2[RG][4]; f32x4 g2[RG][4];
#pragma unroll
        for (int k = 0; k < RG; ++k) { const int e1 = __builtin_amdgcn_readfirstlane((int)t0[k].x), e2 = __builtin_amdgcn_readfirstlane((int)t0[k].z);
            const size_t s1 = (size_t)tb[e1] * 256 + t0[k].y, s2 = (size_t)tb[e2] * 256 + t0[k].w; const float* mr = mod_row(a, li, row[k]);
#pragma unroll
            for (int j = 0; j < 4; ++j) { const int c = 4 * F.lane + 256 * j; y1[k][j] = *(const u32x2*)(Y + s1 * 1024 + c); y2[k][j] = *(const u32x2*)(Y + s2 * 1024 + c); g2[k][j] = *(const f32x4*)(mr + 5120 + c); } }
#pragma unroll
        for (int k = 0; k < RG; ++k)
#pragma unroll
            for (int j = 0; j < 4; ++j) { f32x4 y; y[0] = w1[k] * bflo(y1[k][j].x) + w2[k] * bflo(y2[k][j].x); y[1] = w1[k] * bfhi(y1[k][j].x) + w2[k] * bfhi(y2[k][j].x);
                y[2] = w1[k] * bflo(y1[k][j].y) + w2[k] * bflo(y2[k][j].y); y[3] = w1[k] * bfhi(y1[k][j].y) + w2[k] * bfhi(y2[k][j].y);
                v[k][j] = v[k][j] * DN_ALPHA + g2[k][j] * y; }
        ln_rows(v, lg, lb, F.lane);
        if (li < DEPTH - 1) {
#pragma unroll
            for (int k = 0; k < RG; ++k) { const float* mn = mod_row(a, li + 1, row[k]);
#pragma unroll
                for (int j = 0; j < 4; ++j) { const int c = 4 * F.lane + 256 * j; if (ok[k]) *(f32x4*)(X + (size_t)row[k] * D + c) = v[k][j]; const f32x4 sh = *(const f32x4*)(mn + c), sc = *(const f32x4*)(mn + 1024 + c); v[k][j] = v[k][j] * (sc + 1.0f) + sh; } }
            store_h8_rows(H, SA, row, ok, F.lane, v);
        } else {
#pragma unroll
            for (int k = 0; k < RG; ++k) { const int b = row[k] / LSEQ, p = row[k] % LSEQ;
                if (ok[k] && p >= CN) { float* o = a.out + ((size_t)b * TL + (p - CN)) * D;
#pragma unroll
                    for (int j = 0; j < 4; ++j) *(f32x4*)(o + 4 * F.lane + 256 * j) = v[k][j]; } }
        }
    }
}

DI void a1_qkv(const Args& a, const Frame& F, int slot) {
    pg8::DenseSched S; S.init(a.ws + WS_H, a.ws + WS_WATT_IN + (size_t)slot * 3072 * 1024, MROWS, 3072, 1024, F.G, F.bid, F.tid);
    pg8::EpiBf16S E{(bf16_t*)(a.ws + MX_Q), 1024, 1024, (size_t)MROWS * 1024, (const float*)(a.ws + WS_SCL + SCL_SA), (const float*)(a.ws + WS_SCL + SCL_ATT) + slot * 3072, (const f32x2*)(a.ws + WS_PAR + PAR_ROPE)};
    pg8::gemm_phase<pg8::EpiBf16S, pg8::DenseSched, true>(F.lds, 1024, S, E, F.tid);
    bg_tail(a, F, S.nwg, slot);
}
DI void a1b_rope(const Args& a, const Frame& F) {
    const f32x2* tabl = (const f32x2*)(a.ws + WS_PAR + PAR_ROPE);
    const int quarter = F.lane & 3, colb = (F.lane >> 2) * 64 + quarter * 16;
    for (int it = F.gw; it < 2 * NB * TL; it += F.NGW) {
        const int which = it & 1, lr = it >> 1, b = lr / TL, t = lr % TL;
        bf16_t* p = (bf16_t*)(a.ws + (which ? MX_K : MX_Q)) + ((size_t)b * LSEQ + CN + t) * 1024 + colb;
        const int pos = (quarter < 2) ? (t >> 6) : (t & 63);
        u32x4 w0 = *(const u32x4*)p, w1 = *(const u32x4*)(p + 8);
        unsigned wi[8] = {w0.x, w0.y, w0.z, w0.w, w1.x, w1.y, w1.z, w1.w}; unsigned wo[8];
#pragma unroll
        for (int q = 0; q < 8; ++q) {
            const float m0 = bflo(wi[q]), m1 = bfhi(wi[q]);
            const float o0 = __shfl_xor(m0, 1), o1 = __shfl_xor(m1, 1);
            const f32x2 cs0 = tabl[pos * 16 + 2 * q], cs1 = tabl[pos * 16 + 2 * q + 1];
            const float sg = (quarter & 1) ? 1.0f : -1.0f;
            wo[q] = pk2(m0 * cs0.x + sg * o0 * cs0.y, m1 * cs1.x + sg * o1 * cs1.y);
        }
        *(u32x4*)p = (u32x4){wo[0], wo[1], wo[2], wo[3]}; *(u32x4*)(p + 8) = (u32x4){wo[4], wo[5], wo[6], wo[7]};
    }
}
DI void a2_attention(const Args& a, const Frame& F, int li, int slot) {
    const float lam_init = (li == 0) ? 0.2f : 0.55605820415562f;
    const float* lm = a.in[I_ALAM] + (size_t)slot * 4 * 64;
    const float s0 = wave_sum(lm[F.lane] * lm[64 + F.lane]), s1 = wave_sum(lm[128 + F.lane] * lm[192 + F.lane]);
    const float lamf = expf(s0) - expf(s1) + lam_init;
    const bf16_t* Q = (const bf16_t*)(a.ws + MX_Q); const bf16_t* K = (const bf16_t*)(a.ws + MX_K); const bf16_t* V = (const bf16_t*)(a.ws + MX_V); bf16_t* AO = (bf16_t*)(a.ws + MX_AO);
    const float* subg = a.in[I_ASUB] + (size_t)slot * 128;
    const int v = (F.G % 8 == 0) ? (F.bid % 8) * (F.G / 8) + F.bid / 8 : F.bid;
    for (int u = v; u < (li == DEPTH - 1 ? 1024 : 1024 + 128); u += F.G) {
        int b, h, row0, seq;
        if (u < 1024) { const int bh = u >> 4, qb = u & 15; b = bh >> 3; h = bh & 7; row0 = b * LSEQ + CN + qb * 128; seq = LSEQ; }
        else { const int w = u - 1024, bh = w >> 1, qb = w & 1; b = bh >> 3; h = bh & 7; row0 = b * LSEQ + qb * 128; seq = CN; }
        att::attn_unit(Q + (size_t)row0 * 1024, K + (size_t)b * LSEQ * 1024, V + (size_t)b * LSEQ * 1024, AO + (size_t)row0 * 1024, h, seq, lamf, 1.0f - lam_init, subg, (LAS char*)F.lds, F.tid);
    }
}
DI void a3_wout(const Args& a, const Frame& F, int li, int slot) {
    pg8::DenseSched S; S.init(a.ws + MX_AO, a.ws + WS_WATT_OUT + (size_t)slot * 1024 * 1024 * 2, MROWS, 1024, 2048, F.G, F.bid, F.tid, li == DEPTH - 1);
    pg8::EpiResid E{(float*)(a.ws + WS_X), (const float*)(a.ws + WS_MOD) + (size_t)li * 9 * 6144 + 2048};
    pg8::gemm_phase<pg8::EpiResid, pg8::DenseSched>(F.lds, 2048, S, E, F.tid);
    bg_tail(a, F, S.nwg, 2 + slot);
}

DI void s1_win(const Args& a, const Frame& F) {
    pg8::DenseSched S; S.init(a.ws + WS_H, a.ws + WS_WS5_IN, MROWS, 1024, 1024, F.G, F.bid, F.tid);
    pg8::EpiBf16S E{(bf16_t*)(a.ws + MX_U), 1024, 0, 0, (const float*)(a.ws + WS_SCL + SCL_SA), (const float*)(a.ws + WS_SCL + SCL_S5), nullptr};
    pg8::gemm_phase<pg8::EpiBf16S, pg8::DenseSched, true>(F.lds, 1024, S, E, F.tid);
    bg_tail(a, F, S.nwg, 4);
}
template <int MODE> DI void s5_mm(const Args& a, const Frame& F) {
    constexpr int KS = MODE == 1 ? 32 : 48, NCB = MODE == 1 ? 1 : 2, NCBT = 8 * NCB, LDA = KS * 16 + 8;
    LAS bf16_t* At = (LAS bf16_t*)F.lds;
    const bf16_t* Ub = (const bf16_t*)(a.ws + MX_U); const bf16_t* Hin = (const bf16_t*)(a.ws + MX_HIN);
    const bf16_t* Wf = (const bf16_t*)(a.ws + (MODE == 1 ? WS_S5W1 : WS_S5W2));
    const int r32 = F.lane & 31, hh = F.lane >> 5;
    const int v = (F.G % 8 == 0) ? (F.bid % 8) * (F.G / 8) + F.bid / 8 : F.bid;
    for (int u = v; u < 576; u += F.G) {
        const int g = u / 9, rt = u % 9;
#pragma unroll
        for (int q = 0; q < 8; ++q) { const int i = F.wave * 8 + q, r = rt * 64 + i, b = r / 72, c = r % 72;
            __builtin_amdgcn_global_load_lds((const unsigned*)(Ub + ((size_t)(b * LSEQ + c * 32 + (F.lane >> 1)) * 1024 + g * 16 + (F.lane & 1) * 8)), (LAS unsigned*)(At + i * LDA), 16, 0, 0); }
        if (MODE == 2) {
            if (F.lane < 32) {
#pragma unroll
                for (int q = 0; q < 8; ++q) { const int i = F.wave * 8 + q, r = rt * 64 + i;
                    __builtin_amdgcn_global_load_lds((const unsigned*)(Hin + ((size_t)r * 64 + g) * 256 + F.lane * 8), (LAS unsigned*)(At + i * LDA + 512), 16, 0, 0); } }
        }
        asm volatile("s_waitcnt vmcnt(0)" ::: "memory");
        LDS_WAIT();
        __syncthreads();
        f32x16 acc[2][NCB];
#pragma unroll
        for (int rb = 0; rb < 2; ++rb)
#pragma unroll
            for (int cb = 0; cb < NCB; ++cb) acc[rb][cb] = f32x16{};
        const bf16_t* wb = Wf + ((size_t)(g * NCBT + F.wave * NCB) * KS) * 512 + F.lane * 8;
        bf16x8 bq[4][NCB], bn[4][NCB];
#pragma unroll
        for (int q = 0; q < 4; ++q)
#pragma unroll
            for (int cb = 0; cb < NCB; ++cb) bq[q][cb] = *(const bf16x8*)(wb + ((size_t)cb * KS + q) * 512);
        for (int k0 = 0; k0 < KS; k0 += 4) {
            if (k0 + 4 < KS) {
#pragma unroll
                for (int q = 0; q < 4; ++q)
#pragma unroll
                    for (int cb = 0; cb < NCB; ++cb) bn[q][cb] = *(const bf16x8*)(wb + ((size_t)cb * KS + k0 + 4 + q) * 512);
            }
#pragma unroll
            for (int q = 0; q < 4; ++q) {
                const bf16x8 a0 = *(const LAS bf16x8*)(At + r32 * LDA + (k0 + q) * 16 + 8 * hh), a1 = *(const LAS bf16x8*)(At + (32 + r32) * LDA + (k0 + q) * 16 + 8 * hh);
#pragma unroll
                for (int cb = 0; cb < NCB; ++cb) { acc[0][cb] = __builtin_amdgcn_mfma_f32_32x32x16_bf16(a0, bq[q][cb], acc[0][cb], 0, 0, 0); acc[1][cb] = __builtin_amdgcn_mfma_f32_32x32x16_bf16(a1, bq[q][cb], acc[1][cb], 0, 0, 0); }
            }
#pragma unroll
            for (int q = 0; q < 4; ++q)
#pragma unroll
                for (int cb = 0; cb < NCB; ++cb) bq[q][cb] = bn[q][cb];
        }
#pragma unroll
        for (int rb = 0; rb < 2; ++rb)
#pragma unroll
            for (int reg = 0; reg < 16; ++reg) {
                const int r = rt * 64 + rb * 32 + att::crow(reg, hh);
                if (MODE == 1) { float* E = (float*)(a.ws + MX_E); E[((size_t)r * 64 + g) * 256 + F.wave * 32 + r32] = acc[rb][0][reg]; }
                else { const int b = r / 72, c = r % 72; bf16_t* Gb = (bf16_t*)(a.ws + MX_G);
#pragma unroll
                    for (int cb = 0; cb < NCB; ++cb) { const int col = (F.wave * NCB + cb) * 32 + r32, to = col >> 4, no = col & 15;
                        Gb[(size_t)(b * LSEQ + c * 32 + to) * 1024 + g * 16 + no] = (bf16_t)f2bf(gelu_tanh(acc[rb][cb][reg])); } }
            }
        __syncthreads();
    }
}
DI void s5_carry(const Args& a, const Frame& F) {
    const int gt = F.bid * 512 + F.tid; if (gt >= 65536) return;
    const int p = gt & 63, dir = (gt >> 6) & 1, g = (gt >> 7) & 63, b = gt >> 13;
    const f32x2 z32 = ((const f32x2*)(a.ws + WS_S5ZP))[((dir * 64 + g) * 64 + p) * 33 + 32];
    const float* E = (const float*)(a.ws + MX_E); bf16_t* Hin = (bf16_t*)(a.ws + MX_HIN);
    float hr = 0.f, hi = 0.f;
#define S5_CH(s) (dir ? ((s) < 8 ? 7 - (s) : 79 - (s)) : (s))
    for (int s0 = 0; s0 < 72; s0 += 8) {
        float er[8], ei[8];
#pragma unroll
        for (int q = 0; q < 8; ++q) { const size_t idx = ((size_t)(b * 72 + S5_CH(s0 + q)) * 64 + g) * 256 + dir * 128 + p; er[q] = E[idx]; ei[q] = E[idx + 64]; }
#pragma unroll
        for (int q = 0; q < 8; ++q) { const size_t idx = ((size_t)(b * 72 + S5_CH(s0 + q)) * 64 + g) * 256 + dir * 128 + p;
            Hin[idx] = (bf16_t)f2bf(hr); Hin[idx + 64] = (bf16_t)f2bf(hi);
            const float nr = z32.x * hr - z32.y * hi + er[q], ni = z32.x * hi + z32.y * hr + ei[q]; hr = nr; hi = ni; }
    }
#undef S5_CH
}
DI void s3_glu(const Args& a, const Frame& F, int li) {
    pg8::DenseSched S; S.init(a.ws + MX_G, a.ws + WS_WS5_GLU, MROWS, 2048, 2048, F.G, F.bid, F.tid);
    pg8::EpiGluResid E{(float*)(a.ws + WS_X), (const float*)(a.ws + WS_MOD) + (size_t)li * 9 * 6144 + 2048};
    pg8::gemm_phase<pg8::EpiGluResid, pg8::DenseSched>(F.lds, 2048, S, E, F.tid);
    bg_tail(a, F, S.nwg, 5);
}

DI void l1_win(const Args& a, const Frame& F) {
    pg8::DenseSched S; S.init(a.ws + WS_H, a.ws + WS_WLRU_IN, MROWS, 2816, 1024, F.G, F.bid, F.tid);
    pg8::EpiBf16S E{(bf16_t*)(a.ws + MX_UG), 2816, 0, 0, (const float*)(a.ws + WS_SCL + SCL_SA), (const float*)(a.ws + WS_SCL + SCL_LRU), nullptr};
    pg8::gemm_phase<pg8::EpiBf16S, pg8::DenseSched, true>(F.lds, 1024, S, E, F.tid);
    bg_tail(a, F, S.nwg, 6);
}
template <int PASS> DI void lru_tiles(const Args& a, const Frame& F) {
    constexpr int UNR = (PASS == 1) ? 2 : 1;
    const int half = F.wave >> 2, wq = F.wave & 3, dir = wq >> 1, nbh = wq & 1, ht = F.tid & 255;
    LAS unsigned char* ub = F.lds + half * 58368;
    LAS bf16_t* XB = (LAS bf16_t*)ub;
    LAS float* HS = (LAS float*)(ub + 13312);
    LAS bf16_t* RAW = (LAS bf16_t*)(ub + 13312);
    const bf16_t* Ug = (const bf16_t*)(a.ws + MX_UG); const bf16_t* BD = (const bf16_t*)(a.ws + WS_BD);
    const float* SP = (const float*)(a.ws + WS_PAR + PAR_SP);
    f32x2* SUMM = (f32x2*)(a.ws + MX_SUMM); const float* CARRY = (const float*)(a.ws + MX_CARRY); bf16_t* A2 = (bf16_t*)(a.ws + MX_A2);
    const int fr = F.lane & 15, fq = F.lane >> 4;
    const int src1 = dir ? F.lane + 16 : F.lane - 16, src2 = dir ? F.lane + 32 : F.lane - 32, lastl = dir ? fr : fr + 48;
    const bool val1 = dir ? (fq <= 2) : (fq >= 1), val2 = dir ? (fq <= 1) : (fq >= 2);
    const int slot = F.bid * 2 + half, n = slot & 15, rc0 = slot >> 4, nslots16 = (F.G * 2) >> 4;
#define LRU_LOADW(dst, nbi_) do { _Pragma("unroll") for (int mat = 0; mat < 2; ++mat) _Pragma("unroll") for (int ks = 0; ks < 3; ++ks) \
        dst[mat][ks] = *(const bf16x8*)(BD + ((size_t)((dir * 2 + mat) * 16 + n) * 96 + (nbh * 3 + (nbi_)) * 16 + fr) * 96 + ks * 32 + fq * 8); } while (0)
    u32x4 rawv[3], gwv[3];
#define LRU_LOAD_RAW(rc_) do { const int b_ = (rc_) / 36, c_ = (rc_) % 36, p0_ = c_ * 64, lo_ = (c_ < 4) ? 0 : CN, hi_ = (c_ < 4) ? CN : LSEQ; \
        _Pragma("unroll") for (int it = 0; it < 3; ++it) { const int pi = ht + 256 * it; rawv[it] = (u32x4){0u, 0u, 0u, 0u}; \
            if (pi < 737) { const int j = pi / 11, cg = pi % 11, q = p0_ - 1 + j; if (q >= lo_ && q < hi_) rawv[it] = *(const u32x4*)(Ug + ((size_t)b_ * LSEQ + q) * 2816 + LRUW + n * 88 + cg * 8); } } } while (0)
#define LRU_LOAD_GATE(rc_) do { const int b_ = (rc_) / 36, c_ = (rc_) % 36, p0_ = c_ * 64; \
        _Pragma("unroll") for (int it = 0; it < 3; ++it) { const int gi = ht + 256 * it; gwv[it] = (u32x4){0u, 0u, 0u, 0u}; \
            if (gi < 704) { const int row = gi / 11, cg = gi % 11; gwv[it] = *(const u32x4*)(Ug + ((size_t)b_ * LSEQ + p0_ + row) * 2816 + n * 88 + cg * 8); } } } while (0)
    if (rc0 < 288) LRU_LOAD_RAW(rc0);
    for (int rc = rc0; rc < 288; rc += nslots16) {
        const int b = rc / 36, c = rc % 36, p0 = c * 64;
        const size_t rowbase = (size_t)b * LSEQ + p0;
        bf16x8 wcur[2][3], wnxt[2][3];
        LRU_LOADW(wcur, 0);
        float bav[3], bxv[3], spv[3], hcv[3];
#pragma unroll
        for (int nbi = 0; nbi < 3; ++nbi) { const int e = (nbh * 3 + nbi) * 16 + fr, ecl = e < 88 ? e : 87, cch = n * 88 + ecl;
            bav[nbi] = a.in[I_LBA][dir * LRUW + cch]; bxv[nbi] = a.in[I_LBX][dir * LRUW + cch]; spv[nbi] = SP[dir * LRUW + cch];
            hcv[nbi] = (PASS == 2) ? CARRY[((size_t)(dir * 8 + b) * 36 + c) * LRUW + cch] : 0.f; }
#pragma unroll
        for (int it = 0; it < 3; ++it) { const int pi = ht + 256 * it; if (pi < 737) { const int j = pi / 11, cg = pi % 11; *(LAS u32x4*)(RAW + j * 88 + cg * 8) = rawv[it]; } }
        LDS_WAIT();
        __syncthreads();
#pragma unroll
        for (int it = 0; it < 3; ++it) { const int gi = ht + 256 * it;
            if (gi < 704) { const int row = gi / 11, cg = gi % 11, c0 = n * 88 + cg * 8;
                float acc[8]; { const f32x4 b0 = *(const f32x4*)(a.in[I_LCB] + c0), b1 = *(const f32x4*)(a.in[I_LCB] + c0 + 4); acc[0] = b0[0]; acc[1] = b0[1]; acc[2] = b0[2]; acc[3] = b0[3]; acc[4] = b1[0]; acc[5] = b1[1]; acc[6] = b1[2]; acc[7] = b1[3]; }
#pragma unroll
                for (int k = 0; k < 4; ++k) { const u32x4 rw = *(const LAS u32x4*)(RAW + (row + k) * 88 + cg * 8); const f32x4 w0 = *(const f32x4*)(a.in[I_LCW] + k * LRUW + c0), w1 = *(const f32x4*)(a.in[I_LCW] + k * LRUW + c0 + 4);
                    acc[0] += w0[0] * bflo(rw.x); acc[1] += w0[1] * bfhi(rw.x); acc[2] += w0[2] * bflo(rw.y); acc[3] += w0[3] * bfhi(rw.y);
                    acc[4] += w1[0] * bflo(rw.z); acc[5] += w1[1] * bfhi(rw.z); acc[6] += w1[2] * bflo(rw.w); acc[7] += w1[3] * bfhi(rw.w); }
                u32x4 o; o.x = pk2(acc[0], acc[1]); o.y = pk2(acc[2], acc[3]); o.z = pk2(acc[4], acc[5]); o.w = pk2(acc[6], acc[7]);
                *(LAS u32x4*)(XB + row * 104 + cg * 8) = o; } }
        if (ht < 64) *(LAS u32x4*)(XB + ht * 104 + 88) = (u32x4){0u, 0u, 0u, 0u};
        LDS_WAIT();
        __syncthreads();
        if (PASS == 2) LRU_LOAD_GATE(rc);
#pragma unroll
        for (int nbi = 0; nbi < 3; ++nbi) {
            if (nbi < 2) LRU_LOADW(wnxt, nbi + 1);
            const int e = (nbh * 3 + nbi) * 16 + fr, ecl = e < 88 ? e : 87, cch = n * 88 + ecl;
            const float ba = bav[nbi], bx = bxv[nbi], sp = spv[nbi];
            float Hc = hcv[nbi], Pt = 1.f; (void)cch;
#pragma unroll UNR
            for (int mi = 0; mi < 4; ++mi) {
                const int mb = dir ? 3 - mi : mi;
                f32x4 acc0 = {0.f, 0.f, 0.f, 0.f}, acc1 = {0.f, 0.f, 0.f, 0.f};
#pragma unroll
                for (int ks = 0; ks < 3; ++ks) { const bf16x8 af = *(const LAS bf16x8*)(XB + (mb * 16 + fr) * 104 + ks * 32 + fq * 8);
                    acc0 = __builtin_amdgcn_mfma_f32_16x16x32_bf16(af, wcur[0][ks], acc0, 0, 0, 0); acc1 = __builtin_amdgcn_mfma_f32_16x16x32_bf16(af, wcur[1][ks], acc1, 0, 0, 0); }
                float av[4], bt[4];
#pragma unroll
                for (int j = 0; j < 4; ++j) { const float xs = bf2f(XB[(mb * 16 + fq * 4 + j) * 104 + ecl]);
                    const float r = __builtin_amdgcn_rcpf(1.0f + __expf(-(acc0[j] + ba))), ig = __builtin_amdgcn_rcpf(1.0f + __expf(-(acc1[j] + bx)));
                    const float la = -8.0f * r * sp; av[j] = __expf(la); bt[j] = __builtin_amdgcn_sqrtf(fmaxf(1.0f - av[j] * av[j], 0.f)) * ig * xs; }
                float Pl = 1.f, hl = 0.f;
#pragma unroll
                for (int jj = 0; jj < 4; ++jj) { const int j = dir ? 3 - jj : jj; hl = fmaf(av[j], hl, bt[j]); Pl *= av[j]; }
                float Pn = __shfl(Pl, src1), hn = __shfl(hl, src1);
                float Pi = val1 ? Pn * Pl : Pl, hi = val1 ? fmaf(Pl, hn, hl) : hl;
                Pn = __shfl(Pi, src2); hn = __shfl(hi, src2);
                const float Pi2 = val2 ? Pn * Pi : Pi, hi2 = val2 ? fmaf(Pi, hn, hi) : hi;
                const float Pex = __shfl(Pi2, src1), hex = __shfl(hi2, src1);
                const float Pe = val1 ? Pex : 1.f, he = val1 ? hex : 0.f;
                const float Ptot = __shfl(Pi2, lastl), htot = __shfl(hi2, lastl);
                if (PASS == 2) {
                    float h = fmaf(Pe, Hc, he);
#pragma unroll
                    for (int jj = 0; jj < 4; ++jj) { const int j = dir ? 3 - jj : jj; h = fmaf(av[j], h, bt[j]); if (e < 88) HS[(dir * 64 + mb * 16 + fq * 4 + j) * 88 + e] = h; }
                }
                Hc = fmaf(Ptot, Hc, htot); Pt *= Ptot;
            }
            if (PASS == 1) { if (fq == 0 && e < 88) SUMM[((size_t)(dir * 8 + b) * 36 + c) * LRUW + n * 88 + e] = (f32x2){Pt, Hc}; }
            if (nbi < 2) {
#pragma unroll
                for (int mat = 0; mat < 2; ++mat)
#pragma unroll
                    for (int ks = 0; ks < 3; ++ks) wcur[mat][ks] = wnxt[mat][ks];
            }
        }
        if (rc + nslots16 < 288) LRU_LOAD_RAW(rc + nslots16);
        if (PASS == 2) {
            LDS_WAIT();
            __syncthreads();
#pragma unroll
            for (int it = 0; it < 3; ++it) { const int gi = ht + 256 * it;
                if (gi < 704) { const int row = gi / 11, cg = gi % 11;
                    const f32x4 f0 = *(const LAS f32x4*)(HS + row * 88 + cg * 8), f1 = *(const LAS f32x4*)(HS + row * 88 + cg * 8 + 4), g0 = *(const LAS f32x4*)(HS + (64 + row) * 88 + cg * 8), g1 = *(const LAS f32x4*)(HS + (64 + row) * 88 + cg * 8 + 4);
                    const u32x4 gw = gwv[it]; u32x4 o;
                    o.x = pk2((f0[0] + g0[0]) * gelu_tanh(bflo(gw.x)), (f0[1] + g0[1]) * gelu_tanh(bfhi(gw.x))); o.y = pk2((f0[2] + g0[2]) * gelu_tanh(bflo(gw.y)), (f0[3] + g0[3]) * gelu_tanh(bfhi(gw.y)));
                    o.z = pk2((f1[0] + g1[0]) * gelu_tanh(bflo(gw.z)), (f1[1] + g1[1]) * gelu_tanh(bfhi(gw.z))); o.w = pk2((f1[2] + g1[2]) * gelu_tanh(bflo(gw.w)), (f1[3] + g1[3]) * gelu_tanh(bfhi(gw.w)));
                    *(u32x4*)(A2 + (rowbase + row) * LRUW + n * 88 + cg * 8) = o; } }
        }
        LDS_WAIT();
        __syncthreads();
    }
#undef LRU_LOAD_RAW
#undef LRU_LOAD_GATE
#undef LRU_LOADW
}
DI void l3_carry(const Args& a, const Frame& F) {
    const f32x2* SUMM = (const f32x2*)(a.ws + MX_SUMM); float* CARRY = (float*)(a.ws + MX_CARRY);
    const int gt = F.bid * 512 + F.tid;
    if (gt < 2 * NB * LRUW) {
        const int dir = gt / (NB * LRUW), b = (gt / LRUW) % NB, ch = gt % LRUW; float h = 0.f;
        for (int s = 0; s < 36; ++s) { const int c = dir ? (s < 4 ? 3 - s : 39 - s) : s; const size_t idx = ((size_t)(dir * 8 + b) * 36 + c) * LRUW + ch;
            CARRY[idx] = h; const f32x2 ph = SUMM[idx]; h = fmaf(ph.x, h, ph.y); }
    }
}
DI void l5_wout(const Args& a, const Frame& F, int li) {
    pg8::DenseSched S; S.init(a.ws + MX_A2, a.ws + WS_WLRU_OUT, MROWS, 1024, LRUW * 2, F.G, F.bid, F.tid);
    pg8::EpiResid E{(float*)(a.ws + WS_X), (const float*)(a.ws + WS_MOD) + (size_t)li * 9 * 6144 + 2048};
    pg8::gemm_phase<pg8::EpiResid, pg8::DenseSched>(F.lds, LRUW * 2, S, E, F.tid);
    bg_tail(a, F, S.nwg, 7);
}

constexpr int NPHASE = 37;
__global__ void __launch_bounds__(NWAVES * 64, 2) fwd_kernel(Args args) {
    extern __shared__ __attribute__((aligned(16))) unsigned char lds_raw[];
    Frame F;
    F.lds = (LAS unsigned char*)lds_raw;
    F.wave = __builtin_amdgcn_readfirstlane((int)threadIdx.x >> 6); F.tid = 0; F.lane = 0;
    F.G = gridDim.x; F.bid = blockIdx.x; F.gw = F.bid * NWAVES + F.wave; F.NGW = F.G * NWAVES;
    volatile LAS unsigned* MISC = (volatile LAS unsigned*)(F.lds + MISC_OFF);
    for (int u = threadIdx.x; u < (LDS_BYTES - MISC_OFF) / 4; u += NWAVES * 64) ((LAS unsigned*)(F.lds + MISC_OFF))[u] = 0u;
    __syncthreads();
    XcdBarrier bar = xcd_barrier_post((unsigned*)(args.ws + WS_CTL) + CW_BAR, MISC + 8);
    const int lo = args.ph_lo, hi = args.ph_hi;
#define IN(k) (lo <= (k) && (k) < hi)
#define NREP(k) ((((PROBE_MASK) >> (k)) & 1ull) ? (args.ph_hi >= NPHASE ? 2 : 1) : 1)
#define SEAM(k) do { if (IN(k) && IN((k) + 1)) xcd_barrier(bar, refresh(F).tid == 0); } while (0)
    if (IN(0)) { for (int rep = 0; rep < NREP(0); ++rep) p0_prologue(args, refresh(F)); }   SEAM(0);
    if (IN(1)) { for (int rep = 0; rep < NREP(1); ++rep) { p0b_modreduce(args, refresh(F)); s5_tables_a(args, refresh(F)); } } SEAM(1);
    if (IN(2)) { for (int rep = 0; rep < NREP(2); ++rep) { p1_init(args, refresh(F)); s5_tables_b(args, refresh(F)); } }       SEAM(2);
    if (IN(3)) { for (int rep = 0; rep < NREP(3); ++rep) a1_qkv(args, refresh(F), 0); }          SEAM(3);
    if (IN(4)) { for (int rep = 0; rep < NREP(4); ++rep) (void)0; }
    if (IN(5)) { for (int rep = 0; rep < NREP(5); ++rep) a2_attention(args, refresh(F), 0, 0); } SEAM(5);
    if (IN(6)) { for (int rep = 0; rep < NREP(6); ++rep) a3_wout(args, refresh(F), 0, 0); }      SEAM(6);
    if (IN(7)) { for (int rep = 0; rep < NREP(7); ++rep) m0_route(args, refresh(F), 0); }        SEAM(7);
    if (IN(8)) { for (int rep = 0; rep < NREP(8); ++rep) m1_gateup(args, refresh(F), 0); }       SEAM(8);
    if (IN(9)) { for (int rep = 0; rep < NREP(9); ++rep) m2_down(args, refresh(F), 0); }         SEAM(9);
    if (IN(10)) { for (int rep = 0; rep < NREP(10); ++rep) m3_combine(args, refresh(F), 0); }     SEAM(10);
    if (IN(11)) { for (int rep = 0; rep < NREP(11); ++rep) s1_win(args, refresh(F)); }            SEAM(11);
    if (IN(12)) { for (int rep = 0; rep < NREP(12); ++rep) s5_mm<1>(args, refresh(F)); }           SEAM(12);
    if (IN(13)) { for (int rep = 0; rep < NREP(13); ++rep) s5_carry(args, refresh(F)); }          SEAM(13);
    if (IN(14)) { for (int rep = 0; rep < NREP(14); ++rep) s5_mm<2>(args, refresh(F)); }         SEAM(14);
    if (IN(15)) { for (int rep = 0; rep < NREP(15); ++rep) s3_glu(args, refresh(F), 1); }         SEAM(15);
    if (IN(16)) { for (int rep = 0; rep < NREP(16); ++rep) m0_route(args, refresh(F), 1); }       SEAM(16);
    if (IN(17)) { for (int rep = 0; rep < NREP(17); ++rep) m1_gateup(args, refresh(F), 1); }      SEAM(17);
    if (IN(18)) { for (int rep = 0; rep < NREP(18); ++rep) m2_down(args, refresh(F), 1); }        SEAM(18);
    if (IN(19)) { for (int rep = 0; rep < NREP(19); ++rep) m3_combine(args, refresh(F), 1); }     SEAM(19);
    if (IN(20)) { for (int rep = 0; rep < NREP(20); ++rep) l1_win(args, refresh(F)); }            SEAM(20);
    if (IN(21)) { for (int rep = 0; rep < NREP(21); ++rep) lru_tiles<1>(args, refresh(F)); }      SEAM(21);
    if (IN(22)) { for (int rep = 0; rep < NREP(22); ++rep) l3_carry(args, refresh(F)); }          SEAM(22);
    if (IN(23)) { for (int rep = 0; rep < NREP(23); ++rep) lru_tiles<2>(args, refresh(F)); }      SEAM(23);
    if (IN(24)) { for (int rep = 0; rep < NREP(24); ++rep) l5_wout(args, refresh(F), 2); }        SEAM(24);
    if (IN(25)) { for (int rep = 0; rep < NREP(25); ++rep) m0_route(args, refresh(F), 2); }       SEAM(25);
    if (IN(26)) { for (int rep = 0; rep < NREP(26); ++rep) m1_gateup(args, refresh(F), 2); }      SEAM(26);
    if (IN(27)) { for (int rep = 0; rep < NREP(27); ++rep) m2_down(args, refresh(F), 2); }        SEAM(27);
    if (IN(28)) { for (int rep = 0; rep < NREP(28); ++rep) m3_combine(args, refresh(F), 2); }     SEAM(28);
    if (IN(29)) { for (int rep = 0; rep < NREP(29); ++rep) a1_qkv(args, refresh(F), 1); }         SEAM(29);
    if (IN(30)) { for (int rep = 0; rep < NREP(30); ++rep) (void)0; }
    if (IN(31)) { for (int rep = 0; rep < NREP(31); ++rep) a2_attention(args, refresh(F), 3, 1); } SEAM(31);
    if (IN(32)) { for (int rep = 0; rep < NREP(32); ++rep) a3_wout(args, refresh(F), 3, 1); }     SEAM(32);
    if (IN(33)) { for (int rep = 0; rep < NREP(33); ++rep) m0_route(args, refresh(F), 3); }       SEAM(33);
    if (IN(34)) { for (int rep = 0; rep < NREP(34); ++rep) m1_gateup(args, refresh(F), 3); }      SEAM(34);
    if (IN(35)) { for (int rep = 0; rep < NREP(35); ++rep) m2_down(args, refresh(F), 3); }        SEAM(35);
    if (IN(36)) { for (int rep = 0; rep < NREP(36); ++rep) m3_combine(args, refresh(F), 3); }
#undef IN
#undef SEAM
}

extern "C" void kernel_launch(void* const* d_in, const int* in_sizes, int n_in, void* d_out, int out_size, void* d_ws, size_t ws_size, hipStream_t stream) {
    static int grid = 0;
    if (grid == 0) {
        if (n_in != 37 || ws_size < WS_END) { fprintf(stderr, "kernel_launch: unexpected n_in %d or ws_size %zu\n", n_in, ws_size); grid = -1; return; }
        if (hipFuncSetAttribute((const void*)fwd_kernel, hipFuncAttributeMaxDynamicSharedMemorySize, LDS_BYTES) != hipSuccess) { fprintf(stderr, "kernel_launch: hipFuncSetAttribute failed\n"); grid = -1; return; }
        int per_cu = 0;
        if (hipOccupancyMaxActiveBlocksPerMultiprocessor(&per_cu, (const void*)fwd_kernel, NWAVES * 64, LDS_BYTES) != hipSuccess || per_cu < 1) fprintf(stderr, "kernel_launch: occupancy query says %d\n", per_cu);
        (void)hipGetLastError();
        grid = 256;
    }
    if (grid < 0) return;
    (void)hipMemsetAsync((char*)d_ws + WS_CTL, 0, CTL_ZERO_BYTES, stream);
    Args a{};
    for (int i = 0; i < 37; ++i) a.in[i] = (const float*)d_in[i];
    a.out = (float*)d_out; a.ws = (unsigned char*)d_ws;
#if MK_N_LAUNCHES == 1
    a.ph_lo = 0; a.ph_hi = NPHASE;
    hipLaunchKernelGGL(fwd_kernel, dim3(grid), dim3(NWAVES * 64), LDS_BYTES, stream, a);
#else
    for (int p = 0; p < NPHASE; ++p) { a.ph_lo = p; a.ph_hi = p + 1; hipLaunchKernelGGL(fwd_kernel, dim3(grid), dim3(NWAVES * 64), LDS_BYTES, stream, a); }
#endif
    (void)in_sizes; (void)out_size;
}
```
